# Optimizing an MI355X kernel written in HIP

```python
import jax, jax.numpy as jnp
from jax import lax
import numpy as np

D_MODEL = 1024
BATCH = 4
SEQ = 8192
DEPTH = 2

N_META = 16
CONV_GROUPS = 8
CONV_GROUP_DIM = 64
D_CONV = CONV_GROUPS * CONV_GROUP_DIM
CONV_WIDTH = 3
MLA_HEADS = 8
QK_NOPE = 64
QK_ROPE = 32
V_HEAD = 64
Q_LORA = 256
KV_LORA = 128
D_MLA = MLA_HEADS * V_HEAD
ROPE_BASE = 10000.0
Q_BLOCK = 128
NEG_INF = -1e30
D_FF = 2816
N_BRANCH = 2
ALPHA = (2 * DEPTH) ** 0.25
BETA = (8 * DEPTH) ** -0.25
LN_EPS = 1e-5
RMS_EPS = 1e-6
IN_SPLITS = (D_CONV, D_CONV, D_CONV, Q_LORA, KV_LORA, QK_ROPE, D_MODEL, D_MODEL)
D_IN = sum(IN_SPLITS)

kernel_name = 'hybrid_shortconv_mla_macaron_deepnorm'


def layer_norm(x, g, b):
    xf = x.astype(jnp.float32)
    mu = jnp.mean(xf, axis=-1, keepdims=True)
    var = jnp.mean(jnp.square(xf - mu), axis=-1, keepdims=True)
    return ((xf - mu) * lax.rsqrt(var + LN_EPS) * g + b).astype(x.dtype)


def rms_norm(x, g):
    xf = x.astype(jnp.float32)
    return (xf * lax.rsqrt(jnp.mean(jnp.square(xf), axis=-1, keepdims=True) + RMS_EPS) * g).astype(x.dtype)


def rope_tables(T):
    inv_freq = 1.0 / (ROPE_BASE ** (jnp.arange(0, QK_ROPE, 2, dtype=jnp.float32) / QK_ROPE))
    ang = jnp.arange(T, dtype=jnp.float32)[:, None] * inv_freq[None, :]
    return jnp.cos(ang), jnp.sin(ang)


def apply_rope(x, cos, sin):
    x1, x2 = jnp.split(x.astype(jnp.float32), 2, axis=-1)
    return jnp.concatenate([x1 * cos - x2 * sin, x2 * cos + x1 * sin], axis=-1).astype(x.dtype)


def swiglu(x, w_up, w_down):
    gate, up = jnp.split(x @ w_up, 2, axis=-1)
    return (jax.nn.silu(gate) * up) @ w_down


def causal_short_conv(u, w):
    T = u.shape[1]
    up = jnp.pad(u, ((0, 0), (CONV_WIDTH - 1, 0), (0, 0)))
    out = up[:, 0:T] * w[0]
    for k in range(1, CONV_WIDTH):
        out = out + up[:, k:k + T] * w[k]
    return out


def mla_causal_attention(q_nope, q_rope, k_nope, k_rope, v):
    bsz, T = q_nope.shape[:2]
    n_blocks = -(-T // Q_BLOCK)
    pad = n_blocks * Q_BLOCK - T
    scale = (QK_NOPE + QK_ROPE) ** -0.5

    def to_blocks(a):
        a = jnp.pad(a, ((0, 0), (0, pad), (0, 0), (0, 0)))
        return jnp.moveaxis(a.reshape(bsz, n_blocks, Q_BLOCK, *a.shape[2:]), 1, 0)

    q_pos = jnp.arange(n_blocks * Q_BLOCK, dtype=jnp.int32).reshape(n_blocks, Q_BLOCK)
    k_pos = jnp.arange(T, dtype=jnp.int32)

    def one_block(args):
        qn, qr, qp = args
        s = (jnp.einsum('bqhd,bkhd->bhqk', qn, k_nope)
             + jnp.einsum('bqhr,bkr->bhqk', qr, k_rope)).astype(jnp.float32) * scale
        s = jnp.where(k_pos[None, :] <= qp[:, None], s, NEG_INF)
        p = jax.nn.softmax(s, axis=-1).astype(v.dtype)
        return jnp.einsum('bhqk,bkhd->bqhd', p, v)

    out = lax.map(one_block, (to_blocks(q_nope), to_blocks(q_rope), q_pos))
    out = jnp.moveaxis(out, 0, 1).reshape(bsz, n_blocks * Q_BLOCK, MLA_HEADS, V_HEAD)
    return out[:, :T]


def hybrid_mixer(x, w_in, b_gate, conv_w, q_norm_g, w_uq, kv_norm_g, w_ukv, w_br_conv, w_br_mla, w_o, cos, sin):
    bsz, T, _ = x.shape
    cuts = [int(c) for c in np.cumsum(IN_SPLITS)[:-1]]
    b_in, c_in, h_in, c_q, c_kv, k_r, g_conv, g_mla = jnp.split(x @ w_in, cuts, axis=-1)
    y_conv = b_in * causal_short_conv(c_in * h_in, conv_w)
    q = (rms_norm(c_q, q_norm_g) @ w_uq).reshape(bsz, T, MLA_HEADS, QK_NOPE + QK_ROPE)
    q_nope = q[..., :QK_NOPE]
    q_rope = apply_rope(q[..., QK_NOPE:], cos[None, :, None], sin[None, :, None])
    kv = (rms_norm(c_kv, kv_norm_g) @ w_ukv).reshape(bsz, T, MLA_HEADS, QK_NOPE + V_HEAD)
    k_nope, v = kv[..., :QK_NOPE], kv[..., QK_NOPE:]
    k_rope = apply_rope(k_r, cos[None], sin[None])
    y_mla = mla_causal_attention(q_nope, q_rope, k_nope, k_rope, v).reshape(bsz, T, D_MLA)
    merged = (jax.nn.sigmoid(g_conv + b_gate[0]) * (y_conv @ w_br_conv)
              + jax.nn.sigmoid(g_mla + b_gate[1]) * (y_mla @ w_br_mla))
    return merged @ w_o


def setup_inputs(seed: int = 0) -> dict:
    key = jax.random.key(seed)
    ks = jax.random.split(key, 18)
    L = DEPTH

    def dense(k, shape, scale=1.0):
        return jax.random.normal(k, shape, jnp.float32) * (scale * shape[-2] ** -0.5)

    def near_one(k, shape):
        return 1.0 + 0.02 * jax.random.normal(k, shape, jnp.float32)

    def small(k, shape):
        return 0.02 * jax.random.normal(k, shape, jnp.float32)

    return {
        'x': jax.random.normal(ks[0], (BATCH, SEQ, D_MODEL), jnp.float32),
        'meta_tokens': jax.random.normal(ks[1], (N_META, D_MODEL), jnp.float32),
        'ffn1_w_up': dense(ks[2], (L, D_MODEL, 2 * D_FF)),
        'ffn1_w_down': dense(ks[3], (L, D_FF, D_MODEL), BETA),
        'mix_w_in': dense(ks[4], (L, D_MODEL, D_IN)),
        'mix_b_gate': small(ks[5], (L, N_BRANCH, D_MODEL)),
        'conv_w': dense(ks[6], (L, CONV_WIDTH, D_CONV)),
        'q_norm_g': near_one(ks[7], (L, Q_LORA)),
        'w_uq': dense(ks[8], (L, Q_LORA, MLA_HEADS * (QK_NOPE + QK_ROPE))),
        'kv_norm_g': near_one(ks[9], (L, KV_LORA)),
        'w_ukv': dense(ks[10], (L, KV_LORA, MLA_HEADS * (QK_NOPE + V_HEAD))),
        'w_br_conv': dense(ks[11], (L, D_CONV, D_MODEL)),
        'w_br_mla': dense(ks[12], (L, D_MLA, D_MODEL)),
        'w_o': dense(ks[13], (L, D_MODEL, D_MODEL), BETA),
        'ffn2_w_up': dense(ks[14], (L, D_MODEL, 2 * D_FF)),
        'ffn2_w_down': dense(ks[15], (L, D_FF, D_MODEL), BETA),
        'ln_g': near_one(ks[16], (L, 3, D_MODEL)),
        'ln_b': small(ks[17], (L, 3, D_MODEL)),
    }


def reference(x, meta_tokens, ffn1_w_up, ffn1_w_down, mix_w_in, mix_b_gate, conv_w, q_norm_g, w_uq,
              kv_norm_g, w_ukv, w_br_conv, w_br_mla, w_o, ffn2_w_up, ffn2_w_down, ln_g, ln_b):
    bsz = x.shape[0]
    meta = jnp.broadcast_to(meta_tokens[None].astype(x.dtype), (bsz, N_META, D_MODEL))
    h = jnp.concatenate([meta, x], axis=1)
    cos, sin = rope_tables(h.shape[1])
    for l in range(DEPTH):
        h = layer_norm(ALPHA * h + 0.5 * swiglu(h, ffn1_w_up[l], ffn1_w_down[l]), ln_g[l, 0], ln_b[l, 0])
        mix = hybrid_mixer(h, mix_w_in[l], mix_b_gate[l], conv_w[l], q_norm_g[l], w_uq[l], kv_norm_g[l],
                           w_ukv[l], w_br_conv[l], w_br_mla[l], w_o[l], cos, sin)
        h = layer_norm(ALPHA * h + mix, ln_g[l, 1], ln_b[l, 1])
        h = layer_norm(ALPHA * h + 0.5 * swiglu(h, ffn2_w_up[l], ffn2_w_down[l]), ln_g[l, 2], ln_b[l, 2])
    return h[:, N_META:]
```

```cpp
#include <hip/hip_runtime.h>
#include <cstdio>
#include <cstdint>
namespace pg8 {
#define PG8_LAS __attribute__((address_space(3)))
typedef unsigned short bf16_t;
typedef short bf16x8 __attribute__((ext_vector_type(8)));
typedef float f32x4 __attribute__((ext_vector_type(4)));
typedef unsigned u32x4 __attribute__((ext_vector_type(4)));
constexpr int BM = 256, BK = 64, HALF = 128, HTB = HALF * BK * 2  , STAGE_BYTES = 8 * HTB, NXCD = 8, WGM = 8;

__host__ __device__ __forceinline__ int lds_byte(int r, int c) { const int st = (r >> 4) * 2 + (c >> 5), rr = r & 15, cc = c & 31, ob = rr * 64 + cc * 2; return st * 1024 + (ob ^ (((ob >> 9) & 1) << 5)); }
__host__ __device__ __forceinline__ void stage_rc(int b, int& R, int& C) { const int st = b / 1024, sb = b % 1024, swz = sb ^ (((sb >> 9) & 1) << 5); R = (st >> 1) * 16 + swz / 64; C = (st & 1) * 32 + (swz % 64) / 2; }
__host__ __device__ __forceinline__ int perm32(int rho) { const int n = rho >> 4, i = rho & 15; return 8 * (i >> 2) + 4 * n + (i & 3); }

struct Unit { int pm, pn; };
struct Gemm { const bf16_t* A; const bf16_t* Bt; int M, N, K; };

struct StaticOrder {
    int nM, nN, nwg, G, c;
    __host__ __device__ void init(int M, int N, int G_, int c_) { nM = M / BM; nN = N / BM; nwg = nM * nN; G = G_; c = c_; }
    __host__ __device__ bool next(int i, Unit& u) const {
        const long L = (long)i * G + c; if (L >= nwg) return false;
        int wgid = (int)L; { const int q = nwg / NXCD, r = nwg % NXCD, xcd = wgid % NXCD, off = wgid / NXCD; wgid = (xcd < r ? xcd * (q + 1) : r * (q + 1) + (xcd - r) * q) + off; }
        const int nig = WGM * nN, gid = wgid / nig, fm = gid * WGM, gsz = (nM - fm) < WGM ? (nM - fm) : WGM;
        u.pm = fm + ((wgid % nig) % gsz); u.pn = (wgid % nig) / gsz; return true;
    }
    __device__ __forceinline__ void a_ready(const Unit&) const {}
    __device__ __forceinline__ void done(const Unit&) const {}
};

typedef float f32x2 __attribute__((ext_vector_type(2)));
typedef __bf16 bf16x2_cv __attribute__((ext_vector_type(2)));
__device__ __forceinline__ unsigned cvt_pk_bf16(float lo, float hi) { f32x2 v = {lo, hi}; bf16x2_cv b = __builtin_convertvector(v, bf16x2_cv); return __builtin_bit_cast(unsigned, b); }
__device__ __forceinline__ float fast_sigmoid(float x) { return __builtin_amdgcn_rcpf(1.0f + __builtin_amdgcn_exp2f(-1.4426950408889634f * x)); }
__device__ __forceinline__ u32x4 pack8(const f32x4 a, const f32x4 b) { u32x4 w; w.x = cvt_pk_bf16(a[0], a[1]); w.y = cvt_pk_bf16(a[2], a[3]); w.z = cvt_pk_bf16(b[0], b[1]); w.w = cvt_pk_bf16(b[2], b[3]); return w; }
typedef unsigned u32x2 __attribute__((ext_vector_type(2)));
__device__ __forceinline__ float bf_lo(unsigned w) { return __uint_as_float(w << 16); }
__device__ __forceinline__ float bf_hi(unsigned w) { return __uint_as_float(w & 0xffff0000u); }

struct EpiSwiGLU {
    static constexpr bool PERM = true, AFTER_DRAIN = false;
    bf16_t* O; int ldc;
    __device__ __forceinline__ void operator()(const f32x4 (&acc)[2][2][4][2], const Unit& u, int wr, int wc, int fr, int fq) const {
        const int row0 = u.pm * BM + wr * 64 + fr; const int col0 = u.pn * 128 + wc * 32 + 8 * fq;
#pragma unroll
        for (int ai = 0; ai < 2; ++ai)
#pragma unroll
            for (int m = 0; m < 4; ++m) {
                f32x4 v[2];
#pragma unroll
                for (int n = 0; n < 2; ++n) { const f32x4 g = acc[ai][0][m][n], up = acc[ai][1][m][n];
#pragma unroll
                    for (int j = 0; j < 4; ++j) v[n][j] = g[j] * fast_sigmoid(g[j]) * up[j]; }
                *(u32x4*)(O + (size_t)(row0 + ai * HALF + m * 16) * ldc + col0) = pack8(v[0], v[1]);
            }
    }
};
struct EpiResid {
    static constexpr bool PERM = true, AFTER_DRAIN = false;
    float* H; float alpha, coef;
    __device__ __forceinline__ void operator()(const f32x4 (&acc)[2][2][4][2], const Unit& u, int wr, int wc, int fr, int fq) const {
        const int row0 = u.pm * BM + wr * 64 + fr; const int col0 = u.pn * BM + wc * 32 + 8 * fq;
#pragma unroll
        for (int ai = 0; ai < 2; ++ai)
#pragma unroll
            for (int m = 0; m < 4; ++m) {
                float* rp = H + (size_t)(row0 + ai * HALF + m * 16) * 1024 + col0;
#pragma unroll
                for (int bj = 0; bj < 2; ++bj) {
                    f32x4 a = *(const f32x4*)(rp + bj * HALF), b = *(const f32x4*)(rp + bj * HALF + 4);
                    a = a * alpha + acc[ai][bj][m][0] * coef; b = b * alpha + acc[ai][bj][m][1] * coef;
                    *(f32x4*)(rp + bj * HALF) = a; *(f32x4*)(rp + bj * HALF + 4) = b;
                }
            }
    }
};
struct EpiInProj {
    static constexpr bool PERM = true, AFTER_DRAIN = false;
    bf16_t* bch; float* lat; bf16_t* gates; const float* bgate;
    __device__ __forceinline__ void operator()(const f32x4 (&acc)[2][2][4][2], const Unit& u, int wr, int wc, int fr, int fq) const {
        const int row0 = u.pm * BM + wr * 64 + fr; const int cw = wc * 32 + 8 * fq; const int pn = u.pn;
        if (pn < 6) {
#pragma unroll
            for (int ai = 0; ai < 2; ++ai)
#pragma unroll
                for (int m = 0; m < 4; ++m) { bf16_t* rp = bch + (size_t)(row0 + ai * HALF + m * 16) * 1536 + pn * BM + cw;
#pragma unroll
                    for (int bj = 0; bj < 2; ++bj) *(u32x4*)(rp + bj * HALF) = pack8(acc[ai][bj][m][0], acc[ai][bj][m][1]); }
        } else if (pn < 8) {
#pragma unroll
            for (int ai = 0; ai < 2; ++ai)
#pragma unroll
                for (int m = 0; m < 4; ++m) { float* rp = lat + (size_t)(row0 + ai * HALF + m * 16) * 512 + (pn - 6) * BM + cw;
#pragma unroll
                    for (int bj = 0; bj < 2; ++bj) { *(f32x4*)(rp + bj * HALF) = acc[ai][bj][m][0]; *(f32x4*)(rp + bj * HALF + 4) = acc[ai][bj][m][1]; } }
        } else {
            const int gc = (pn - 8) * BM + cw;
            f32x4 bv[2][2];
#pragma unroll
            for (int bj = 0; bj < 2; ++bj)
#pragma unroll
                for (int n = 0; n < 2; ++n) bv[bj][n] = *(const f32x4*)(bgate + gc + bj * HALF + 4 * n);
#pragma unroll
            for (int ai = 0; ai < 2; ++ai)
#pragma unroll
                for (int m = 0; m < 4; ++m) { bf16_t* rp = gates + (size_t)(row0 + ai * HALF + m * 16) * 2048 + gc;
#pragma unroll
                    for (int bj = 0; bj < 2; ++bj) { f32x4 v[2];
#pragma unroll
                        for (int n = 0; n < 2; ++n) {
#ifdef PROBE_NO_BIAS
                            const f32x4 x = acc[ai][bj][m][n];
#else
                            const f32x4 x = acc[ai][bj][m][n] + bv[bj][n];
#endif
#pragma unroll
                            for (int j = 0; j < 4; ++j) {
#ifdef PROBE_PLAIN_GATES
                                v[n][j] = acc[ai][bj][m][n][j];
#elif defined(PROBE_BV_GATES)
                                v[n][j] = bv[bj][n][j] * 16.0f;
#else
                                v[n][j] = fast_sigmoid(x[j]);
#endif
                            } }
                        *(u32x4*)(rp + bj * HALF) = pack8(v[0], v[1]); } }
        }
    }
};
struct EpiPlain {
    static constexpr bool PERM = true, AFTER_DRAIN = false;
    bf16_t* O; int ldc; float scale;
    __device__ __forceinline__ void operator()(const f32x4 (&acc)[2][2][4][2], const Unit& u, int wr, int wc, int fr, int fq) const {
        const int row0 = u.pm * BM + wr * 64 + fr; const int col0 = u.pn * BM + wc * 32 + 8 * fq;
#pragma unroll
        for (int ai = 0; ai < 2; ++ai)
#pragma unroll
            for (int m = 0; m < 4; ++m) { bf16_t* rp = O + (size_t)(row0 + ai * HALF + m * 16) * ldc + col0;
#pragma unroll
                for (int bj = 0; bj < 2; ++bj) *(u32x4*)(rp + bj * HALF) = pack8(acc[ai][bj][m][0] * scale, acc[ai][bj][m][1] * scale); }
    }
};
struct EpiVt {
    static constexpr bool PERM = false, AFTER_DRAIN = false;
    bf16_t* Vt;
    __device__ __forceinline__ void operator()(const f32x4 (&acc)[2][2][4][2], const Unit& u, int wr, int wc, int fr, int fq) const {
        constexpr int T_ = 8208, TP_ = 8320, M_ = 4 * 8208;
        const int feat0 = u.pm * BM + wr * 64 + fr; const int pos = 8 * (fq & 1) + 4 * (fq >> 1);
#pragma unroll
        for (int bj = 0; bj < 2; ++bj)
#pragma unroll
            for (int n = 0; n < 2; ++n) {
                const int tok0 = u.pn * BM + bj * HALF + wc * 32 + n * 16;
                if (tok0 < M_) {
                    const int b = tok0 / T_, t0 = tok0 - b * T_;
                    bf16_t* vp = Vt + ((size_t)b * 512 + feat0) * TP_ + t0 + pos;
#pragma unroll
                    for (int ai = 0; ai < 2; ++ai)
#pragma unroll
                        for (int m = 0; m < 4; ++m) { const f32x4 x = acc[ai][bj][m][n]; u32x2 w; w.x = cvt_pk_bf16(x[0], x[1]); w.y = cvt_pk_bf16(x[2], x[3]);
                            *(u32x2*)(vp + (size_t)(ai * HALF + m * 16) * TP_) = w; }
                }
            }
    }
};
template <bool ACCUM> struct EpiGate {
    static constexpr bool PERM = true, AFTER_DRAIN = false;
    bf16_t* O; const bf16_t* G;
    __device__ __forceinline__ void operator()(const f32x4 (&acc)[2][2][4][2], const Unit& u, int wr, int wc, int fr, int fq) const {
        const int row0 = u.pm * BM + wr * 64 + fr; const int col0 = u.pn * BM + wc * 32 + 8 * fq;
#pragma unroll
        for (int ai = 0; ai < 2; ++ai)
#pragma unroll
            for (int m = 0; m < 4; ++m) { const size_t row = (size_t)(row0 + ai * HALF + m * 16);
#pragma unroll
                for (int bj = 0; bj < 2; ++bj) {
                    const u32x4 g = *(const u32x4*)(G + row * 2048 + col0 + bj * HALF);
                    f32x4 a = acc[ai][bj][m][0], b = acc[ai][bj][m][1];
                    a[0] *= bf_lo(g.x); a[1] *= bf_hi(g.x); a[2] *= bf_lo(g.y); a[3] *= bf_hi(g.y);
                    b[0] *= bf_lo(g.z); b[1] *= bf_hi(g.z); b[2] *= bf_lo(g.w); b[3] *= bf_hi(g.w);
                    bf16_t* op = O + row * 1024 + col0 + bj * HALF;
                    if (ACCUM) { const u32x4 p = *(const u32x4*)op;
                        a[0] += bf_lo(p.x); a[1] += bf_hi(p.x); a[2] += bf_lo(p.y); a[3] += bf_hi(p.y);
                        b[0] += bf_lo(p.z); b[1] += bf_hi(p.z); b[2] += bf_lo(p.w); b[3] += bf_hi(p.w); }
                    *(u32x4*)op = pack8(a, b);
                }
            }
    }
};

template <class Epi, class Sched, bool ALIGN_EPI = false, bool SP2 = false>
__device__ __forceinline__ void gemm_phase(PG8_LAS unsigned char* lds, const Gemm g, const Sched& S, const Epi& E) {
    int tid_ = threadIdx.x; asm volatile("" : "+v"(tid_));
    const int tid = tid_, wid = __builtin_amdgcn_readfirstlane(tid >> 6), lane = tid & 63, wr = wid >> 2, wc = wid & 3, fr = lane & 15, fq = lane >> 4;
    int K_ = g.K; asm volatile("" : "+s"(K_));
    const int K = K_, nt = K / BK;
    unsigned voffA[2], voffB[2];
#pragma unroll
    for (int i = 0; i < 2; ++i) { int R, C; stage_rc(tid * 16 + i * 8192, R, C); const int Rb = Epi::PERM ? ((R & ~31) + perm32(R & 31)) : R;
        voffA[i] = (unsigned)(R * K + C) * 2u; voffB[i] = (unsigned)(Rb * K + C) * 2u; }
    const size_t kstep = (size_t)(BK * 2);
    const size_t hstep = (size_t)HALF * K * 2;
    const size_t tstep = 2 * hstep;
    const unsigned ldsw = (unsigned)wid * 1024u;
    const int aoff = lds_byte(wr * 64 + fr, fq * 8), boff = lds_byte(wc * 32 + fr, fq * 8);
#define PG8_SA(b, h) (((b) * 2 + (h)) * HTB)
#define PG8_SB(b, h) ((4 + (b) * 2 + (h)) * HTB)
#define PG8_STAGE(bufoff, gbase, voff) do { _Pragma("unroll") for (int _i = 0; _i < 2; ++_i) \
        __builtin_amdgcn_global_load_lds((const unsigned*)((const char*)(gbase) + (voff)[_i]), (PG8_LAS unsigned*)(lds + (bufoff) + ldsw + _i * 8192), 16, 0, 0); } while (0)
#define PG8_LDA(dst, b, h) do { _Pragma("unroll") for (int m = 0; m < 4; ++m) _Pragma("unroll") for (int k = 0; k < 2; ++k) dst[m][k] = *(const PG8_LAS bf16x8*)(lds + PG8_SA(b, h) + aoff + m * 2048 + k * 1024); } while (0)
#define PG8_LDB(dst, b, h) do { _Pragma("unroll") for (int n = 0; n < 2; ++n) _Pragma("unroll") for (int k = 0; k < 2; ++k) dst[n][k] = *(const PG8_LAS bf16x8*)(lds + PG8_SB(b, h) + boff + n * 2048 + k * 1024); } while (0)
#define PG8_MMA(ai, bj, At, Bt) do { __builtin_amdgcn_s_setprio(1); _Pragma("unroll") for (int m = 0; m < 4; ++m) _Pragma("unroll") for (int n = 0; n < 2; ++n) _Pragma("unroll") for (int k = 0; k < 2; ++k) \
        acc[ai][bj][m][n] = __builtin_amdgcn_mfma_f32_16x16x32_bf16(Bt[n][k], At[m][k], acc[ai][bj][m][n], 0, 0, 0); __builtin_amdgcn_s_setprio(0); } while (0)
#define PG8_WAIT_V(n) asm volatile("s_waitcnt vmcnt(" #n ")" ::: "memory")
#define PG8_WAIT_L(n) asm volatile("s_waitcnt lgkmcnt(" #n ")" ::: "memory")
#define PG8_BAR __builtin_amdgcn_s_barrier()
#define PG8_SCHED __builtin_amdgcn_sched_barrier(0)
    Unit cur, nxt; int ui = 0;
    if (!S.next(0, cur)) return;
    f32x4 acc[2][2][4][2];
#pragma unroll
    for (int a = 0; a < 2; ++a)
#pragma unroll
        for (int b = 0; b < 2; ++b)
#pragma unroll
            for (int m = 0; m < 4; ++m)
#pragma unroll
                for (int n = 0; n < 2; ++n) acc[a][b][m][n] = (f32x4){0.f, 0.f, 0.f, 0.f};
    bf16x8 At[4][2], B0[2][2], B1[2][2];
    const char* cA = (const char*)g.A + (size_t)cur.pm * tstep; const char* cB = (const char*)g.Bt + (size_t)cur.pn * tstep;
    S.a_ready(cur);
    if constexpr (SP2) {
        PG8_STAGE(PG8_SB(0, 0), cB, voffB); PG8_STAGE(PG8_SB(0, 1), cB + hstep, voffB); PG8_STAGE(PG8_SA(0, 0), cA, voffA); PG8_STAGE(PG8_SA(0, 1), cA + hstep, voffA);
        if (wr == 1) PG8_BAR;
        PG8_WAIT_V(2); PG8_BAR;
        PG8_STAGE(PG8_SB(1, 0), cB + kstep, voffB); PG8_STAGE(PG8_SA(1, 0), cA + kstep, voffA); PG8_STAGE(PG8_SB(1, 1), cB + hstep + kstep, voffB);
        PG8_WAIT_V(6); PG8_BAR;
    } else {
        PG8_STAGE(PG8_SB(0, 0), cB, voffB); PG8_STAGE(PG8_SA(0, 0), cA, voffA); PG8_STAGE(PG8_SB(0, 1), cB + hstep, voffB); PG8_STAGE(PG8_SA(0, 1), cA + hstep, voffA);
        if (wr == 1) PG8_BAR;
        PG8_WAIT_V(4); PG8_BAR;
        PG8_STAGE(PG8_SB(1, 0), cB + kstep, voffB); PG8_STAGE(PG8_SA(1, 0), cA + kstep, voffA); PG8_STAGE(PG8_SB(1, 1), cB + hstep + kstep, voffB);
        PG8_WAIT_V(6); PG8_BAR;
    }
    for (;;) {
        const bool has_next = S.next(ui + 1, nxt);
        const char* nA = has_next ? (const char*)g.A + (size_t)nxt.pm * tstep : cA; const char* nB = has_next ? (const char*)g.Bt + (size_t)nxt.pn * tstep : cB;
        for (int t = 0; t < nt; t += 2) {
            const bool last = (t == nt - 2);
            const char* a1 = cA + (size_t)(t + 1) * kstep;
            const char* a2 = last ? nA : cA + (size_t)(t + 2) * kstep; const char* b2 = last ? nB : cB + (size_t)(t + 2) * kstep;
            const char* a3 = a2 + kstep; const char* b3 = b2 + kstep;
            if (last && has_next) S.a_ready(nxt);
            if constexpr (SP2) {
            PG8_LDB(B0, 0, 0); PG8_LDB(B1, 0, 1); PG8_SCHED; PG8_LDA(At, 0, 0); PG8_STAGE(PG8_SA(1, 1), a1 + hstep, voffA);
            PG8_WAIT_V(8); PG8_WAIT_L(0); PG8_BAR; PG8_MMA(0, 0, At, B0); PG8_MMA(0, 1, At, B1); PG8_BAR; PG8_SCHED;
            PG8_LDA(At, 0, 1); PG8_STAGE(PG8_SB(0, 0), b2, voffB); PG8_STAGE(PG8_SB(0, 1), b2 + hstep, voffB); PG8_STAGE(PG8_SA(0, 0), a2, voffA);
            PG8_WAIT_V(8); PG8_WAIT_L(0); PG8_BAR; PG8_MMA(1, 0, At, B0); PG8_MMA(1, 1, At, B1); PG8_BAR; PG8_SCHED;
            PG8_LDB(B0, 1, 0); PG8_LDB(B1, 1, 1); PG8_SCHED; PG8_LDA(At, 1, 0); PG8_STAGE(PG8_SA(0, 1), a2 + hstep, voffA);
            PG8_WAIT_V(8); PG8_WAIT_L(0); PG8_BAR; PG8_MMA(0, 0, At, B0); PG8_MMA(0, 1, At, B1); PG8_BAR; PG8_SCHED;
            PG8_LDA(At, 1, 1); PG8_STAGE(PG8_SB(1, 0), b3, voffB); PG8_STAGE(PG8_SB(1, 1), b3 + hstep, voffB); PG8_STAGE(PG8_SA(1, 0), a3, voffA);
            PG8_WAIT_V(8); PG8_WAIT_L(0); PG8_BAR; PG8_MMA(1, 0, At, B0); PG8_MMA(1, 1, At, B1); PG8_BAR; PG8_SCHED;
            } else {
            PG8_LDB(B0, 0, 0); PG8_SCHED; PG8_LDA(At, 0, 0); PG8_STAGE(PG8_SA(1, 1), a1 + hstep, voffA);
            PG8_WAIT_L(8); PG8_BAR; PG8_WAIT_L(0); PG8_MMA(0, 0, At, B0); PG8_BAR; PG8_SCHED;
            PG8_LDB(B1, 0, 1); PG8_STAGE(PG8_SB(0, 0), b2, voffB);
            PG8_BAR; PG8_WAIT_L(0); PG8_MMA(0, 1, At, B1); PG8_BAR;
            PG8_LDA(At, 0, 1); PG8_STAGE(PG8_SA(0, 0), a2, voffA);
            PG8_BAR; PG8_WAIT_L(0); PG8_MMA(1, 0, At, B0); PG8_BAR; PG8_SCHED;
            PG8_STAGE(PG8_SB(0, 1), b2 + hstep, voffB);
            PG8_WAIT_V(6); PG8_BAR; PG8_MMA(1, 1, At, B1); PG8_BAR;
            PG8_LDB(B0, 1, 0); PG8_SCHED; PG8_LDA(At, 1, 0); PG8_STAGE(PG8_SA(0, 1), a2 + hstep, voffA);
            PG8_WAIT_L(8); PG8_BAR; PG8_WAIT_L(0); PG8_MMA(0, 0, At, B0); PG8_BAR; PG8_SCHED;
            PG8_LDB(B1, 1, 1); PG8_STAGE(PG8_SB(1, 0), b3, voffB);
            PG8_BAR; PG8_WAIT_L(0); PG8_MMA(0, 1, At, B1); PG8_BAR;
            PG8_LDA(At, 1, 1); PG8_STAGE(PG8_SA(1, 0), a3, voffA);
            PG8_BAR; PG8_WAIT_L(0); PG8_MMA(1, 0, At, B0); PG8_BAR; PG8_SCHED;
            PG8_STAGE(PG8_SB(1, 1), b3 + hstep, voffB);
            PG8_WAIT_V(6); PG8_BAR; PG8_MMA(1, 1, At, B1); PG8_BAR;
            }
        }
        if constexpr (ALIGN_EPI) { if (wr == 0) PG8_BAR; }
        if constexpr (!Epi::AFTER_DRAIN) { E(acc, cur, wr, wc, fr, fq); S.done(cur); }
        if (!has_next) break;
#pragma unroll
        for (int a = 0; a < 2; ++a)
#pragma unroll
            for (int b = 0; b < 2; ++b)
#pragma unroll
                for (int m = 0; m < 4; ++m)
#pragma unroll
                    for (int n = 0; n < 2; ++n) acc[a][b][m][n] = (f32x4){0.f, 0.f, 0.f, 0.f};
        cur = nxt; cA = nA; cB = nB; ++ui;
        if constexpr (ALIGN_EPI) { if (wr == 1) PG8_BAR; }
    }
    PG8_WAIT_V(0);
    if constexpr (!ALIGN_EPI) { if (wr == 0) PG8_BAR; }
    PG8_BAR;
    if constexpr (Epi::AFTER_DRAIN) { E.fused(acc, cur, wr, wc, fr, fq, lds, wid, lane); S.done(cur); }
#undef PG8_SA
#undef PG8_SB
#undef PG8_STAGE
#undef PG8_LDA
#undef PG8_LDB
#undef PG8_MMA
#undef PG8_WAIT_V
#undef PG8_WAIT_L
#undef PG8_BAR
#undef PG8_SCHED
}
}

#include <hip/hip_cooperative_groups.h>
namespace cg = cooperative_groups;

constexpr int D_MODEL = 1024, BATCH = 4, SEQ = 8192, DEPTH = 2, N_META = 16, T = SEQ + N_META  , M = BATCH * T  , MPAD = 33024  ;
constexpr int D_CONV = 512, D_FF = 2816, D_IN = 4000, D_INP = 4096, NHEAD = 8, TP = 8320;
constexpr float ALPHA = 1.4142135623730951f;
constexpr float LN_EPS = 1e-5f, RMS_EPS = 1e-6f;
constexpr float QSCALE = 0.10206207261596575f * 1.4426950408889634f;
constexpr int NWAVES = 8;

constexpr size_t OFF_CTL = 0;
constexpr size_t OFF_ROPE = 65536;
constexpr size_t OFF_HF = 2097152;
constexpr size_t SZ_HF = (size_t)MPAD * 1024 * 4;
constexpr size_t OFF_W = OFF_HF + SZ_HF;
constexpr size_t SZ_W = 17825792;
constexpr size_t OFF_S = OFF_W + SZ_W;
constexpr size_t SZ_HB = (size_t)MPAD * 1024 * 2;
constexpr size_t S_HB = OFF_S;
constexpr size_t S_GATES = OFF_S + SZ_HB;
constexpr size_t S_ACT = S_GATES;
constexpr size_t S_BCH = S_GATES + (size_t)MPAD * 2048 * 2;
constexpr size_t S_LAT = S_BCH + (size_t)MPAD * 1536 * 2;
constexpr size_t S_END4 = S_LAT + (size_t)MPAD * 512 * 4;
constexpr size_t S_YCONV = S_HB;
constexpr size_t S_CQN = S_YCONV + (size_t)MPAD * 512 * 2;
constexpr size_t S_CKVN = S_CQN + (size_t)MPAD * 256 * 2;
static_assert(S_CKVN + (size_t)MPAD * 256 * 2 <= S_GATES, "row-prep outputs fit in hb's region");
constexpr size_t S_Q = S_BCH;
constexpr size_t S_KN = S_Q + (size_t)MPAD * 768 * 2;
constexpr size_t S_VT = S_KN + (size_t)MPAD * 512 * 2;
constexpr size_t S_YMLA = S_VT + (size_t)BATCH * NHEAD * 64 * TP * 2;
static_assert(S_YMLA + (size_t)MPAD * 512 * 2 <= S_END4, "attention tensors fit in bch|lat's region");
constexpr size_t S_MERGED = S_Q;
static_assert(S_MERGED + (size_t)MPAD * 1024 * 2 <= S_VT + 0 * S_YMLA && S_ACT + (size_t)MPAD * 2816 * 2 <= S_END4, "overlays");
constexpr size_t S_KR = S_END4;
constexpr size_t WS_NEED = S_KR + (size_t)MPAD * 32 * 2;
static_assert(WS_NEED <= 536870912, "fits the guaranteed workspace");
constexpr size_t W_UP = 0, W_DOWN = (size_t)5632 * 1024 * 2;
constexpr size_t W_IN = 0, W_UQ = (size_t)4096 * 1024 * 2, W_UKV = W_UQ + 768 * 256 * 2, W_BC = W_UKV + 1024 * 256 * 2, W_BM = W_BC + 1024 * 512 * 2, W_O = W_BM + 1024 * 512 * 2;
static_assert(W_O + 1024 * 1024 * 2 <= SZ_W && W_DOWN + (size_t)1024 * 2816 * 2 <= SZ_W, "weight region");
constexpr int RING_BYTES = 131072, LDS_MISC = RING_BYTES, LDS_BYTES = RING_BYTES + 256;

#define LAS __attribute__((address_space(3)))
typedef unsigned short bf16;
typedef unsigned v4u __attribute__((ext_vector_type(4)));
typedef unsigned v2u __attribute__((ext_vector_type(2)));
typedef float f32x4 __attribute__((ext_vector_type(4)));
typedef float f32x2 __attribute__((ext_vector_type(2)));
typedef float f32x16 __attribute__((ext_vector_type(16)));
typedef short bf16x8 __attribute__((ext_vector_type(8)));
#define LDS_WAIT() asm volatile("s_waitcnt lgkmcnt(0)" ::: "memory")

__device__ __forceinline__ unsigned pk2(float lo, float hi) { return pg8::cvt_pk_bf16(lo, hi); }
__device__ __forceinline__ float wave_sum(float v) {
#pragma unroll
    for (int o = 1; o < 64; o <<= 1) v += __shfl_xor(v, o);
    return v;
}

__device__ __forceinline__ float inv_freq_of(int k) {
    switch (k) { case 0: return 1.000000000e+00f; case 1: return 5.623413324e-01f; case 2: return 3.162277639e-01f; case 3: return 1.778279394e-01f; case 4: return 1.000000015e-01f; case 5: return 5.623412877e-02f;
        case 6: return 3.162277862e-02f; case 7: return 1.778279431e-02f; case 8: return 9.999999776e-03f; case 9: return 5.623413250e-03f; case 10: return 3.162277862e-03f; case 11: return 1.778279431e-03f;
        case 12: return 1.000000047e-03f; case 13: return 5.623413017e-04f; case 14: return 3.162277862e-04f; default: return 1.778279402e-04f; }
}
__device__ __forceinline__ void transpose_item(const float* W, int N, int k0, int scol0, bf16* dst, int ldk, int drow0, LAS float* scr, int lane) {
    if (scol0 >= 0) {
#pragma unroll 8
        for (int i = 0; i < 32; ++i) { const int kk = 2 * i + (lane >> 5); scr[kk * 33 + (lane & 31)] = W[(size_t)(k0 + kk) * N + scol0 + (lane & 31)]; }
    } else {
#pragma unroll 8
        for (int i = 0; i < 32; ++i) { const int kk = 2 * i + (lane >> 5); scr[kk * 33 + (lane & 31)] = 0.f; }
    }
    LDS_WAIT(); asm volatile("" ::: "memory");
    const int c = lane & 7;
#pragma unroll
    for (int j = 0; j < 4; ++j) { const int n = (lane >> 3) + 8 * j; const LAS float* s = scr + (8 * c) * 33 + n;
        v4u o; o.x = pk2(s[0 * 33], s[1 * 33]); o.y = pk2(s[2 * 33], s[3 * 33]); o.z = pk2(s[4 * 33], s[5 * 33]); o.w = pk2(s[6 * 33], s[7 * 33]);
        *(v4u*)(dst + (size_t)(drow0 + n) * ldk + k0 + 8 * c) = o; }
    LDS_WAIT(); asm volatile("" ::: "memory");
}
__device__ __forceinline__ void convert_ffn(const float* w_up, const float* w_down, unsigned char* wreg, LAS float* scr, int gw, int ngw, int lane) {
    constexpr int I_UP = 16 * 176, I_DN = 44 * 32;
    for (int it = gw; it < I_UP + I_DN; it += ngw) {
        if (it < I_UP) { const int kb = it / 176, g = it % 176, tile = g >> 3, sub = g & 7;
            const int scol = sub < 4 ? tile * 128 + sub * 32 : D_FF + tile * 128 + (sub - 4) * 32;
            transpose_item(w_up, 2 * D_FF, kb * 64, scol, (bf16*)(wreg + W_UP), 1024, g * 32, scr, lane); }
        else { const int r = it - I_UP, kb = r / 32, g = r % 32; transpose_item(w_down, 1024, kb * 64, g * 32, (bf16*)(wreg + W_DOWN), D_FF, g * 32, scr, lane); }
    }
}
__device__ __forceinline__ void convert_mixer(const float* w_in, const float* w_uq, const float* w_ukv, const float* w_bc, const float* w_bm, const float* w_o, unsigned char* wreg, LAS float* scr, int gw, int ngw, int lane) {
    constexpr int I_IN = 16 * 128, I_UQ = 4 * 24, I_UKV = 4 * 32, I_BR = 8 * 32, I_O = 16 * 32;
    for (int it = gw; it < I_IN + I_UQ + I_UKV + 2 * I_BR + I_O; it += ngw) {
        int r = it;
        if (r < I_IN) { const int kb = r / 128, g = r % 128, n = g * 32; const int scol = n < 1952 ? n : (n < 2048 ? -1 : (n < 3072 ? 1952 + (n - 2048) : 2976 + (n - 3072)));
            transpose_item(w_in, D_IN, kb * 64, scol, (bf16*)(wreg + W_IN), 1024, n, scr, lane); continue; } r -= I_IN;
        if (r < I_UQ) { const int kb = r / 24, g = r % 24; transpose_item(w_uq, 768, kb * 64, g * 32, (bf16*)(wreg + W_UQ), 256, g * 32, scr, lane); continue; } r -= I_UQ;
        if (r < I_UKV) { const int kb = r / 32, g = r % 32, gg = g & 15; const int scol = (gg >> 1) * 128 + (g >> 4) * 64 + (gg & 1) * 32;
            transpose_item(w_ukv, 1024, kb < 2 ? kb * 64 : 0, kb < 2 ? scol : -1, (bf16*)(wreg + W_UKV) + (kb < 2 ? 0 : kb * 64), 256, g * 32, scr, lane); continue; } r -= I_UKV;
        if (r < I_BR) { const int kb = r / 32, g = r % 32; transpose_item(w_bc, 1024, kb * 64, g * 32, (bf16*)(wreg + W_BC), 512, g * 32, scr, lane); continue; } r -= I_BR;
        if (r < I_BR) { const int kb = r / 32, g = r % 32; transpose_item(w_bm, 1024, kb * 64, g * 32, (bf16*)(wreg + W_BM), 512, g * 32, scr, lane); continue; } r -= I_BR;
        { const int kb = r / 32, g = r % 32; transpose_item(w_o, 1024, kb * 64, g * 32, (bf16*)(wreg + W_O), 1024, g * 32, scr, lane); }
    }
}

__device__ __forceinline__ void ln_row(const float* xin, const float* g, const float* bt, float* of32, bf16* ob16, int lane) {
    const f32x4* xr = (const f32x4*)xin + lane;
    f32x4 v[4]; float s = 0.f;
#pragma unroll
    for (int j = 0; j < 4; ++j) { v[j] = xr[64 * j]; s += (v[j].x + v[j].y) + (v[j].z + v[j].w); }
    const float mean = wave_sum(s) * (1.f / 1024.f); float s2 = 0.f;
#pragma unroll
    for (int j = 0; j < 4; ++j) { v[j] = v[j] - mean; s2 += (v[j].x * v[j].x + v[j].y * v[j].y) + (v[j].z * v[j].z + v[j].w * v[j].w); }
    const float rstd = 1.f / sqrtf(wave_sum(s2) * (1.f / 1024.f) + LN_EPS);
#pragma unroll
    for (int j = 0; j < 4; ++j) { const f32x4 gg = ((const f32x4*)g)[lane + 64 * j], bb = ((const f32x4*)bt)[lane + 64 * j]; v[j] = v[j] * rstd * gg + bb; }
    if (of32) {
#pragma unroll
        for (int j = 0; j < 4; ++j) ((f32x4*)of32)[lane + 64 * j] = v[j]; }
    if (ob16) {
#pragma unroll
        for (int j = 0; j < 4; ++j) { v2u w; w.x = pk2(v[j].x, v[j].y); w.y = pk2(v[j].z, v[j].w); ((v2u*)ob16)[lane + 64 * j] = w; } }
}

namespace att {
constexpr int KB = 12288, VB = 8192, OFF_V = 2 * KB, OFF_WS = 2 * KB + 3 * VB, OFF_Q = OFF_WS + 8 * 256;
__device__ __forceinline__ int crow(int r, int hi) { return (r & 3) + 8 * (r >> 2) + 4 * hi; }
__device__ __forceinline__ void attn_unit(int b, int h, int qb, const bf16* Q, const bf16* Kn, const bf16* Kr, const bf16* Vt, const float* rope, bf16* Y, LAS unsigned char* lds) {
    int tid_ = threadIdx.x; asm volatile("" : "+v"(tid_));
    const int tid = tid_, lane = tid & 63, r32 = lane & 31, hi = lane >> 5; const int wid = __builtin_amdgcn_readfirstlane(tid >> 6);
    const int q0 = qb * 256, q0w = q0 + wid * 32;
    const size_t rowbase = (size_t)b * T;
    int NT = (q0 + 256) / 64; if (NT > (T + 63) / 64) NT = (T + 63) / 64;
    int ntw = 0; if (q0w < T) { ntw = (q0w + 31) / 64 + 1; if (ntw > NT) ntw = NT; }
    bf16x8 qr[6];
    { int tq = q0w + r32; if (tq > T - 1) tq = T - 1; const bf16* qp = Q + (rowbase + tq) * 768 + h * 96 + hi * 8;
#pragma unroll
      for (int d0 = 0; d0 < 6; ++d0) qr[d0] = *(const bf16x8*)(qp + d0 * 16);
      const float* rt = rope + (size_t)tq * 32 + 8 * hi; const f32x4 c0 = *(const f32x4*)rt, c1 = *(const f32x4*)(rt + 4), s0 = *(const f32x4*)(rt + 16), s1 = *(const f32x4*)(rt + 20);
      v4u a = __builtin_bit_cast(v4u, qr[4]), bb = __builtin_bit_cast(v4u, qr[5]), oa, ob;
#define ROT2(AW, BW, CA, CB, SA, SB, OA, OB) do { const float x1l = pg8::bf_lo(AW), x1h = pg8::bf_hi(AW), x2l = pg8::bf_lo(BW), x2h = pg8::bf_hi(BW); \
        OA = pk2(x1l * (CA) - x2l * (SA), x1h * (CB) - x2h * (SB)); OB = pk2(x2l * (CA) + x1l * (SA), x2h * (CB) + x1h * (SB)); } while (0)
      ROT2(a.x, bb.x, c0[0], c0[1], s0[0], s0[1], oa.x, ob.x); ROT2(a.y, bb.y, c0[2], c0[3], s0[2], s0[3], oa.y, ob.y);
      ROT2(a.z, bb.z, c1[0], c1[1], s1[0], s1[1], oa.z, ob.z); ROT2(a.w, bb.w, c1[2], c1[3], s1[2], s1[3], oa.w, ob.w);
#undef ROT2
      qr[4] = __builtin_bit_cast(bf16x8, oa); qr[5] = __builtin_bit_cast(bf16x8, ob); }
    const bf16* kn_src = Kn + (rowbase + lane) * 512 + h * 64 + wid * 8;
    const bf16* kr_src = Kr + (rowbase + lane) * 32 + (wid & 3) * 8;
    const bf16* v_src = Vt + ((size_t)(b * 8 + h) * 64 + lane) * TP + wid * 8;
    v4u kreg, krreg = (v4u){0u, 0u, 0u, 0u}, vreg;
#define ATT_LOAD(kt) do { kreg = *(const v4u*)(kn_src + (size_t)(kt) * 64 * 512); if (wid < 4) krreg = *(const v4u*)(kr_src + (size_t)(kt) * 64 * 32); vreg = *(const v4u*)(v_src + (size_t)(kt) * 64); } while (0)
#define ATT_STORE(buf, vslot) do { *(LAS v4u*)(lds + (buf) * KB + wid * 1024 + lane * 16) = kreg; if (wid < 4) *(LAS v4u*)(lds + (buf) * KB + (8 + wid) * 1024 + lane * 16) = krreg; \
        *(LAS v4u*)(lds + OFF_V + (vslot) * VB + wid * 1024 + lane * 16) = vreg; } while (0)
    LAS float* wsf = (LAS float*)(lds + OFF_WS + wid * 256);
    ATT_LOAD(0); ATT_STORE(0, 0);
    __syncthreads();
    const bool skew = wid >= 4;
    bf16x8 pw[4];
    int vs_cur = 0, vs_prev = 2, vs_next = 1;
#define ATT_PV(vslot) do { const LAS unsigned char* vb_ = lds + OFF_V + (vslot) * VB + hi * 1024 + r32 * 16; \
        _Pragma("unroll") for (int ks = 0; ks < 4; ++ks) { \
            const bf16x8 v0 = *(const LAS bf16x8*)(vb_ + ks * 2048), v1 = *(const LAS bf16x8*)(vb_ + ks * 2048 + 512); \
            o0 = __builtin_amdgcn_mfma_f32_32x32x16_bf16(pw[ks], v0, o0, 0, 0, 0); \
            o1 = __builtin_amdgcn_mfma_f32_32x32x16_bf16(pw[ks], v1, o1, 0, 0, 0); } } while (0)
    float mrow = 0.f, lsum = 0.f;
    f32x16 o0, o1, negm;
#pragma unroll
    for (int r = 0; r < 16; ++r) { o0[r] = 0.f; o1[r] = 0.f; negm[r] = 0.f; }
    for (int kt = 0; kt < NT; ++kt) {
        const int cur = kt & 1;
        if (kt + 1 < NT) ATT_LOAD(kt + 1);
        if (skew && kt >= 1 && kt - 1 < ntw) ATT_PV(vs_prev);
        if (kt < ntw) {
            const LAS unsigned char* kb = lds + cur * KB + hi * 1024 + r32 * 16;
            f32x16 p0, p1;
#pragma unroll
            for (int d0 = 0; d0 < 6; ++d0) {
                const bf16x8 a0 = *(const LAS bf16x8*)(kb + d0 * 2048), a1 = *(const LAS bf16x8*)(kb + d0 * 2048 + 512);
                p0 = __builtin_amdgcn_mfma_f32_32x32x16_bf16(a0, qr[d0], d0 == 0 ? negm : p0, 0, 0, 0);
                p1 = __builtin_amdgcn_mfma_f32_32x32x16_bf16(a1, qr[d0], d0 == 0 ? negm : p1, 0, 0, 0);
            }
            if (64 * kt + 63 > q0w) {
                const int q = q0w + r32, kbase = 64 * kt + 4 * hi;
#pragma unroll
                for (int r = 0; r < 16; ++r) { const int key = kbase + (r & 3) + 8 * (r >> 2); if (key > q) p0[r] = -1e30f; if (key + 32 > q) p1[r] = -1e30f; }
            }
            float mx = fmaxf(p0[0], p1[0]);
#pragma unroll
            for (int r = 1; r < 16; ++r) mx = fmaxf(mx, fmaxf(p0[r], p1[r]));
            mx = fmaxf(mx, __shfl_xor(mx, 32));
            if (kt == 0 || __any(mx > 8.0f)) {
                const float dl = (kt == 0) ? mx : fmaxf(mx, 0.f), alpha = __builtin_amdgcn_exp2f(-dl);
                mrow += dl; lsum *= alpha;
#pragma unroll
                for (int r = 0; r < 16; ++r) { p0[r] -= dl; p1[r] -= dl; negm[r] = -mrow; }
                if (hi == 0) wsf[r32] = alpha;
                LDS_WAIT();
#pragma unroll
                for (int i = 0; i < 4; ++i) { const f32x4 a = *(const LAS f32x4*)(wsf + 8 * i + 4 * hi);
#pragma unroll
                    for (int j = 0; j < 4; ++j) { o0[4 * i + j] *= a[j]; o1[4 * i + j] *= a[j]; } }
            }
            float s = 0.f;
#pragma unroll
            for (int r = 0; r < 16; ++r) { p0[r] = __builtin_amdgcn_exp2f(p0[r]); p1[r] = __builtin_amdgcn_exp2f(p1[r]); s += p0[r] + p1[r]; }
            lsum += s;
#pragma unroll
            for (int ks = 0; ks < 4; ++ks) { v4u w;
                if (ks < 2) { w.x = pk2(p0[8 * ks + 0], p0[8 * ks + 1]); w.y = pk2(p0[8 * ks + 2], p0[8 * ks + 3]); w.z = pk2(p0[8 * ks + 4], p0[8 * ks + 5]); w.w = pk2(p0[8 * ks + 6], p0[8 * ks + 7]); }
                else { const int k2 = ks - 2; w.x = pk2(p1[8 * k2 + 0], p1[8 * k2 + 1]); w.y = pk2(p1[8 * k2 + 2], p1[8 * k2 + 3]); w.z = pk2(p1[8 * k2 + 4], p1[8 * k2 + 5]); w.w = pk2(p1[8 * k2 + 6], p1[8 * k2 + 7]); }
                pw[ks] = __builtin_bit_cast(bf16x8, w); }
            if (!skew) ATT_PV(vs_cur);
        }
        if (kt + 1 < NT) ATT_STORE(cur ^ 1, vs_next);
        { const int t_ = vs_prev; vs_prev = vs_cur; vs_cur = vs_next; vs_next = t_; }
        __syncthreads();
    }
    if (skew && NT - 1 < ntw) ATT_PV(vs_prev);
#undef ATT_PV
    if (ntw > 0) {
        lsum += __shfl_xor(lsum, 32);
        if (hi == 0) wsf[32 + r32] = 1.0f / lsum;
        LDS_WAIT();
        bf16* yp = Y + (rowbase + q0w) * 512 + h * 64 + r32;
#pragma unroll
        for (int i = 0; i < 4; ++i) { const f32x4 a = *(const LAS f32x4*)(wsf + 32 + 8 * i + 4 * hi);
#pragma unroll
            for (int j = 0; j < 4; ++j) { const int r = 4 * i + j, q = crow(r, hi);
                if (q0w + q < T) { const unsigned w = pk2(o0[r] * a[j], o1[r] * a[j]); yp[(size_t)q * 512] = (bf16)(w & 0xffffu); yp[(size_t)q * 512 + 32] = (bf16)(w >> 16); } } }
        LDS_WAIT();
    }
#undef ATT_LOAD
#undef ATT_STORE
}
}

#define GAS __attribute__((address_space(1)))
#ifdef PROBE_SYS_SCOPE
#define XB_SCOPE ""
#else
#define XB_SCOPE "agent"
#endif
#define XB_TMO      128
#define XB_XCNT(j)  (256  + 64 * (j))
#define XB_XSUB(j)  (1280 + 64 * (j))
#define XB_XGEN(j)  (2304 + 64 * (j))
#define XB_TOP      3328
#define XB_TOPGEN   3392
#define XCD_BAR_WORDS 3456
#define XB_SPIN_CAP (1u << 18)

__device__ __forceinline__ unsigned xb_ld(unsigned* p)              { return __hip_atomic_load(p, __ATOMIC_RELAXED, __HIP_MEMORY_SCOPE_AGENT); }
__device__ __forceinline__ unsigned xb_add(unsigned* p, unsigned v) { return __hip_atomic_fetch_add(p, v, __ATOMIC_RELAXED, __HIP_MEMORY_SCOPE_AGENT); }
__device__ __forceinline__ unsigned xb_xcc_id() { return (unsigned)__builtin_amdgcn_s_getreg((3 << 11) | 20) & 0xFu; }
#define XB_SPIN(cond, bar) do { unsigned _sp = 0; while (cond) { __builtin_amdgcn_s_sleep(1); \
    if ((++_sp & 255u) == 0u) { if (xb_ld(&(bar)[XB_TMO])) break; if (_sp > XB_SPIN_CAP) { atomicAdd(&(bar)[XB_TMO], 1u); break; } } } } while (0)

struct XcdBarrier {
    unsigned* bar; unsigned x;
    volatile LAS unsigned* st;
};

__device__ __forceinline__ XcdBarrier xcd_barrier_post(unsigned* bar, volatile LAS unsigned* st) {
    XcdBarrier b; b.bar = bar; b.x = xb_xcc_id(); b.st = st;
    if (threadIdx.x == 0) (void)xb_add(&bar[XB_XCNT(b.x)], 1u);
    return b;
}
__device__ __forceinline__ void xcd_barrier_complete(unsigned* bar, unsigned x, unsigned& nloc, unsigned& nx) {
    const unsigned G = gridDim.x * gridDim.y * gridDim.z;
    unsigned sum, cnt, mine, sp = 0u;
    for (;;) {
        sum = 0u; cnt = 0u; mine = 0u;
#pragma unroll
        for (unsigned j = 0; j < 16; ++j) { const unsigned c = xb_ld(&bar[XB_XCNT(j)]); sum += c; cnt += (c > 0u) ? 1u : 0u; mine = (j == x) ? c : mine; }
        if (sum == G) break;
        __builtin_amdgcn_s_sleep(1);
        if ((++sp & 255u) == 0u) { if (xb_ld(&bar[XB_TMO])) break; if (sp > XB_SPIN_CAP) { atomicAdd(&bar[XB_TMO], 1u); break; } }
    }
    nloc = mine > 0u ? mine : 1u; nx = cnt > 0u ? cnt : 1u;
}

__device__ __forceinline__ void xcd_barrier(const XcdBarrier& b) {
    asm volatile("s_waitcnt vmcnt(0)" ::: "memory");
    __syncthreads();
    if (threadIdx.x == 0) {
        unsigned* bar = b.bar;
        __builtin_amdgcn_s_waitcnt(0);
        unsigned nloc = b.st[0], nx = b.st[1];
        if (nloc == 0u) { xcd_barrier_complete(bar, b.x, nloc, nx); b.st[0] = nloc; b.st[1] = nx; }
        const unsigned old = xb_add(&bar[XB_XSUB(b.x)], 1u);
        const unsigned gen = old / nloc;
        if (old + 1u == (gen + 1u) * nloc) {
            __builtin_amdgcn_fence(__ATOMIC_RELEASE, XB_SCOPE);
            asm volatile("s_waitcnt vmcnt(0)" ::: "memory");
            const unsigned og = xb_add(&bar[XB_TOP], 1u);
            const unsigned tg = og / nx;
            if (og + 1u == (tg + 1u) * nx) xb_add(&bar[XB_TOPGEN], 1u);
            else XB_SPIN(xb_ld(&bar[XB_TOPGEN]) == tg, bar);
            __builtin_amdgcn_fence(__ATOMIC_ACQUIRE, XB_SCOPE);
            xb_add(&bar[XB_XGEN(b.x)], 1u);
            asm volatile("s_waitcnt vmcnt(0)" ::: "memory");
        } else {
            XB_SPIN(xb_ld(&bar[XB_XGEN(b.x)]) == gen, bar);
            __builtin_amdgcn_fence(__ATOMIC_ACQUIRE, XB_SCOPE);
            asm volatile("s_waitcnt vmcnt(0)" ::: "memory");
        }
    }
    __syncthreads();
}

struct Args { const float* in[18]; float* out; unsigned char* ws; };
static_assert(sizeof(Args) == 160, "Args layout");

__global__ void __launch_bounds__(NWAVES * 64, 2) mega_fwd(Args args) {
    extern __shared__ __attribute__((aligned(16))) unsigned char lds_raw[];
    cg::grid_group grid = cg::this_grid();
    LAS unsigned char* lds = (LAS unsigned char*)lds_raw;
    int tid = threadIdx.x, lane = tid & 63; const int wave = __builtin_amdgcn_readfirstlane(tid >> 6);
#define GRID_SYNC() do { XcdBarrier xb_; xb_.bar = ctl + 4096; xb_.x = xb_xcc_id(); xb_.st = (volatile LAS unsigned*)(lds + LDS_MISC) + 8; xcd_barrier(xb_); REBASE(); } while (0)
#define OPQ() do { asm volatile("" : "+v"(tid)); lane = tid & 63; } while (0)
    const int G = gridDim.x, blk = blockIdx.x;
    const int gw = blk * NWAVES + wave, ngw = G * NWAVES;
    const unsigned char* ka = (const unsigned char*)__builtin_amdgcn_kernarg_segment_ptr();
    unsigned char* ws = args.ws;
#define REBASE() do { asm volatile("" : "+s"(ka)); asm volatile("" : "+s"(ws)); } while (0)
#define INP(i) (*(const float* const*)(ka + 8 * (i)))
#define X_IN INP(0)
#define meta INP(1)
#define ffn1_up INP(2)
#define ffn1_down INP(3)
#define w_in INP(4)
#define b_gate INP(5)
#define conv_w INP(6)
#define q_norm_g INP(7)
#define w_uq INP(8)
#define kv_norm_g INP(9)
#define w_ukv INP(10)
#define w_br_conv INP(11)
#define w_br_mla INP(12)
#define w_o INP(13)
#define ffn2_up INP(14)
#define ffn2_down INP(15)
#define ln_g INP(16)
#define ln_b INP(17)
#define OUTP (*(float* const*)(ka + 144))
#define ctl ((unsigned*)(ws + OFF_CTL))
#define rope ((float*)(ws + OFF_ROPE))
#define hf ((float*)(ws + OFF_HF))
#define wreg (ws + OFF_W)
#define hb ((bf16*)(ws + S_HB))
#define act ((bf16*)(ws + S_ACT))
#define gates ((bf16*)(ws + S_GATES))
#define bch ((bf16*)(ws + S_BCH))
#define lat ((float*)(ws + S_LAT))
#define yconv ((bf16*)(ws + S_YCONV))
#define cqn ((bf16*)(ws + S_CQN))
#define ckvn ((bf16*)(ws + S_CKVN))
#define krb ((bf16*)(ws + S_KR))
#define Qb ((bf16*)(ws + S_Q))
#define Knb ((bf16*)(ws + S_KN))
#define Vtb ((bf16*)(ws + S_VT))
#define ymla ((bf16*)(ws + S_YMLA))
#define merged ((bf16*)(ws + S_MERGED))
    LAS float* scr = (LAS float*)(lds + wave * 16384);
    LAS unsigned char* ring = lds;
    if (threadIdx.x < 64) ((LAS unsigned*)(lds + LDS_MISC))[threadIdx.x] = 0u;
    __syncthreads();
    (void)xcd_barrier_post(ctl + 4096, (volatile LAS unsigned*)(lds + LDS_MISC) + 8);
    grid.sync();

#ifdef PROBE_DUMP_BIAS
    OPQ();
    for (int row = gw; row < BATCH * SEQ; row += ngw) { float* o = OUTP + (size_t)row * 1024; for (int c = lane; c < 1024; c += 64) o[c] = b_gate[c] + 2.0f * b_gate[1024 + c] + 4.0f * b_gate[2048 + c] + 8.0f * b_gate[3072 + c]; }
    return;
#endif
    OPQ();
    for (int row = gw; row < MPAD; row += ngw) {
        f32x4 v[4];
        if (row < M) { const int b = row / T, t = row - b * T; const f32x4* src = (const f32x4*)(t < N_META ? meta + (size_t)t * 1024 : X_IN + ((size_t)b * SEQ + (t - N_META)) * 1024) + lane;
#pragma unroll
            for (int j = 0; j < 4; ++j) v[j] = src[64 * j]; }
        else {
#pragma unroll
            for (int j = 0; j < 4; ++j) v[j] = (f32x4){0.f, 0.f, 0.f, 0.f}; }
#pragma unroll
        for (int j = 0; j < 4; ++j) { ((f32x4*)(hf + (size_t)row * 1024))[lane + 64 * j] = v[j]; v2u w; w.x = pk2(v[j].x, v[j].y); w.y = pk2(v[j].z, v[j].w); ((v2u*)(hb + (size_t)row * 1024))[lane + 64 * j] = w; }
    }
    for (int i = blk * 512 + tid; i < T * 16; i += G * 512) { const int t = i >> 4, k = i & 15;
        const float inv_freq = inv_freq_of(k); const float ang = (float)t * inv_freq;
        const double rev = (double)ang * 0.15915494309189535; const float fr = (float)(rev - floor(rev));
        rope[t * 32 + k] = __builtin_amdgcn_cosf(fr); rope[t * 32 + 16 + k] = __builtin_amdgcn_sinf(fr); }
    convert_ffn(ffn1_up, ffn1_down, wreg, scr, gw, ngw, lane);
    GRID_SYNC();

    for (int step = 0; step < 3 * DEPTH; ++step) {
        const int l = step / 3, sub = step % 3;
#ifdef PROBE_STEPS
        if (step == PROBE_STEPS) {
            OPQ();
            for (int row = gw; row < M; row += ngw) { const int b = row / T, t = row - b * T; if (t >= N_META) {
#pragma unroll
                for (int j = 0; j < 4; ++j) ((f32x4*)(OUTP + ((size_t)b * SEQ + (t - N_META)) * 1024))[lane + 64 * j] = ((const f32x4*)(hf + (size_t)row * 1024))[lane + 64 * j]; } }
            return;
        }
#endif
        if (sub != 1) {
            { pg8::Gemm g{hb, (const bf16*)(wreg + W_UP), MPAD, 2 * D_FF, 1024}; pg8::StaticOrder S; S.init(MPAD, 2 * D_FF, G, blk);
              pg8::EpiSwiGLU E{act, D_FF};
              pg8::gemm_phase<pg8::EpiSwiGLU, pg8::StaticOrder, true, true>(ring, g, S, E); }
            GRID_SYNC();
            { pg8::Gemm g{act, (const bf16*)(wreg + W_DOWN), MPAD, 1024, D_FF}; pg8::StaticOrder S; S.init(MPAD, 1024, G, blk);
              pg8::EpiResid E{hf, ALPHA, 0.5f};
              pg8::gemm_phase<pg8::EpiResid, pg8::StaticOrder, true, true>(ring, g, S, E); }
            GRID_SYNC();
            OPQ();
            const int li = (sub == 0) ? 0 : 2; const float* lg = ln_g + ((size_t)l * 3 + li) * 1024; const float* lb = ln_b + ((size_t)l * 3 + li) * 1024;
            const bool final_ln = (step == 3 * DEPTH - 1);
            for (int row = gw; row < MPAD; row += ngw) {
                if (!final_ln) ln_row(hf + (size_t)row * 1024, lg, lb, hf + (size_t)row * 1024, hb + (size_t)row * 1024, lane);
                else if (row < M) { const int b = row / T, t = row - b * T; if (t >= N_META) ln_row(hf + (size_t)row * 1024, lg, lb, OUTP + ((size_t)b * SEQ + (t - N_META)) * 1024, nullptr, lane); }
            }
            if (sub == 0) convert_mixer(w_in + (size_t)l * 1024 * D_IN, w_uq + (size_t)l * 256 * 768, w_ukv + (size_t)l * 128 * 1024, w_br_conv + (size_t)l * 512 * 1024, w_br_mla + (size_t)l * 512 * 1024, w_o + (size_t)l * 1024 * 1024, wreg, scr, gw, ngw, lane);
            else if (!final_ln) convert_ffn(ffn1_up + (size_t)(l + 1) * 1024 * 2 * D_FF, ffn1_down + (size_t)(l + 1) * D_FF * 1024, wreg, scr, gw, ngw, lane);
            if (!final_ln) GRID_SYNC();
        } else {
#ifdef PROBE_DUMP_BIAS1
            OPQ();
            for (int row = gw; row < BATCH * SEQ; row += ngw) { float* o = OUTP + (size_t)row * 1024; for (int c = lane; c < 1024; c += 64) o[c] = b_gate[c] + 2.0f * b_gate[1024 + c] + 4.0f * b_gate[2048 + c] + 8.0f * b_gate[3072 + c]; }
            return;
#endif
            { pg8::Gemm g{hb, (const bf16*)(wreg + W_IN), MPAD, D_INP, 1024}; pg8::StaticOrder S; S.init(MPAD, D_INP, G, blk);
              pg8::EpiInProj E{bch, lat, gates, b_gate + (size_t)l * 2048};
              pg8::gemm_phase<pg8::EpiInProj, pg8::StaticOrder, true, true>(ring, g, S, E); }
            GRID_SYNC();
#ifdef PROBE_DUMP_GATES0
            OPQ();
            for (int row = gw; row < M; row += ngw) { const int b = row / T, t = row - b * T; if (t >= N_META) { float* o = OUTP + ((size_t)b * SEQ + (t - N_META)) * 1024;
                for (int c = lane; c < 1024; c += 64) o[c] = pg8::bf_lo(gates[(size_t)row * 2048 + c]) + 2.0f * pg8::bf_lo(gates[(size_t)row * 2048 + 1024 + c]); } }
            return;
#endif
            OPQ();
            { const float* cw = conv_w + (size_t)l * 3 * 512; const float* qg = q_norm_g + (size_t)l * 256; const float* kg = kv_norm_g + (size_t)l * 128;
              for (int row = gw; row < MPAD; row += ngw) {
                int rr = row < M ? row : M - 1; const int b = rr / T, t = rr - b * T;
                f32x4 ua[2] = {(f32x4){0.f, 0.f, 0.f, 0.f}, (f32x4){0.f, 0.f, 0.f, 0.f}};
#pragma unroll
                for (int k = 0; k < 3; ++k) { const int dt = 2 - k;
                    if (t - dt >= 0 && row < M) { const bf16* rp = bch + (size_t)(row - dt) * 1536 + 8 * lane; const v4u c = *(const v4u*)(rp + 512), hh = *(const v4u*)(rp + 1024);
                        const f32x4 w0 = *(const f32x4*)(cw + k * 512 + 8 * lane), w1 = *(const f32x4*)(cw + k * 512 + 8 * lane + 4);
                        ua[0][0] += w0[0] * pg8::bf_lo(c.x) * pg8::bf_lo(hh.x); ua[0][1] += w0[1] * pg8::bf_hi(c.x) * pg8::bf_hi(hh.x);
                        ua[0][2] += w0[2] * pg8::bf_lo(c.y) * pg8::bf_lo(hh.y); ua[0][3] += w0[3] * pg8::bf_hi(c.y) * pg8::bf_hi(hh.y);
                        ua[1][0] += w1[0] * pg8::bf_lo(c.z) * pg8::bf_lo(hh.z); ua[1][1] += w1[1] * pg8::bf_hi(c.z) * pg8::bf_hi(hh.z);
                        ua[1][2] += w1[2] * pg8::bf_lo(c.w) * pg8::bf_lo(hh.w); ua[1][3] += w1[3] * pg8::bf_hi(c.w) * pg8::bf_hi(hh.w); } }
                { const v4u bb = *(const v4u*)(bch + (size_t)row * 1536 + 8 * lane);
                  v4u o; o.x = pk2(ua[0][0] * pg8::bf_lo(bb.x), ua[0][1] * pg8::bf_hi(bb.x)); o.y = pk2(ua[0][2] * pg8::bf_lo(bb.y), ua[0][3] * pg8::bf_hi(bb.y));
                  o.z = pk2(ua[1][0] * pg8::bf_lo(bb.z), ua[1][1] * pg8::bf_hi(bb.z)); o.w = pk2(ua[1][2] * pg8::bf_lo(bb.w), ua[1][3] * pg8::bf_hi(bb.w));
                  *(v4u*)(yconv + (size_t)row * 512 + 8 * lane) = o; }
                const float* lr = lat + (size_t)row * 512;
                { const f32x4 v = *(const f32x4*)(lr + 4 * lane); const float ss = wave_sum((v.x * v.x + v.y * v.y) + (v.z * v.z + v.w * v.w));
                  const float rs = 1.f / sqrtf(ss * (1.f / 256.f) + RMS_EPS); const f32x4 gg = *(const f32x4*)(qg + 4 * lane);
                  v2u w; w.x = pk2(v.x * rs * gg.x, v.y * rs * gg.y); w.y = pk2(v.z * rs * gg.z, v.w * rs * gg.w); *(v2u*)(cqn + (size_t)row * 256 + 4 * lane) = w; }
                { const f32x2 v = *(const f32x2*)(lr + 256 + 2 * lane); const float ss = wave_sum(v.x * v.x + v.y * v.y);
                  const float rs = 1.f / sqrtf(ss * (1.f / 128.f) + RMS_EPS); const f32x2 gg = *(const f32x2*)(kg + 2 * lane);
                  *(unsigned*)(ckvn + (size_t)row * 256 + 2 * lane) = pk2(v.x * rs * gg.x, v.y * rs * gg.y); *(unsigned*)(ckvn + (size_t)row * 256 + 128 + 2 * lane) = 0u; }
                if (lane < 16) { const float x1 = lr[384 + lane], x2 = lr[400 + lane], cs = rope[t * 32 + lane], sn = rope[t * 32 + 16 + lane];
                  const unsigned w = pk2(x1 * cs - x2 * sn, x2 * cs + x1 * sn); krb[(size_t)row * 32 + lane] = (bf16)(w & 0xffffu); krb[(size_t)row * 32 + 16 + lane] = (bf16)(w >> 16); }
              } }
            GRID_SYNC();
#ifdef PROBE_DUMP_GATES
            OPQ();
            for (int row = gw; row < M; row += ngw) { const int b = row / T, t = row - b * T; if (t >= N_META) { float* o = OUTP + ((size_t)b * SEQ + (t - N_META)) * 1024;
                for (int c = lane; c < 1024; c += 64) o[c] = pg8::bf_lo(gates[(size_t)row * 2048 + c]) + 2.0f * pg8::bf_lo(gates[(size_t)row * 2048 + 1024 + c]); } }
            return;
#endif
#ifdef PROBE_DUMP_ROWPREP
            OPQ();
            for (int row = gw; row < M; row += ngw) { const int b = row / T, t = row - b * T; if (t >= N_META) { float* o = OUTP + ((size_t)b * SEQ + (t - N_META)) * 1024;
                for (int c = lane; c < 1024; c += 64) { float v = 0.f;
                    if (c < 512) v = pg8::bf_lo(yconv[(size_t)row * 512 + c]); else if (c < 768) v = pg8::bf_lo(cqn[(size_t)row * 256 + c - 512]); else if (c < 896) v = pg8::bf_lo(ckvn[(size_t)row * 256 + c - 768]); else if (c < 928) v = pg8::bf_lo(krb[(size_t)row * 32 + c - 896]);
                    else if (c < 960) v = lat[(size_t)row * 512 + 384 + c - 928];
                    o[c] = v; } } }
            return;
#endif
            OPQ();
            for (int i = blk * 512 + tid; i < BATCH * NHEAD * 64 * (TP - T); i += G * 512) { const int r = i / (TP - T), c = i % (TP - T); Vtb[(size_t)r * TP + T + c] = 0; }
            { pg8::Gemm g{cqn, (const bf16*)(wreg + W_UQ), MPAD, 768, 256}; pg8::StaticOrder S; S.init(MPAD, 768, G, blk);
              pg8::EpiPlain E{Qb, 768, QSCALE};
              pg8::gemm_phase<pg8::EpiPlain, pg8::StaticOrder, true, true>(ring, g, S, E); }
            { pg8::Gemm g{ckvn, (const bf16*)(wreg + W_UKV), MPAD, 512, 256}; pg8::StaticOrder S; S.init(MPAD, 512, G, blk);
              pg8::EpiPlain E{Knb, 512, 1.0f};
              pg8::gemm_phase<pg8::EpiPlain, pg8::StaticOrder, true, true>(ring, g, S, E); }
            { pg8::Gemm g{(const bf16*)(wreg + W_UKV) + 512 * 256, ckvn, 512, MPAD, 256}; pg8::StaticOrder S; S.init(512, MPAD, G, blk);
              pg8::EpiVt E{Vtb};
              pg8::gemm_phase<pg8::EpiVt, pg8::StaticOrder, true, true>(ring, g, S, E); }
            GRID_SYNC();
            OPQ();
#ifdef PROBE_NOATTN
            for (size_t i = (size_t)blk * 512 + tid; i < (size_t)MPAD * 512 / 8; i += (size_t)G * 512) ((v4u*)ymla)[i] = (v4u){0u, 0u, 0u, 0u};
            if (false)
#endif
#ifdef PROBE_ATTN_TWICE
            for (int rep = 0; rep < 2; ++rep)
            { const int grp = blk & 7; unsigned* qctr = ctl + 64 * (rep * 16 + l * 8 + grp);
#else
            { const int grp = blk & 7; unsigned* qctr = ctl + 64 * (l * 8 + grp);
#endif
              volatile LAS unsigned* bc = (volatile LAS unsigned*)(lds + LDS_MISC);
              for (;;) {
                  if (tid == 0) bc[0] = atomicAdd(qctr, 1u);
                  __syncthreads();
                  const unsigned u = bc[0];
                  __syncthreads();
                  if (u >= 132u) break;
                  const int qb = 32 - (int)(u >> 2), bh = grp * 4 + (int)(u & 3u);
                  att::attn_unit(bh >> 3, bh & 7, qb, Qb, Knb, krb, Vtb, rope, ymla, lds);
              } }
            GRID_SYNC();
            { pg8::Gemm g{yconv, (const bf16*)(wreg + W_BC), MPAD, 1024, 512}; pg8::StaticOrder S; S.init(MPAD, 1024, G, blk);
              pg8::EpiGate<false> E{merged, gates};
              pg8::gemm_phase<pg8::EpiGate<false>, pg8::StaticOrder, true, true>(ring, g, S, E); }
#ifdef PROBE_SYNC_BETWEEN
            GRID_SYNC();
#endif
#ifndef PROBE_SKIP_BR2
            { pg8::Gemm g{ymla, (const bf16*)(wreg + W_BM), MPAD, 1024, 512}; pg8::StaticOrder S; S.init(MPAD, 1024, G, blk);
              pg8::EpiGate<true> E{merged, gates + 1024};
              pg8::gemm_phase<pg8::EpiGate<true>, pg8::StaticOrder, true, true>(ring, g, S, E); }
#endif
            GRID_SYNC();
#ifdef PROBE_DUMP_MERGED
            OPQ();
            for (int row = gw; row < M; row += ngw) { const int b = row / T, t = row - b * T; if (t >= N_META) { float* o = OUTP + ((size_t)b * SEQ + (t - N_META)) * 1024;
                for (int c = lane; c < 1024; c += 64) o[c] = pg8::bf_lo(merged[(size_t)row * 1024 + c]); } }
            return;
#endif
            { pg8::Gemm g{merged, (const bf16*)(wreg + W_O), MPAD, 1024, 1024}; pg8::StaticOrder S; S.init(MPAD, 1024, G, blk);
              pg8::EpiResid E{hf, ALPHA, 1.0f};
              pg8::gemm_phase<pg8::EpiResid, pg8::StaticOrder, true, true>(ring, g, S, E); }
            GRID_SYNC();
            OPQ();
            { const float* lg = ln_g + ((size_t)l * 3 + 1) * 1024; const float* lb = ln_b + ((size_t)l * 3 + 1) * 1024;
              for (int row = gw; row < MPAD; row += ngw) ln_row(hf + (size_t)row * 1024, lg, lb, hf + (size_t)row * 1024, hb + (size_t)row * 1024, lane);
              convert_ffn(ffn2_up + (size_t)l * 1024 * 2 * D_FF, ffn2_down + (size_t)l * D_FF * 1024, wreg, scr, gw, ngw, lane); }
            GRID_SYNC();
        }
    }
}

extern "C" void kernel_launch(void* const* d_in, const int* in_sizes, int n_in, void* d_out, int out_size, void* d_ws, size_t ws_size, hipStream_t stream) {
    static int grid = 0;
    if (grid == 0) {
        if (n_in != 18 || ws_size < WS_NEED) { fprintf(stderr, "kernel_launch: expected 18 inputs and >= %zu bytes of workspace; got %d, %zu\n", (size_t)WS_NEED, n_in, ws_size); grid = -1; return; }
        int dev = 0, cus = 0, per_cu = 0;
        hipGetDevice(&dev); hipDeviceGetAttribute(&cus, hipDeviceAttributeMultiprocessorCount, dev);
        if (hipFuncSetAttribute((const void*)mega_fwd, hipFuncAttributeMaxDynamicSharedMemorySize, LDS_BYTES) != hipSuccess) { fprintf(stderr, "kernel_launch: hipFuncSetAttribute failed\n"); grid = -1; return; }
        hipOccupancyMaxActiveBlocksPerMultiprocessor(&per_cu, (const void*)mega_fwd, NWAVES * 64, LDS_BYTES);
        (void)hipGetLastError();
        if (per_cu < 1) per_cu = 1;
        grid = cus;
    }
    if (grid < 0) return;
    (void)hipMemsetAsync((char*)d_ws + OFF_CTL, 0, 65536, stream);
    Args a{};
    for (int i = 0; i < 18; ++i) a.in[i] = (const float*)d_in[i];
    a.out = (float*)d_out; a.ws = (unsigned char*)d_ws;
    void* params[] = {&a};
    hipError_t e = hipLaunchCooperativeKernel((const void*)mega_fwd, dim3(grid), dim3(NWAVES * 64), params, LDS_BYTES, stream);
    if (e != hipSuccess) fprintf(stderr, "cooperative launch failed: %s (grid %d)\n", hipGetErrorString(e), grid);
}
```

```cpp
#include <hip/hip_runtime.h>
#include <cstdio>
#include <cstdint>
namespace pg8 {
#define PG8_LAS __attribute__((address_space(3)))
typedef unsigned short bf16_t;
typedef short bf16x8 __attribute__((ext_vector_type(8)));
typedef float f32x4 __attribute__((ext_vector_type(4)));
typedef unsigned u32x4 __attribute__((ext_vector_type(4)));
constexpr int BM = 256, BK = 64, HALF = 128, HTB = HALF * BK * 2  , STAGE_BYTES = 8 * HTB, NXCD = 8, WGM = 8;

__host__ __device__ __forceinline__ int lds_byte(int r, int c) { const int st = (r >> 4) * 2 + (c >> 5), rr = r & 15, cc = c & 31, ob = rr * 64 + cc * 2; return st * 1024 + (ob ^ (((ob >> 9) & 1) << 5)); }
__host__ __device__ __forceinline__ void stage_rc(int b, int& R, int& C) { const int st = b / 1024, sb = b % 1024, swz = sb ^ (((sb >> 9) & 1) << 5); R = (st >> 1) * 16 + swz / 64; C = (st & 1) * 32 + (swz % 64) / 2; }
__host__ __device__ __forceinline__ int perm32(int rho) { const int n = rho >> 4, i = rho & 15; return 8 * (i >> 2) + 4 * n + (i & 3); }

struct Unit { int pm, pn; };
struct Gemm { const bf16_t* A; const bf16_t* Bt; int M, N, K; };

struct StaticOrder {
    int nM, nN, nwg, G, c;
    __host__ __device__ void init(int M, int N, int G_, int c_) { nM = M / BM; nN = N / BM; nwg = nM * nN; G = G_; c = c_; }
    __host__ __device__ bool next(int i, Unit& u) const {
        const long L = (long)i * G + c; if (L >= nwg) return false;
        int wgid = (int)L; { const int q = nwg / NXCD, r = nwg % NXCD, xcd = wgid % NXCD, off = wgid / NXCD; wgid = (xcd < r ? xcd * (q + 1) : r * (q + 1) + (xcd - r) * q) + off; }
        const int nig = WGM * nN, gid = wgid / nig, fm = gid * WGM, gsz = (nM - fm) < WGM ? (nM - fm) : WGM;
        u.pm = fm + ((wgid % nig) % gsz); u.pn = (wgid % nig) / gsz; return true;
    }
    __device__ __forceinline__ void a_ready(const Unit&) const {}
    __device__ __forceinline__ void done(const Unit&) const {}
};

struct SignalOrder : StaticOrder {
    unsigned* tot_main; unsigned* tot_tail;
    __device__ __forceinline__ void done(const Unit& u) const {
        asm volatile("s_waitcnt vmcnt(0)" ::: "memory");
        if ((threadIdx.x & 63) == 0) __hip_atomic_fetch_add(u.pm < 128 ? tot_main : tot_tail, 1u, __ATOMIC_RELAXED, __HIP_MEMORY_SCOPE_AGENT);
    }
};
typedef float f32x2 __attribute__((ext_vector_type(2)));
typedef __bf16 bf16x2_cv __attribute__((ext_vector_type(2)));
__device__ __forceinline__ unsigned cvt_pk_bf16(float lo, float hi) { f32x2 v = {lo, hi}; bf16x2_cv b = __builtin_convertvector(v, bf16x2_cv); return __builtin_bit_cast(unsigned, b); }
__device__ __forceinline__ float fast_sigmoid(float x) { return __builtin_amdgcn_rcpf(1.0f + __builtin_amdgcn_exp2f(-1.4426950408889634f * x)); }
__device__ __forceinline__ u32x4 pack8(const f32x4 a, const f32x4 b) { u32x4 w; w.x = cvt_pk_bf16(a[0], a[1]); w.y = cvt_pk_bf16(a[2], a[3]); w.z = cvt_pk_bf16(b[0], b[1]); w.w = cvt_pk_bf16(b[2], b[3]); return w; }
typedef unsigned u32x2 __attribute__((ext_vector_type(2)));
__device__ __forceinline__ float bf_lo(unsigned w) { return __uint_as_float(w << 16); }
__device__ __forceinline__ float bf_hi(unsigned w) { return __uint_as_float(w & 0xffff0000u); }

struct EpiSwiGLU {
    static constexpr bool PERM = true, AFTER_DRAIN = false;
    bf16_t* O; int ldc;
    __device__ __forceinline__ void operator()(const f32x4 (&acc)[2][2][4][2], const Unit& u, int wr, int wc, int fr, int fq) const {
        const int row0 = u.pm * BM + wr * 64 + fr; const int col0 = u.pn * 128 + wc * 32 + 8 * fq;
#pragma unroll
        for (int ai = 0; ai < 2; ++ai)
#pragma unroll
            for (int m = 0; m < 4; ++m) {
                f32x4 v[2];
#pragma unroll
                for (int n = 0; n < 2; ++n) { const f32x4 g = acc[ai][0][m][n], up = acc[ai][1][m][n];
#pragma unroll
                    for (int j = 0; j < 4; ++j) v[n][j] = g[j] * fast_sigmoid(g[j]) * up[j]; }
                *(u32x4*)(O + (size_t)(row0 + ai * HALF + m * 16) * ldc + col0) = pack8(v[0], v[1]);
            }
    }
};
__device__ __forceinline__ void st_wt(float* p, const f32x4 v) { asm volatile("global_store_dwordx4 %0, %1, off sc0 sc1" :: "v"(p), "v"(v) : "memory"); }
struct EpiResid {
    static constexpr bool PERM = true, AFTER_DRAIN = false, WT = false;
    float* H; float alpha, coef;
    __device__ __forceinline__ void operator()(const f32x4 (&acc)[2][2][4][2], const Unit& u, int wr, int wc, int fr, int fq) const {
        const int row0 = u.pm * BM + wr * 64 + fr; const int col0 = u.pn * BM + wc * 32 + 8 * fq;
#pragma unroll
        for (int ai = 0; ai < 2; ++ai)
#pragma unroll
            for (int m = 0; m < 4; ++m) {
                float* rp = H + (size_t)(row0 + ai * HALF + m * 16) * 1024 + col0;
#pragma unroll
                for (int bj = 0; bj < 2; ++bj) {
                    f32x4 a = *(const f32x4*)(rp + bj * HALF), b = *(const f32x4*)(rp + bj * HALF + 4);
                    a = a * alpha + acc[ai][bj][m][0] * coef; b = b * alpha + acc[ai][bj][m][1] * coef;
                    if (WT) { st_wt(rp + bj * HALF, a); st_wt(rp + bj * HALF + 4, b); } else { *(f32x4*)(rp + bj * HALF) = a; *(f32x4*)(rp + bj * HALF + 4) = b; }
                }
            }
    }
};
struct EpiInProj {
    static constexpr bool PERM = true, AFTER_DRAIN = false;
    bf16_t* bch; float* lat; bf16_t* gates; const float* bgate;
    __device__ __forceinline__ void operator()(const f32x4 (&acc)[2][2][4][2], const Unit& u, int wr, int wc, int fr, int fq) const {
        const int row0 = u.pm * BM + wr * 64 + fr; const int cw = wc * 32 + 8 * fq; const int pn = u.pn;
        if (pn < 6) {
#pragma unroll
            for (int ai = 0; ai < 2; ++ai)
#pragma unroll
                for (int m = 0; m < 4; ++m) { bf16_t* rp = bch + (size_t)(row0 + ai * HALF + m * 16) * 1536 + pn * BM + cw;
#pragma unroll
                    for (int bj = 0; bj < 2; ++bj) *(u32x4*)(rp + bj * HALF) = pack8(acc[ai][bj][m][0], acc[ai][bj][m][1]); }
        } else if (pn < 8) {
#pragma unroll
            for (int ai = 0; ai < 2; ++ai)
#pragma unroll
                for (int m = 0; m < 4; ++m) { float* rp = lat + (size_t)(row0 + ai * HALF + m * 16) * 512 + (pn - 6) * BM + cw;
#pragma unroll
                    for (int bj = 0; bj < 2; ++bj) { *(f32x4*)(rp + bj * HALF) = acc[ai][bj][m][0]; *(f32x4*)(rp + bj * HALF + 4) = acc[ai][bj][m][1]; } }
        } else {
            const int gc = (pn - 8) * BM + cw;
            f32x4 bv[2][2];
#pragma unroll
            for (int bj = 0; bj < 2; ++bj)
#pragma unroll
                for (int n = 0; n < 2; ++n) bv[bj][n] = *(const f32x4*)(bgate + gc + bj * HALF + 4 * n);
#pragma unroll
            for (int ai = 0; ai < 2; ++ai)
#pragma unroll
                for (int m = 0; m < 4; ++m) { bf16_t* rp = gates + (size_t)(row0 + ai * HALF + m * 16) * 2048 + gc;
#pragma unroll
                    for (int bj = 0; bj < 2; ++bj) { f32x4 v[2];
#pragma unroll
                        for (int n = 0; n < 2; ++n) {
#ifdef PROBE_NO_BIAS
                            const f32x4 x = acc[ai][bj][m][n];
#else
                            const f32x4 x = acc[ai][bj][m][n] + bv[bj][n];
#endif
#pragma unroll
                            for (int j = 0; j < 4; ++j) {
#ifdef PROBE_PLAIN_GATES
                                v[n][j] = acc[ai][bj][m][n][j];
#elif defined(PROBE_BV_GATES)
                                v[n][j] = bv[bj][n][j] * 16.0f;
#else
                                v[n][j] = fast_sigmoid(x[j]);
#endif
                            } }
                        *(u32x4*)(rp + bj * HALF) = pack8(v[0], v[1]); } }
        }
    }
};
struct EpiPlain {
    static constexpr bool PERM = true, AFTER_DRAIN = false;
    bf16_t* O; int ldc; float scale;
    __device__ __forceinline__ void operator()(const f32x4 (&acc)[2][2][4][2], const Unit& u, int wr, int wc, int fr, int fq) const {
        const int row0 = u.pm * BM + wr * 64 + fr; const int col0 = u.pn * BM + wc * 32 + 8 * fq;
#pragma unroll
        for (int ai = 0; ai < 2; ++ai)
#pragma unroll
            for (int m = 0; m < 4; ++m) { bf16_t* rp = O + (size_t)(row0 + ai * HALF + m * 16) * ldc + col0;
#pragma unroll
                for (int bj = 0; bj < 2; ++bj) *(u32x4*)(rp + bj * HALF) = pack8(acc[ai][bj][m][0] * scale, acc[ai][bj][m][1] * scale); }
    }
};
struct EpiVt {
    static constexpr bool PERM = false, AFTER_DRAIN = false;
    bf16_t* Vt;
    __device__ __forceinline__ void operator()(const f32x4 (&acc)[2][2][4][2], const Unit& u, int wr, int wc, int fr, int fq) const {
        constexpr int T_ = 8208, TP_ = 8320, M_ = 4 * 8208;
        const int feat0 = u.pm * BM + wr * 64 + fr; const int pos = 8 * (fq & 1) + 4 * (fq >> 1);
#pragma unroll
        for (int bj = 0; bj < 2; ++bj)
#pragma unroll
            for (int n = 0; n < 2; ++n) {
                const int tok0 = u.pn * BM + bj * HALF + wc * 32 + n * 16;
                if (tok0 < M_) {
                    const int b = tok0 / T_, t0 = tok0 - b * T_;
                    bf16_t* vp = Vt + ((size_t)b * 512 + feat0) * TP_ + t0 + pos;
#pragma unroll
                    for (int ai = 0; ai < 2; ++ai)
#pragma unroll
                        for (int m = 0; m < 4; ++m) { const f32x4 x = acc[ai][bj][m][n]; u32x2 w; w.x = cvt_pk_bf16(x[0], x[1]); w.y = cvt_pk_bf16(x[2], x[3]);
                            *(u32x2*)(vp + (size_t)(ai * HALF + m * 16) * TP_) = w; }
                }
            }
    }
};
template <bool ACCUM> struct EpiGate {
    static constexpr bool PERM = true, AFTER_DRAIN = false;
    bf16_t* O; const bf16_t* G;
    __device__ __forceinline__ void operator()(const f32x4 (&acc)[2][2][4][2], const Unit& u, int wr, int wc, int fr, int fq) const {
        const int row0 = u.pm * BM + wr * 64 + fr; const int col0 = u.pn * BM + wc * 32 + 8 * fq;
#pragma unroll
        for (int ai = 0; ai < 2; ++ai)
#pragma unroll
            for (int m = 0; m < 4; ++m) { const size_t row = (size_t)(row0 + ai * HALF + m * 16);
#pragma unroll
                for (int bj = 0; bj < 2; ++bj) {
                    const u32x4 g = *(const u32x4*)(G + row * 2048 + col0 + bj * HALF);
                    f32x4 a = acc[ai][bj][m][0], b = acc[ai][bj][m][1];
                    a[0] *= bf_lo(g.x); a[1] *= bf_hi(g.x); a[2] *= bf_lo(g.y); a[3] *= bf_hi(g.y);
                    b[0] *= bf_lo(g.z); b[1] *= bf_hi(g.z); b[2] *= bf_lo(g.w); b[3] *= bf_hi(g.w);
                    bf16_t* op = O + row * 1024 + col0 + bj * HALF;
                    if (ACCUM) { const u32x4 p = *(const u32x4*)op;
                        a[0] += bf_lo(p.x); a[1] += bf_hi(p.x); a[2] += bf_lo(p.y); a[3] += bf_hi(p.y);
                        b[0] += bf_lo(p.z); b[1] += bf_hi(p.z); b[2] += bf_lo(p.w); b[3] += bf_hi(p.w); }
                    *(u32x4*)op = pack8(a, b);
                }
            }
    }
};

template <class Epi, class Sched, bool ALIGN_EPI = false, bool SP2 = false>
__device__ __forceinline__ void gemm_phase(PG8_LAS unsigned char* lds, const Gemm g, const Sched& S, const Epi& E) {
    int tid_ = threadIdx.x; asm volatile("" : "+v"(tid_));
    const int tid = tid_, wid = __builtin_amdgcn_readfirstlane(tid >> 6), lane = tid & 63, wr = wid >> 2, wc = wid & 3, fr = lane & 15, fq = lane >> 4;
    int K_ = g.K; asm volatile("" : "+s"(K_));
    const int K = K_, nt = K / BK;
    unsigned voffA[2], voffB[2];
#pragma unroll
    for (int i = 0; i < 2; ++i) { int R, C; stage_rc(tid * 16 + i * 8192, R, C); const int Rb = Epi::PERM ? ((R & ~31) + perm32(R & 31)) : R;
        voffA[i] = (unsigned)(R * K + C) * 2u; voffB[i] = (unsigned)(Rb * K + C) * 2u; }
    const size_t kstep = (size_t)(BK * 2);
    const size_t hstep = (size_t)HALF * K * 2;
    const size_t tstep = 2 * hstep;
    const unsigned ldsw = (unsigned)wid * 1024u;
    const int aoff = lds_byte(wr * 64 + fr, fq * 8), boff = lds_byte(wc * 32 + fr, fq * 8);
#define PG8_SA(b, h) (((b) * 2 + (h)) * HTB)
#define PG8_SB(b, h) ((4 + (b) * 2 + (h)) * HTB)
#define PG8_STAGE(bufoff, gbase, voff) do { _Pragma("unroll") for (int _i = 0; _i < 2; ++_i) \
        __builtin_amdgcn_global_load_lds((const unsigned*)((const char*)(gbase) + (voff)[_i]), (PG8_LAS unsigned*)(lds + (bufoff) + ldsw + _i * 8192), 16, 0, 0); } while (0)
#define PG8_LDA(dst, b, h) do { _Pragma("unroll") for (int m = 0; m < 4; ++m) _Pragma("unroll") for (int k = 0; k < 2; ++k) dst[m][k] = *(const PG8_LAS bf16x8*)(lds + PG8_SA(b, h) + aoff + m * 2048 + k * 1024); } while (0)
#define PG8_LDB(dst, b, h) do { _Pragma("unroll") for (int n = 0; n < 2; ++n) _Pragma("unroll") for (int k = 0; k < 2; ++k) dst[n][k] = *(const PG8_LAS bf16x8*)(lds + PG8_SB(b, h) + boff + n * 2048 + k * 1024); } while (0)
#define PG8_MMA(ai, bj, At, Bt) do { __builtin_amdgcn_s_setprio(1); _Pragma("unroll") for (int m = 0; m < 4; ++m) _Pragma("unroll") for (int n = 0; n < 2; ++n) _Pragma("unroll") for (int k = 0; k < 2; ++k) \
        acc[ai][bj][m][n] = __builtin_amdgcn_mfma_f32_16x16x32_bf16(Bt[n][k], At[m][k], acc[ai][bj][m][n], 0, 0, 0); __builtin_amdgcn_s_setprio(0); } while (0)
#define PG8_WAIT_V(n) asm volatile("s_waitcnt vmcnt(" #n ")" ::: "memory")
#define PG8_WAIT_L(n) asm volatile("s_waitcnt lgkmcnt(" #n ")" ::: "memory")
#define PG8_BAR __builtin_amdgcn_s_barrier()
#define PG8_SCHED __builtin_amdgcn_sched_barrier(0)
    Unit cur, nxt; int ui = 0;
    if (!S.next(0, cur)) return;
    f32x4 acc[2][2][4][2];
#pragma unroll
    for (int a = 0; a < 2; ++a)
#pragma unroll
        for (int b = 0; b < 2; ++b)
#pragma unroll
            for (int m = 0; m < 4; ++m)
#pragma unroll
                for (int n = 0; n < 2; ++n) acc[a][b][m][n] = (f32x4){0.f, 0.f, 0.f, 0.f};
    bf16x8 At[4][2], B0[2][2], B1[2][2];
    const char* cA = (const char*)g.A + (size_t)cur.pm * tstep; const char* cB = (const char*)g.Bt + (size_t)cur.pn * tstep;
    S.a_ready(cur);
    if constexpr (SP2) {
        PG8_STAGE(PG8_SB(0, 0), cB, voffB); PG8_STAGE(PG8_SB(0, 1), cB + hstep, voffB); PG8_STAGE(PG8_SA(0, 0), cA, voffA); PG8_STAGE(PG8_SA(0, 1), cA + hstep, voffA);
        if (wr == 1) PG8_BAR;
        PG8_WAIT_V(2); PG8_BAR;
        PG8_STAGE(PG8_SB(1, 0), cB + kstep, voffB); PG8_STAGE(PG8_SA(1, 0), cA + kstep, voffA); PG8_STAGE(PG8_SB(1, 1), cB + hstep + kstep, voffB);
        PG8_WAIT_V(6); PG8_BAR;
    } else {
        PG8_STAGE(PG8_SB(0, 0), cB, voffB); PG8_STAGE(PG8_SA(0, 0), cA, voffA); PG8_STAGE(PG8_SB(0, 1), cB + hstep, voffB); PG8_STAGE(PG8_SA(0, 1), cA + hstep, voffA);
        if (wr == 1) PG8_BAR;
        PG8_WAIT_V(4); PG8_BAR;
        PG8_STAGE(PG8_SB(1, 0), cB + kstep, voffB); PG8_STAGE(PG8_SA(1, 0), cA + kstep, voffA); PG8_STAGE(PG8_SB(1, 1), cB + hstep + kstep, voffB);
        PG8_WAIT_V(6); PG8_BAR;
    }
    for (;;) {
        const bool has_next = S.next(ui + 1, nxt);
        const char* nA = has_next ? (const char*)g.A + (size_t)nxt.pm * tstep : cA; const char* nB = has_next ? (const char*)g.Bt + (size_t)nxt.pn * tstep : cB;
        for (int t = 0; t < nt; t += 2) {
            const bool last = (t == nt - 2);
            const char* a1 = cA + (size_t)(t + 1) * kstep;
            const char* a2 = last ? nA : cA + (size_t)(t + 2) * kstep; const char* b2 = last ? nB : cB + (size_t)(t + 2) * kstep;
            const char* a3 = a2 + kstep; const char* b3 = b2 + kstep;
            if (last && has_next) S.a_ready(nxt);
            if constexpr (SP2) {
            PG8_LDB(B0, 0, 0); PG8_LDB(B1, 0, 1); PG8_SCHED; PG8_LDA(At, 0, 0); PG8_STAGE(PG8_SA(1, 1), a1 + hstep, voffA);
            PG8_WAIT_V(8); PG8_WAIT_L(0); PG8_BAR; PG8_MMA(0, 0, At, B0); PG8_MMA(0, 1, At, B1); PG8_BAR; PG8_SCHED;
            PG8_LDA(At, 0, 1); PG8_STAGE(PG8_SB(0, 0), b2, voffB); PG8_STAGE(PG8_SB(0, 1), b2 + hstep, voffB); PG8_STAGE(PG8_SA(0, 0), a2, voffA);
            PG8_WAIT_V(8); PG8_WAIT_L(0); PG8_BAR; PG8_MMA(1, 0, At, B0); PG8_MMA(1, 1, At, B1); PG8_BAR; PG8_SCHED;
            PG8_LDB(B0, 1, 0); PG8_LDB(B1, 1, 1); PG8_SCHED; PG8_LDA(At, 1, 0); PG8_STAGE(PG8_SA(0, 1), a2 + hstep, voffA);
            PG8_WAIT_V(8); PG8_WAIT_L(0); PG8_BAR; PG8_MMA(0, 0, At, B0); PG8_MMA(0, 1, At, B1); PG8_BAR; PG8_SCHED;
            PG8_LDA(At, 1, 1); PG8_STAGE(PG8_SB(1, 0), b3, voffB); PG8_STAGE(PG8_SB(1, 1), b3 + hstep, voffB); PG8_STAGE(PG8_SA(1, 0), a3, voffA);
            PG8_WAIT_V(8); PG8_WAIT_L(0); PG8_BAR; PG8_MMA(1, 0, At, B0); PG8_MMA(1, 1, At, B1); PG8_BAR; PG8_SCHED;
            } else {
            PG8_LDB(B0, 0, 0); PG8_SCHED; PG8_LDA(At, 0, 0); PG8_STAGE(PG8_SA(1, 1), a1 + hstep, voffA);
            PG8_WAIT_L(8); PG8_BAR; PG8_WAIT_L(0); PG8_MMA(0, 0, At, B0); PG8_BAR; PG8_SCHED;
            PG8_LDB(B1, 0, 1); PG8_STAGE(PG8_SB(0, 0), b2, voffB);
            PG8_BAR; PG8_WAIT_L(0); PG8_MMA(0, 1, At, B1); PG8_BAR;
            PG8_LDA(At, 0, 1); PG8_STAGE(PG8_SA(0, 0), a2, voffA);
            PG8_BAR; PG8_WAIT_L(0); PG8_MMA(1, 0, At, B0); PG8_BAR; PG8_SCHED;
            PG8_STAGE(PG8_SB(0, 1), b2 + hstep, voffB);
            PG8_WAIT_V(6); PG8_BAR; PG8_MMA(1, 1, At, B1); PG8_BAR;
            PG8_LDB(B0, 1, 0); PG8_SCHED; PG8_LDA(At, 1, 0); PG8_STAGE(PG8_SA(0, 1), a2 + hstep, voffA);
            PG8_WAIT_L(8); PG8_BAR; PG8_WAIT_L(0); PG8_MMA(0, 0, At, B0); PG8_BAR; PG8_SCHED;
            PG8_LDB(B1, 1, 1); PG8_STAGE(PG8_SB(1, 0), b3, voffB);
            PG8_BAR; PG8_WAIT_L(0); PG8_MMA(0, 1, At, B1); PG8_BAR;
            PG8_LDA(At, 1, 1); PG8_STAGE(PG8_SA(1, 0), a3, voffA);
            PG8_BAR; PG8_WAIT_L(0); PG8_MMA(1, 0, At, B0); PG8_BAR; PG8_SCHED;
            PG8_STAGE(PG8_SB(1, 1), b3 + hstep, voffB);
            PG8_WAIT_V(6); PG8_BAR; PG8_MMA(1, 1, At, B1); PG8_BAR;
            }
        }
        if constexpr (ALIGN_EPI) { if (wr == 0) PG8_BAR; }
        if constexpr (!Epi::AFTER_DRAIN) { E(acc, cur, wr, wc, fr, fq); S.done(cur); }
        if (!has_next) break;
#pragma unroll
        for (int a = 0; a < 2; ++a)
#pragma unroll
            for (int b = 0; b < 2; ++b)
#pragma unroll
                for (int m = 0; m < 4; ++m)
#pragma unroll
                    for (int n = 0; n < 2; ++n) acc[a][b][m][n] = (f32x4){0.f, 0.f, 0.f, 0.f};
        cur = nxt; cA = nA; cB = nB; ++ui;
        if constexpr (ALIGN_EPI) { if (wr == 1) PG8_BAR; }
    }
    PG8_WAIT_V(0);
    if constexpr (!ALIGN_EPI) { if (wr == 0) PG8_BAR; }
    PG8_BAR;
    if constexpr (Epi::AFTER_DRAIN) { E.fused(acc, cur, wr, wc, fr, fq, lds, wid, lane); S.done(cur); }
#undef PG8_SA
#undef PG8_SB
#undef PG8_STAGE
#undef PG8_LDA
#undef PG8_LDB
#undef PG8_MMA
#undef PG8_WAIT_V
#undef PG8_WAIT_L
#undef PG8_BAR
#undef PG8_SCHED
}
}

#include <hip/hip_cooperative_groups.h>
namespace cg = cooperative_groups;

constexpr int D_MODEL = 1024, BATCH = 4, SEQ = 8192, DEPTH = 2, N_META = 16, T = SEQ + N_META  , M = BATCH * T  , MPAD = 33024  , MMAIN = 32768  ;
constexpr int D_CONV = 512, D_FF = 2816, D_IN = 4000, D_INP = 4096, NHEAD = 8, TP = 8320;
constexpr float ALPHA = 1.4142135623730951f;
constexpr float LN_EPS = 1e-5f, RMS_EPS = 1e-6f;
constexpr float QSCALE = 0.10206207261596575f * 1.4426950408889634f;
constexpr int NWAVES = 8;

constexpr size_t OFF_CTL = 0;
constexpr size_t OFF_ROPE = 65536;
constexpr size_t OFF_HF = 2097152;
constexpr size_t SZ_HF = (size_t)MPAD * 1024 * 4;
constexpr size_t OFF_W = OFF_HF + SZ_HF;
constexpr size_t SZ_W = 17825792;
constexpr size_t OFF_S = OFF_W + SZ_W;
constexpr size_t SZ_HB = (size_t)MPAD * 1024 * 2;
constexpr size_t S_HB = OFF_S;
constexpr size_t S_GATES = OFF_S + SZ_HB;
constexpr size_t S_ACT = S_GATES;
constexpr size_t S_BCH = S_GATES + (size_t)MPAD * 2048 * 2;
constexpr size_t S_LAT = S_BCH + (size_t)MPAD * 1536 * 2;
constexpr size_t S_END4 = S_LAT + (size_t)MPAD * 512 * 4;
constexpr size_t S_YCONV = S_HB;
constexpr size_t S_CQN = S_YCONV + (size_t)MPAD * 512 * 2;
constexpr size_t S_CKVN = S_CQN + (size_t)MPAD * 256 * 2;
static_assert(S_CKVN + (size_t)MPAD * 256 * 2 <= S_GATES, "row-prep outputs fit in hb's region");
constexpr size_t S_Q = S_BCH;
constexpr size_t S_KN = S_Q + (size_t)MPAD * 768 * 2;
constexpr size_t S_VT = S_KN + (size_t)MPAD * 512 * 2;
constexpr size_t S_YMLA = S_VT + (size_t)BATCH * NHEAD * 64 * TP * 2;
static_assert(S_YMLA + (size_t)MPAD * 512 * 2 <= S_END4, "attention tensors fit in bch|lat's region");
constexpr size_t S_MERGED = S_Q;
static_assert(S_MERGED + (size_t)MPAD * 1024 * 2 <= S_VT + 0 * S_YMLA && S_ACT + (size_t)MPAD * 2816 * 2 <= S_END4, "overlays");
constexpr size_t S_KR = S_END4;
constexpr size_t WS_NEED = S_KR + (size_t)MPAD * 32 * 2;
static_assert(WS_NEED <= 536870912, "fits the guaranteed workspace");
constexpr size_t W_UP = 0, W_DOWN = (size_t)5632 * 1024 * 2;
constexpr size_t W_IN = 0, W_UQ = (size_t)4096 * 1024 * 2, W_UKV = W_UQ + 768 * 256 * 2, W_BC = W_UKV + 1024 * 256 * 2, W_BM = W_BC + 1024 * 512 * 2, W_O = W_BM + 1024 * 512 * 2;
static_assert(W_O + 1024 * 1024 * 2 <= SZ_W && W_DOWN + (size_t)1024 * 2816 * 2 <= SZ_W, "weight region");
constexpr int RING_BYTES = 131072, LDS_MISC = RING_BYTES, LDS_BYTES = RING_BYTES + 256;

#define LAS __attribute__((address_space(3)))
typedef unsigned short bf16;
typedef unsigned v4u __attribute__((ext_vector_type(4)));
typedef unsigned v2u __attribute__((ext_vector_type(2)));
typedef float f32x4 __attribute__((ext_vector_type(4)));
typedef float f32x2 __attribute__((ext_vector_type(2)));
typedef float f32x16 __attribute__((ext_vector_type(16)));
typedef short bf16x8 __attribute__((ext_vector_type(8)));
#define LDS_WAIT() asm volatile("s_waitcnt lgkmcnt(0)" ::: "memory")

__device__ __forceinline__ unsigned pk2(float lo, float hi) { return pg8::cvt_pk_bf16(lo, hi); }
__device__ __forceinline__ float wave_sum(float v) {
#pragma unroll
    for (int o = 1; o < 64; o <<= 1) v += __shfl_xor(v, o);
    return v;
}

__device__ __forceinline__ float inv_freq_of(int k) {
    switch (k) { case 0: return 1.000000000e+00f; case 1: return 5.623413324e-01f; case 2: return 3.162277639e-01f; case 3: return 1.778279394e-01f; case 4: return 1.000000015e-01f; case 5: return 5.623412877e-02f;
        case 6: return 3.162277862e-02f; case 7: return 1.778279431e-02f; case 8: return 9.999999776e-03f; case 9: return 5.623413250e-03f; case 10: return 3.162277862e-03f; case 11: return 1.778279431e-03f;
        case 12: return 1.000000047e-03f; case 13: return 5.623413017e-04f; case 14: return 3.162277862e-04f; default: return 1.778279402e-04f; }
}
__device__ __forceinline__ void transpose_item(const float* W, int N, int k0, int scol0, bf16* dst, int ldk, int drow0, LAS float* scr, int lane) {
    if (scol0 >= 0) {
#pragma unroll 8
        for (int i = 0; i < 32; ++i) { const int kk = 2 * i + (lane >> 5); scr[kk * 33 + (lane & 31)] = W[(size_t)(k0 + kk) * N + scol0 + (lane & 31)]; }
    } else {
#pragma unroll 8
        for (int i = 0; i < 32; ++i) { const int kk = 2 * i + (lane >> 5); scr[kk * 33 + (lane & 31)] = 0.f; }
    }
    LDS_WAIT(); asm volatile("" ::: "memory");
    const int c = lane & 7;
#pragma unroll
    for (int j = 0; j < 4; ++j) { const int n = (lane >> 3) + 8 * j; const LAS float* s = scr + (8 * c) * 33 + n;
        v4u o; o.x = pk2(s[0 * 33], s[1 * 33]); o.y = pk2(s[2 * 33], s[3 * 33]); o.z = pk2(s[4 * 33], s[5 * 33]); o.w = pk2(s[6 * 33], s[7 * 33]);
        *(v4u*)(dst + (size_t)(drow0 + n) * ldk + k0 + 8 * c) = o; }
    LDS_WAIT(); asm volatile("" ::: "memory");
}
__device__ __forceinline__ void convert_ffn(const float* w_up, const float* w_down, unsigned char* wreg, LAS float* scr, int gw, int ngw, int lane) {
    constexpr int I_UP = 16 * 176, I_DN = 44 * 32;
    for (int it = gw; it < I_UP + I_DN; it += ngw) {
        if (it < I_UP) { const int kb = it / 176, g = it % 176, tile = g >> 3, sub = g & 7;
            const int scol = sub < 4 ? tile * 128 + sub * 32 : D_FF + tile * 128 + (sub - 4) * 32;
            transpose_item(w_up, 2 * D_FF, kb * 64, scol, (bf16*)(wreg + W_UP), 1024, g * 32, scr, lane); }
        else { const int r = it - I_UP, kb = r / 32, g = r % 32; transpose_item(w_down, 1024, kb * 64, g * 32, (bf16*)(wreg + W_DOWN), D_FF, g * 32, scr, lane); }
    }
}
__device__ __forceinline__ void convert_mixer(const float* w_in, const float* w_uq, const float* w_ukv, const float* w_bc, const float* w_bm, const float* w_o, unsigned char* wreg, LAS float* scr, int gw, int ngw, int lane) {
    constexpr int I_IN = 16 * 128, I_UQ = 4 * 24, I_UKV = 4 * 32, I_BR = 8 * 32, I_O = 16 * 32;
    for (int it = gw; it < I_IN + I_UQ + I_UKV + 2 * I_BR + I_O; it += ngw) {
        int r = it;
        if (r < I_IN) { const int kb = r / 128, g = r % 128, n = g * 32; const int scol = n < 1952 ? n : (n < 2048 ? -1 : (n < 3072 ? 1952 + (n - 2048) : 2976 + (n - 3072)));
            transpose_item(w_in, D_IN, kb * 64, scol, (bf16*)(wreg + W_IN), 1024, n, scr, lane); continue; } r -= I_IN;
        if (r < I_UQ) { const int kb = r / 24, g = r % 24; transpose_item(w_uq, 768, kb * 64, g * 32, (bf16*)(wreg + W_UQ), 256, g * 32, scr, lane); continue; } r -= I_UQ;
        if (r < I_UKV) { const int kb = r / 32, g = r % 32, gg = g & 15; const int scol = (gg >> 1) * 128 + (g >> 4) * 64 + (gg & 1) * 32;
            transpose_item(w_ukv, 1024, kb < 2 ? kb * 64 : 0, kb < 2 ? scol : -1, (bf16*)(wreg + W_UKV) + (kb < 2 ? 0 : kb * 64), 256, g * 32, scr, lane); continue; } r -= I_UKV;
        if (r < I_BR) { const int kb = r / 32, g = r % 32; transpose_item(w_bc, 1024, kb * 64, g * 32, (bf16*)(wreg + W_BC), 512, g * 32, scr, lane); continue; } r -= I_BR;
        if (r < I_BR) { const int kb = r / 32, g = r % 32; transpose_item(w_bm, 1024, kb * 64, g * 32, (bf16*)(wreg + W_BM), 512, g * 32, scr, lane); continue; } r -= I_BR;
        { const int kb = r / 32, g = r % 32; transpose_item(w_o, 1024, kb * 64, g * 32, (bf16*)(wreg + W_O), 1024, g * 32, scr, lane); }
    }
}

__device__ __forceinline__ void ln_row(const float* xin, const float* g, const float* bt, float* of32, bf16* ob16, int lane) {
    const f32x4* xr = (const f32x4*)xin + lane;
    f32x4 v[4]; float s = 0.f;
#pragma unroll
    for (int j = 0; j < 4; ++j) { v[j] = xr[64 * j]; s += (v[j].x + v[j].y) + (v[j].z + v[j].w); }
    const float mean = wave_sum(s) * (1.f / 1024.f); float s2 = 0.f;
#pragma unroll
    for (int j = 0; j < 4; ++j) { v[j] = v[j] - mean; s2 += (v[j].x * v[j].x + v[j].y * v[j].y) + (v[j].z * v[j].z + v[j].w * v[j].w); }
    const float rstd = 1.f / sqrtf(wave_sum(s2) * (1.f / 1024.f) + LN_EPS);
#pragma unroll
    for (int j = 0; j < 4; ++j) { const f32x4 gg = ((const f32x4*)g)[lane + 64 * j], bb = ((const f32x4*)bt)[lane + 64 * j]; v[j] = v[j] * rstd * gg + bb; }
    if (of32) {
#pragma unroll
        for (int j = 0; j < 4; ++j) ((f32x4*)of32)[lane + 64 * j] = v[j]; }
    if (ob16) {
#pragma unroll
        for (int j = 0; j < 4; ++j) { v2u w; w.x = pk2(v[j].x, v[j].y); w.y = pk2(v[j].z, v[j].w); ((v2u*)ob16)[lane + 64 * j] = w; } }
}

struct TailResid { float* H; float alpha, coef;
    __device__ __forceinline__ void operator()(int token, int col, const f32x4 s) const { float* p = H + (size_t)token * 1024 + col; const f32x4 h = *(const f32x4*)p; *(f32x4*)p = h * alpha + s * coef; } };
template <bool ACCUM> struct TailGate { bf16* O; const bf16* G;
    __device__ __forceinline__ void operator()(int token, int col, f32x4 s) const {
        const v2u g = *(const v2u*)(G + (size_t)token * 2048 + col); bf16* op = O + (size_t)token * 1024 + col;
        s[0] *= pg8::bf_lo(g.x); s[1] *= pg8::bf_hi(g.x); s[2] *= pg8::bf_lo(g.y); s[3] *= pg8::bf_hi(g.y);
        if (ACCUM) { const v2u p = *(const v2u*)op; s[0] += pg8::bf_lo(p.x); s[1] += pg8::bf_hi(p.x); s[2] += pg8::bf_lo(p.y); s[3] += pg8::bf_hi(p.y); }
        v2u w; w.x = pk2(s[0], s[1]); w.y = pk2(s[2], s[3]); *(v2u*)op = w; } };
template <class F> __device__ __forceinline__ void tail_gemm(const bf16* A, const bf16* Bt, int K, int blk, LAS unsigned char* lds, const F& epi) {
    if (blk >= 64) return;
    int tid_ = threadIdx.x; asm volatile("" : "+v"(tid_));
    const int lane = tid_ & 63, wid = tid_ >> 6, fr = lane & 15, fq = lane >> 4, n0 = blk * 16, kw = K >> 3;
    const bf16* ap = A + (size_t)fr * K + wid * kw + fq * 8;
    const bf16* bp = Bt + (size_t)(n0 + fr) * K + wid * kw + fq * 8;
    f32x4 acc[4];
#pragma unroll
    for (int m = 0; m < 4; ++m) acc[m] = (f32x4){0.f, 0.f, 0.f, 0.f};
    for (int k = 0; k < kw; k += 32) {
        const bf16x8 b = *(const bf16x8*)(bp + k);
#pragma unroll
        for (int m = 0; m < 4; ++m) { const bf16x8 a = *(const bf16x8*)(ap + (size_t)m * 16 * K + k); acc[m] = __builtin_amdgcn_mfma_f32_16x16x32_bf16(b, a, acc[m], 0, 0, 0); }
    }
    LAS f32x4* red = (LAS f32x4*)lds;
#pragma unroll
    for (int m = 0; m < 4; ++m) red[(wid * 4 + m) * 64 + lane] = acc[m];
    __syncthreads();
    if (wid < 4) { f32x4 s = red[wid * 64 + lane];
#pragma unroll
        for (int w = 1; w < 8; ++w) s = s + red[(w * 4 + wid) * 64 + lane];
        epi(wid * 16 + fr, n0 + fq * 4, s); }
    __syncthreads();
}

namespace att {
constexpr int KB = 12288, VB = 8192, OFF_V = 2 * KB, OFF_WS = 2 * KB + 3 * VB, OFF_Q = OFF_WS + 8 * 256;
__device__ __forceinline__ int crow(int r, int hi) { return (r & 3) + 8 * (r >> 2) + 4 * hi; }
__device__ __forceinline__ void attn_unit(int b, int h, int qb, const bf16* Q, const bf16* Kn, const bf16* Kr, const bf16* Vt, const float* rope, bf16* Y, LAS unsigned char* lds) {
    int tid_ = threadIdx.x; asm volatile("" : "+v"(tid_));
    const int tid = tid_, lane = tid & 63, r32 = lane & 31, hi = lane >> 5; const int wid = __builtin_amdgcn_readfirstlane(tid >> 6);
    const int q0 = qb * 256, q0w = q0 + wid * 32;
    const size_t rowbase = (size_t)b * T;
    int NT = (q0 + 256) / 64; if (NT > (T + 63) / 64) NT = (T + 63) / 64;
    int ntw = 0; if (q0w < T) { ntw = (q0w + 31) / 64 + 1; if (ntw > NT) ntw = NT; }
    bf16x8 qr[6];
    { int tq = q0w + r32; if (tq > T - 1) tq = T - 1; const bf16* qp = Q + (rowbase + tq) * 768 + h * 96 + hi * 8;
#pragma unroll
      for (int d0 = 0; d0 < 6; ++d0) qr[d0] = *(const bf16x8*)(qp + d0 * 16);
      const float* rt = rope + (size_t)tq * 32 + 8 * hi; const f32x4 c0 = *(const f32x4*)rt, c1 = *(const f32x4*)(rt + 4), s0 = *(const f32x4*)(rt + 16), s1 = *(const f32x4*)(rt + 20);
      v4u a = __builtin_bit_cast(v4u, qr[4]), bb = __builtin_bit_cast(v4u, qr[5]), oa, ob;
#define ROT2(AW, BW, CA, CB, SA, SB, OA, OB) do { const float x1l = pg8::bf_lo(AW), x1h = pg8::bf_hi(AW), x2l = pg8::bf_lo(BW), x2h = pg8::bf_hi(BW); \
        OA = pk2(x1l * (CA) - x2l * (SA), x1h * (CB) - x2h * (SB)); OB = pk2(x2l * (CA) + x1l * (SA), x2h * (CB) + x1h * (SB)); } while (0)
      ROT2(a.x, bb.x, c0[0], c0[1], s0[0], s0[1], oa.x, ob.x); ROT2(a.y, bb.y, c0[2], c0[3], s0[2], s0[3], oa.y, ob.y);
      ROT2(a.z, bb.z, c1[0], c1[1], s1[0], s1[1], oa.z, ob.z); ROT2(a.w, bb.w, c1[2], c1[3], s1[2], s1[3], oa.w, ob.w);
#undef ROT2
      qr[4] = __builtin_bit_cast(bf16x8, oa); qr[5] = __builtin_bit_cast(bf16x8, ob); }
    const bf16* kn_src = Kn + (rowbase + lane) * 512 + h * 64 + wid * 8;
    const bf16* kr_src = Kr + (rowbase + lane) * 32 + (wid & 3) * 8;
    const bf16* v_src = Vt + ((size_t)(b * 8 + h) * 64 + lane) * TP + wid * 8;
    v4u kreg, krreg = (v4u){0u, 0u, 0u, 0u}, vreg;
#define ATT_LOAD(kt) do { kreg = *(const v4u*)(kn_src + (size_t)(kt) * 64 * 512); if (wid < 4) krreg = *(const v4u*)(kr_src + (size_t)(kt) * 64 * 32); vreg = *(const v4u*)(v_src + (size_t)(kt) * 64); } while (0)
#define ATT_STORE(buf, vslot) do { *(LAS v4u*)(lds + (buf) * KB + wid * 1024 + lane * 16) = kreg; if (wid < 4) *(LAS v4u*)(lds + (buf) * KB + (8 + wid) * 1024 + lane * 16) = krreg; \
        *(LAS v4u*)(lds + OFF_V + (vslot) * VB + wid * 1024 + lane * 16) = vreg; } while (0)
    LAS float* wsf = (LAS float*)(lds + OFF_WS + wid * 256);
    ATT_LOAD(0); ATT_STORE(0, 0);
    __syncthreads();
    const bool skew = wid >= 4;
    bf16x8 pw[4];
    int vs_cur = 0, vs_prev = 2, vs_next = 1;
#define ATT_PV(vslot) do { const LAS unsigned char* vb_ = lds + OFF_V + (vslot) * VB + hi * 1024 + r32 * 16; \
        _Pragma("unroll") for (int ks = 0; ks < 4; ++ks) { \
            const bf16x8 v0 = *(const LAS bf16x8*)(vb_ + ks * 2048), v1 = *(const LAS bf16x8*)(vb_ + ks * 2048 + 512); \
            o0 = __builtin_amdgcn_mfma_f32_32x32x16_bf16(pw[ks], v0, o0, 0, 0, 0); \
            o1 = __builtin_amdgcn_mfma_f32_32x32x16_bf16(pw[ks], v1, o1, 0, 0, 0); } } while (0)
    float mrow = 0.f, lsum = 0.f;
    f32x16 o0, o1, negm;
#pragma unroll
    for (int r = 0; r < 16; ++r) { o0[r] = 0.f; o1[r] = 0.f; negm[r] = 0.f; }
    for (int kt = 0; kt < NT; ++kt) {
        const int cur = kt & 1;
        if (kt + 1 < NT) ATT_LOAD(kt + 1);
        if (skew && kt >= 1 && kt - 1 < ntw) ATT_PV(vs_prev);
        if (kt < ntw) {
            const LAS unsigned char* kb = lds + cur * KB + hi * 1024 + r32 * 16;
            f32x16 p0, p1;
#pragma unroll
            for (int d0 = 0; d0 < 6; ++d0) {
                const bf16x8 a0 = *(const LAS bf16x8*)(kb + d0 * 2048), a1 = *(const LAS bf16x8*)(kb + d0 * 2048 + 512);
                p0 = __builtin_amdgcn_mfma_f32_32x32x16_bf16(a0, qr[d0], d0 == 0 ? negm : p0, 0, 0, 0);
                p1 = __builtin_amdgcn_mfma_f32_32x32x16_bf16(a1, qr[d0], d0 == 0 ? negm : p1, 0, 0, 0);
            }
            if (64 * kt + 63 > q0w) {
                const int q = q0w + r32, kbase = 64 * kt + 4 * hi;
#pragma unroll
                for (int r = 0; r < 16; ++r) { const int key = kbase + (r & 3) + 8 * (r >> 2); if (key > q) p0[r] = -1e30f; if (key + 32 > q) p1[r] = -1e30f; }
            }
            float mx = fmaxf(p0[0], p1[0]);
#pragma unroll
            for (int r = 1; r < 16; ++r) mx = fmaxf(mx, fmaxf(p0[r], p1[r]));
            mx = fmaxf(mx, __shfl_xor(mx, 32));
            if (kt == 0 || __any(mx > 8.0f)) {
                const float dl = (kt == 0) ? mx : fmaxf(mx, 0.f), alpha = __builtin_amdgcn_exp2f(-dl);
                mrow += dl; lsum *= alpha;
#pragma unroll
                for (int r = 0; r < 16; ++r) { p0[r] -= dl; p1[r] -= dl; negm[r] = -mrow; }
                if (hi == 0) wsf[r32] = alpha;
                LDS_WAIT();
#pragma unroll
                for (int i = 0; i < 4; ++i) { const f32x4 a = *(const LAS f32x4*)(wsf + 8 * i + 4 * hi);
#pragma unroll
                    for (int j = 0; j < 4; ++j) { o0[4 * i + j] *= a[j]; o1[4 * i + j] *= a[j]; } }
            }
            float s = 0.f;
#pragma unroll
            for (int r = 0; r < 16; ++r) { p0[r] = __builtin_amdgcn_exp2f(p0[r]); p1[r] = __builtin_amdgcn_exp2f(p1[r]); s += p0[r] + p1[r]; }
            lsum += s;
#pragma unroll
            for (int ks = 0; ks < 4; ++ks) { v4u w;
                if (ks < 2) { w.x = pk2(p0[8 * ks + 0], p0[8 * ks + 1]); w.y = pk2(p0[8 * ks + 2], p0[8 * ks + 3]); w.z = pk2(p0[8 * ks + 4], p0[8 * ks + 5]); w.w = pk2(p0[8 * ks + 6], p0[8 * ks + 7]); }
                else { const int k2 = ks - 2; w.x = pk2(p1[8 * k2 + 0], p1[8 * k2 + 1]); w.y = pk2(p1[8 * k2 + 2], p1[8 * k2 + 3]); w.z = pk2(p1[8 * k2 + 4], p1[8 * k2 + 5]); w.w = pk2(p1[8 * k2 + 6], p1[8 * k2 + 7]); }
                pw[ks] = __builtin_bit_cast(bf16x8, w); }
            if (!skew) ATT_PV(vs_cur);
        }
        if (kt + 1 < NT) ATT_STORE(cur ^ 1, vs_next);
        { const int t_ = vs_prev; vs_prev = vs_cur; vs_cur = vs_next; vs_next = t_; }
        __syncthreads();
    }
    if (skew && NT - 1 < ntw) ATT_PV(vs_prev);
#undef ATT_PV
    if (ntw > 0) {
        lsum += __shfl_xor(lsum, 32);
        if (hi == 0) wsf[32 + r32] = 1.0f / lsum;
        LDS_WAIT();
        bf16* yp = Y + (rowbase + q0w) * 512 + h * 64 + r32;
#pragma unroll
        for (int i = 0; i < 4; ++i) { const f32x4 a = *(const LAS f32x4*)(wsf + 32 + 8 * i + 4 * hi);
#pragma unroll
            for (int j = 0; j < 4; ++j) { const int r = 4 * i + j, q = crow(r, hi);
                if (q0w + q < T) { const unsigned w = pk2(o0[r] * a[j], o1[r] * a[j]); yp[(size_t)q * 512] = (bf16)(w & 0xffffu); yp[(size_t)q * 512 + 32] = (bf16)(w >> 16); } } }
        LDS_WAIT();
    }
#undef ATT_LOAD
#undef ATT_STORE
}
}

#define GAS __attribute__((address_space(1)))
#ifdef PROBE_SYS_SCOPE
#define XB_SCOPE ""
#else
#define XB_SCOPE "agent"
#endif
#define XB_TMO      128
#define XB_XCNT(j)  (256  + 64 * (j))
#define XB_XSUB(j)  (1280 + 64 * (j))
#define XB_XGEN(j)  (2304 + 64 * (j))
#define XB_TOP      3328
#define XB_TOPGEN   3392
#define XCD_BAR_WORDS 3456
#define XB_SPIN_CAP (1u << 18)

__device__ __forceinline__ unsigned xb_ld(unsigned* p)              { return __hip_atomic_load(p, __ATOMIC_RELAXED, __HIP_MEMORY_SCOPE_AGENT); }
__device__ __forceinline__ unsigned xb_add(unsigned* p, unsigned v) { return __hip_atomic_fetch_add(p, v, __ATOMIC_RELAXED, __HIP_MEMORY_SCOPE_AGENT); }
__device__ __forceinline__ unsigned xb_xcc_id() { return (unsigned)__builtin_amdgcn_s_getreg((3 << 11) | 20) & 0xFu; }
#define XB_SPIN(cond, bar) do { unsigned _sp = 0; while (cond) { __builtin_amdgcn_s_sleep(1); \
    if ((++_sp & 255u) == 0u) { if (xb_ld(&(bar)[XB_TMO])) break; if (_sp > XB_SPIN_CAP) { atomicAdd(&(bar)[XB_TMO], 1u); break; } } } } while (0)

struct XcdBarrier {
    unsigned* bar; unsigned x;
    volatile LAS unsigned* st;
};

__device__ __forceinline__ XcdBarrier xcd_barrier_post(unsigned* bar, volatile LAS unsigned* st) {
    XcdBarrier b; b.bar = bar; b.x = xb_xcc_id(); b.st = st;
    if (threadIdx.x == 0) (void)xb_add(&bar[XB_XCNT(b.x)], 1u);
    return b;
}
__device__ __forceinline__ void xcd_barrier_complete(unsigned* bar, unsigned x, unsigned& nloc, unsigned& nx) {
    const unsigned G = gridDim.x * gridDim.y * gridDim.z;
    unsigned sum, cnt, mine, sp = 0u;
    for (;;) {
        sum = 0u; cnt = 0u; mine = 0u;
#pragma unroll
        for (unsigned j = 0; j < 16; ++j) { const unsigned c = xb_ld(&bar[XB_XCNT(j)]); sum += c; cnt += (c > 0u) ? 1u : 0u; mine = (j == x) ? c : mine; }
        if (sum == G) break;
        __builtin_amdgcn_s_sleep(1);
        if ((++sp & 255u) == 0u) { if (xb_ld(&bar[XB_TMO])) break; if (sp > XB_SPIN_CAP) { atomicAdd(&bar[XB_TMO], 1u); break; } }
    }
    nloc = mine > 0u ? mine : 1u; nx = cnt > 0u ? cnt : 1u;
}

__device__ __forceinline__ void xcd_barrier(const XcdBarrier& b) {
    asm volatile("s_waitcnt vmcnt(0)" ::: "memory");
    __syncthreads();
    if (threadIdx.x == 0) {
        unsigned* bar = b.bar;
        __builtin_amdgcn_s_waitcnt(0);
        unsigned nloc = b.st[0], nx = b.st[1];
        if (nloc == 0u) { xcd_barrier_complete(bar, b.x, nloc, nx); b.st[0] = nloc; b.st[1] = nx; }
        const unsigned old = xb_add(&bar[XB_XSUB(b.x)], 1u);
        const unsigned gen = old / nloc;
        if (old + 1u == (gen + 1u) * nloc) {
            __builtin_amdgcn_fence(__ATOMIC_RELEASE, XB_SCOPE);
            asm volatile("s_waitcnt vmcnt(0)" ::: "memory");
            const unsigned og = xb_add(&bar[XB_TOP], 1u);
            const unsigned tg = og / nx;
            if (og + 1u == (tg + 1u) * nx) xb_add(&bar[XB_TOPGEN], 1u);
            else XB_SPIN(xb_ld(&bar[XB_TOPGEN]) == tg, bar);
            __builtin_amdgcn_fence(__ATOMIC_ACQUIRE, XB_SCOPE);
            xb_add(&bar[XB_XGEN(b.x)], 1u);
            asm volatile("s_waitcnt vmcnt(0)" ::: "memory");
        } else {
            XB_SPIN(xb_ld(&bar[XB_XGEN(b.x)]) == gen, bar);
            __builtin_amdgcn_fence(__ATOMIC_ACQUIRE, XB_SCOPE);
            asm volatile("s_waitcnt vmcnt(0)" ::: "memory");
        }
    }
    __syncthreads();
}

struct Args { const float* in[18]; float* out; unsigned char* ws; };
static_assert(sizeof(Args) == 160, "Args layout");

__global__ void __launch_bounds__(NWAVES * 64, 2) mega_fwd(Args args) {
    extern __shared__ __attribute__((aligned(16))) unsigned char lds_raw[];
    cg::grid_group grid = cg::this_grid();
    LAS unsigned char* lds = (LAS unsigned char*)lds_raw;
    int tid = threadIdx.x, lane = tid & 63; const int wave = __builtin_amdgcn_readfirstlane(tid >> 6);
#define GRID_SYNC() do { XcdBarrier xb_; xb_.bar = ctl + 4096; xb_.x = xb_xcc_id(); xb_.st = (volatile LAS unsigned*)(lds + LDS_MISC) + 8; xcd_barrier(xb_); REBASE(); } while (0)
#define OPQ() do { asm volatile("" : "+v"(tid)); lane = tid & 63; } while (0)
    const int G = gridDim.x, blk = blockIdx.x;
    const int gw = blk * NWAVES + wave, ngw = G * NWAVES;
    const unsigned char* ka = (const unsigned char*)__builtin_amdgcn_kernarg_segment_ptr();
    unsigned char* ws = args.ws;
#define REBASE() do { asm volatile("" : "+s"(ka)); asm volatile("" : "+s"(ws)); } while (0)
#define INP(i) (*(const float* const*)(ka + 8 * (i)))
#define X_IN INP(0)
#define meta INP(1)
#define ffn1_up INP(2)
#define ffn1_down INP(3)
#define w_in INP(4)
#define b_gate INP(5)
#define conv_w INP(6)
#define q_norm_g INP(7)
#define w_uq INP(8)
#define kv_norm_g INP(9)
#define w_ukv INP(10)
#define w_br_conv INP(11)
#define w_br_mla INP(12)
#define w_o INP(13)
#define ffn2_up INP(14)
#define ffn2_down INP(15)
#define ln_g INP(16)
#define ln_b INP(17)
#define OUTP (*(float* const*)(ka + 144))
#define ctl ((unsigned*)(ws + OFF_CTL))
#define rope ((float*)(ws + OFF_ROPE))
#define hf ((float*)(ws + OFF_HF))
#define wreg (ws + OFF_W)
#define hb ((bf16*)(ws + S_HB))
#define act ((bf16*)(ws + S_ACT))
#define gates ((bf16*)(ws + S_GATES))
#define bch ((bf16*)(ws + S_BCH))
#define lat ((float*)(ws + S_LAT))
#define yconv ((bf16*)(ws + S_YCONV))
#define cqn ((bf16*)(ws + S_CQN))
#define ckvn ((bf16*)(ws + S_CKVN))
#define krb ((bf16*)(ws + S_KR))
#define Qb ((bf16*)(ws + S_Q))
#define Knb ((bf16*)(ws + S_KN))
#define Vtb ((bf16*)(ws + S_VT))
#define ymla ((bf16*)(ws + S_YMLA))
#define merged ((bf16*)(ws + S_MERGED))
    LAS float* scr = (LAS float*)(lds + wave * 16384);
    LAS unsigned char* ring = lds;
    if (threadIdx.x < 64) ((LAS unsigned*)(lds + LDS_MISC))[threadIdx.x] = 0u;
    __syncthreads();
    (void)xcd_barrier_post(ctl + 4096, (volatile LAS unsigned*)(lds + LDS_MISC) + 8);
    grid.sync();

#ifdef PROBE_DUMP_BIAS
    OPQ();
    for (int row = gw; row < BATCH * SEQ; row += ngw) { float* o = OUTP + (size_t)row * 1024; for (int c = lane; c < 1024; c += 64) o[c] = b_gate[c] + 2.0f * b_gate[1024 + c] + 4.0f * b_gate[2048 + c] + 8.0f * b_gate[3072 + c]; }
    return;
#endif
    OPQ();
    for (int row = gw; row < MPAD; row += ngw) {
        f32x4 v[4];
        if (row < M) { const int b = row / T, t = row - b * T; const f32x4* src = (const f32x4*)(t < N_META ? meta + (size_t)t * 1024 : X_IN + ((size_t)b * SEQ + (t - N_META)) * 1024) + lane;
#pragma unroll
            for (int j = 0; j < 4; ++j) v[j] = src[64 * j]; }
        else {
#pragma unroll
            for (int j = 0; j < 4; ++j) v[j] = (f32x4){0.f, 0.f, 0.f, 0.f}; }
#pragma unroll
        for (int j = 0; j < 4; ++j) { ((f32x4*)(hf + (size_t)row * 1024))[lane + 64 * j] = v[j]; v2u w; w.x = pk2(v[j].x, v[j].y); w.y = pk2(v[j].z, v[j].w); ((v2u*)(hb + (size_t)row * 1024))[lane + 64 * j] = w; }
    }
    for (int i = blk * 512 + tid; i < T * 16; i += G * 512) { const int t = i >> 4, k = i & 15;
        const float inv_freq = inv_freq_of(k); const float ang = (float)t * inv_freq;
        const double rev = (double)ang * 0.15915494309189535; const float fr = (float)(rev - floor(rev));
        rope[t * 32 + k] = __builtin_amdgcn_cosf(fr); rope[t * 32 + 16 + k] = __builtin_amdgcn_sinf(fr); }
    convert_ffn(ffn1_up, ffn1_down, wreg, scr, gw, ngw, lane);
    GRID_SYNC();

    for (int step = 0; step < 3 * DEPTH; ++step) {
        const int l = step / 3, sub = step % 3;
#ifdef PROBE_STEPS
        if (step == PROBE_STEPS) {
            OPQ();
            for (int row = gw; row < M; row += ngw) { const int b = row / T, t = row - b * T; if (t >= N_META) {
#pragma unroll
                for (int j = 0; j < 4; ++j) ((f32x4*)(OUTP + ((size_t)b * SEQ + (t - N_META)) * 1024))[lane + 64 * j] = ((const f32x4*)(hf + (size_t)row * 1024))[lane + 64 * j]; } }
            return;
        }
#endif
        if (sub != 1) {
            { pg8::Gemm g{hb, (const bf16*)(wreg + W_UP), MPAD, 2 * D_FF, 1024}; pg8::StaticOrder S; S.init(MPAD, 2 * D_FF, G, blk);
              pg8::EpiSwiGLU E{act, D_FF};
              pg8::gemm_phase<pg8::EpiSwiGLU, pg8::StaticOrder, true, true>(ring, g, S, E); }
            GRID_SYNC();
            tail_gemm(act + (size_t)MMAIN * D_FF, (const bf16*)(wreg + W_DOWN), D_FF, blk, lds, TailResid{hf + (size_t)MMAIN * 1024, ALPHA, 0.5f});
            { pg8::Gemm g{act, (const bf16*)(wreg + W_DOWN), MMAIN, 1024, D_FF}; pg8::StaticOrder S; S.init(MMAIN, 1024, G, blk);
              pg8::EpiResid E{hf, ALPHA, 0.5f};
              pg8::gemm_phase<pg8::EpiResid, pg8::StaticOrder, true, true>(ring, g, S, E); }
            GRID_SYNC();
            OPQ();
            const int li = (sub == 0) ? 0 : 2; const float* lg = ln_g + ((size_t)l * 3 + li) * 1024; const float* lb = ln_b + ((size_t)l * 3 + li) * 1024;
            const bool final_ln = (step == 3 * DEPTH - 1);
            for (int row = gw; row < MPAD; row += ngw) {
                if (!final_ln) ln_row(hf + (size_t)row * 1024, lg, lb, hf + (size_t)row * 1024, hb + (size_t)row * 1024, lane);
                else if (row < M) { const int b = row / T, t = row - b * T; if (t >= N_META) ln_row(hf + (size_t)row * 1024, lg, lb, OUTP + ((size_t)b * SEQ + (t - N_META)) * 1024, nullptr, lane); }
            }
            if (sub == 0) convert_mixer(w_in + (size_t)l * 1024 * D_IN, w_uq + (size_t)l * 256 * 768, w_ukv + (size_t)l * 128 * 1024, w_br_conv + (size_t)l * 512 * 1024, w_br_mla + (size_t)l * 512 * 1024, w_o + (size_t)l * 1024 * 1024, wreg, scr, gw, ngw, lane);
            else if (!final_ln) convert_ffn(ffn1_up + (size_t)(l + 1) * 1024 * 2 * D_FF, ffn1_down + (size_t)(l + 1) * D_FF * 1024, wreg, scr, gw, ngw, lane);
            if (!final_ln) GRID_SYNC();
        } else {
#ifdef PROBE_DUMP_BIAS1
            OPQ();
            for (int row = gw; row < BATCH * SEQ; row += ngw) { float* o = OUTP + (size_t)row * 1024; for (int c = lane; c < 1024; c += 64) o[c] = b_gate[c] + 2.0f * b_gate[1024 + c] + 4.0f * b_gate[2048 + c] + 8.0f * b_gate[3072 + c]; }
            return;
#endif
            { pg8::Gemm g{hb, (const bf16*)(wreg + W_IN), MPAD, D_INP, 1024}; pg8::StaticOrder S; S.init(MPAD, D_INP, G, blk);
              pg8::EpiInProj E{bch, lat, gates, b_gate + (size_t)l * 2048};
              pg8::gemm_phase<pg8::EpiInProj, pg8::StaticOrder, true, true>(ring, g, S, E); }
            GRID_SYNC();
#ifdef PROBE_DUMP_GATES0
            OPQ();
            for (int row = gw; row < M; row += ngw) { const int b = row / T, t = row - b * T; if (t >= N_META) { float* o = OUTP + ((size_t)b * SEQ + (t - N_META)) * 1024;
                for (int c = lane; c < 1024; c += 64) o[c] = pg8::bf_lo(gates[(size_t)row * 2048 + c]) + 2.0f * pg8::bf_lo(gates[(size_t)row * 2048 + 1024 + c]); } }
            return;
#endif
            OPQ();
            { const float* cw = conv_w + (size_t)l * 3 * 512; const float* qg = q_norm_g + (size_t)l * 256; const float* kg = kv_norm_g + (size_t)l * 128;
              for (int row = gw; row < MPAD; row += ngw) {
                int rr = row < M ? row : M - 1; const int b = rr / T, t = rr - b * T;
                f32x4 ua[2] = {(f32x4){0.f, 0.f, 0.f, 0.f}, (f32x4){0.f, 0.f, 0.f, 0.f}};
#pragma unroll
                for (int k = 0; k < 3; ++k) { const int dt = 2 - k;
                    if (t - dt >= 0 && row < M) { const bf16* rp = bch + (size_t)(row - dt) * 1536 + 8 * lane; const v4u c = *(const v4u*)(rp + 512), hh = *(const v4u*)(rp + 1024);
                        const f32x4 w0 = *(const f32x4*)(cw + k * 512 + 8 * lane), w1 = *(const f32x4*)(cw + k * 512 + 8 * lane + 4);
                        ua[0][0] += w0[0] * pg8::bf_lo(c.x) * pg8::bf_lo(hh.x); ua[0][1] += w0[1] * pg8::bf_hi(c.x) * pg8::bf_hi(hh.x);
                        ua[0][2] += w0[2] * pg8::bf_lo(c.y) * pg8::bf_lo(hh.y); ua[0][3] += w0[3] * pg8::bf_hi(c.y) * pg8::bf_hi(hh.y);
                        ua[1][0] += w1[0] * pg8::bf_lo(c.z) * pg8::bf_lo(hh.z); ua[1][1] += w1[1] * pg8::bf_hi(c.z) * pg8::bf_hi(hh.z);
                        ua[1][2] += w1[2] * pg8::bf_lo(c.w) * pg8::bf_lo(hh.w); ua[1][3] += w1[3] * pg8::bf_hi(c.w) * pg8::bf_hi(hh.w); } }
                { const v4u bb = *(const v4u*)(bch + (size_t)row * 1536 + 8 * lane);
                  v4u o; o.x = pk2(ua[0][0] * pg8::bf_lo(bb.x), ua[0][1] * pg8::bf_hi(bb.x)); o.y = pk2(ua[0][2] * pg8::bf_lo(bb.y), ua[0][3] * pg8::bf_hi(bb.y));
                  o.z = pk2(ua[1][0] * pg8::bf_lo(bb.z), ua[1][1] * pg8::bf_hi(bb.z)); o.w = pk2(ua[1][2] * pg8::bf_lo(bb.w), ua[1][3] * pg8::bf_hi(bb.w));
                  *(v4u*)(yconv + (size_t)row * 512 + 8 * lane) = o; }
                const float* lr = lat + (size_t)row * 512;
                { const f32x4 v = *(const f32x4*)(lr + 4 * lane); const float ss = wave_sum((v.x * v.x + v.y * v.y) + (v.z * v.z + v.w * v.w));
                  const float rs = 1.f / sqrtf(ss * (1.f / 256.f) + RMS_EPS); const f32x4 gg = *(const f32x4*)(qg + 4 * lane);
                  v2u w; w.x = pk2(v.x * rs * gg.x, v.y * rs * gg.y); w.y = pk2(v.z * rs * gg.z, v.w * rs * gg.w); *(v2u*)(cqn + (size_t)row * 256 + 4 * lane) = w; }
                { const f32x2 v = *(const f32x2*)(lr + 256 + 2 * lane); const float ss = wave_sum(v.x * v.x + v.y * v.y);
                  const float rs = 1.f / sqrtf(ss * (1.f / 128.f) + RMS_EPS); const f32x2 gg = *(const f32x2*)(kg + 2 * lane);
                  *(unsigned*)(ckvn + (size_t)row * 256 + 2 * lane) = pk2(v.x * rs * gg.x, v.y * rs * gg.y); *(unsigned*)(ckvn + (size_t)row * 256 + 128 + 2 * lane) = 0u; }
                if (lane < 16) { const float x1 = lr[384 + lane], x2 = lr[400 + lane], cs = rope[t * 32 + lane], sn = rope[t * 32 + 16 + lane];
                  const unsigned w = pk2(x1 * cs - x2 * sn, x2 * cs + x1 * sn); krb[(size_t)row * 32 + lane] = (bf16)(w & 0xffffu); krb[(size_t)row * 32 + 16 + lane] = (bf16)(w >> 16); }
              } }
            GRID_SYNC();
#ifdef PROBE_DUMP_GATES
            OPQ();
            for (int row = gw; row < M; row += ngw) { const int b = row / T, t = row - b * T; if (t >= N_META) { float* o = OUTP + ((size_t)b * SEQ + (t - N_META)) * 1024;
                for (int c = lane; c < 1024; c += 64) o[c] = pg8::bf_lo(gates[(size_t)row * 2048 + c]) + 2.0f * pg8::bf_lo(gates[(size_t)row * 2048 + 1024 + c]); } }
            return;
#endif
#ifdef PROBE_DUMP_ROWPREP
            OPQ();
            for (int row = gw; row < M; row += ngw) { const int b = row / T, t = row - b * T; if (t >= N_META) { float* o = OUTP + ((size_t)b * SEQ + (t - N_META)) * 1024;
                for (int c = lane; c < 1024; c += 64) { float v = 0.f;
                    if (c < 512) v = pg8::bf_lo(yconv[(size_t)row * 512 + c]); else if (c < 768) v = pg8::bf_lo(cqn[(size_t)row * 256 + c - 512]); else if (c < 896) v = pg8::bf_lo(ckvn[(size_t)row * 256 + c - 768]); else if (c < 928) v = pg8::bf_lo(krb[(size_t)row * 32 + c - 896]);
                    else if (c < 960) v = lat[(size_t)row * 512 + 384 + c - 928];
                    o[c] = v; } } }
            return;
#endif
            OPQ();
            for (int i = blk * 512 + tid; i < BATCH * NHEAD * 64 * (TP - T); i += G * 512) { const int r = i / (TP - T), c = i % (TP - T); Vtb[(size_t)r * TP + T + c] = 0; }
            { pg8::Gemm g{cqn, (const bf16*)(wreg + W_UQ), MPAD, 768, 256}; pg8::StaticOrder S; S.init(MPAD, 768, G, blk);
              pg8::EpiPlain E{Qb, 768, QSCALE};
              pg8::gemm_phase<pg8::EpiPlain, pg8::StaticOrder, true, true>(ring, g, S, E); }
            { pg8::Gemm g{ckvn, (const bf16*)(wreg + W_UKV), MPAD, 512, 256}; pg8::StaticOrder S; S.init(MPAD, 512, G, blk);
              pg8::EpiPlain E{Knb, 512, 1.0f};
              pg8::gemm_phase<pg8::EpiPlain, pg8::StaticOrder, true, true>(ring, g, S, E); }
            { pg8::Gemm g{(const bf16*)(wreg + W_UKV) + 512 * 256, ckvn, 512, MPAD, 256}; pg8::StaticOrder S; S.init(512, MPAD, G, blk);
              pg8::EpiVt E{Vtb};
              pg8::gemm_phase<pg8::EpiVt, pg8::StaticOrder, true, true>(ring, g, S, E); }
            GRID_SYNC();
            OPQ();
#ifdef PROBE_NOATTN
            for (size_t i = (size_t)blk * 512 + tid; i < (size_t)MPAD * 512 / 8; i += (size_t)G * 512) ((v4u*)ymla)[i] = (v4u){0u, 0u, 0u, 0u};
            if (false)
#endif
#ifdef PROBE_ATTN_TWICE
            for (int rep = 0; rep < 2; ++rep)
            { const int grp = blk & 7; unsigned* qctr = ctl + 64 * (rep * 16 + l * 8 + grp);
#else
            { const int grp = blk & 7; unsigned* qctr = ctl + 64 * (l * 8 + grp);
#endif
              volatile LAS unsigned* bc = (volatile LAS unsigned*)(lds + LDS_MISC);
              for (;;) {
                  if (tid == 0) bc[0] = atomicAdd(qctr, 1u);
                  __syncthreads();
                  const unsigned u = bc[0];
                  __syncthreads();
                  if (u >= 132u) break;
                  const int qb = 32 - (int)(u >> 2), bh = grp * 4 + (int)(u & 3u);
                  att::attn_unit(bh >> 3, bh & 7, qb, Qb, Knb, krb, Vtb, rope, ymla, lds);
              } }
            GRID_SYNC();
            tail_gemm(yconv + (size_t)MMAIN * 512, (const bf16*)(wreg + W_BC), 512, blk, lds, TailGate<false>{merged + (size_t)MMAIN * 1024, gates + (size_t)MMAIN * 2048});
            tail_gemm(ymla + (size_t)MMAIN * 512, (const bf16*)(wreg + W_BM), 512, blk, lds, TailGate<true>{merged + (size_t)MMAIN * 1024, gates + (size_t)MMAIN * 2048 + 1024});
            { pg8::Gemm g{yconv, (const bf16*)(wreg + W_BC), MMAIN, 1024, 512}; pg8::StaticOrder S; S.init(MMAIN, 1024, G, blk);
              pg8::EpiGate<false> E{merged, gates};
              pg8::gemm_phase<pg8::EpiGate<false>, pg8::StaticOrder, true, true>(ring, g, S, E); }
#ifdef PROBE_SYNC_BETWEEN
            GRID_SYNC();
#endif
#ifndef PROBE_SKIP_BR2
            { pg8::Gemm g{ymla, (const bf16*)(wreg + W_BM), MMAIN, 1024, 512}; pg8::StaticOrder S; S.init(MMAIN, 1024, G, blk);
              pg8::EpiGate<true> E{merged, gates + 1024};
              pg8::gemm_phase<pg8::EpiGate<true>, pg8::StaticOrder, true, true>(ring, g, S, E); }
#endif
            GRID_SYNC();
#ifdef PROBE_DUMP_MERGED
            OPQ();
            for (int row = gw; row < M; row += ngw) { const int b = row / T, t = row - b * T; if (t >= N_META) { float* o = OUTP + ((size_t)b * SEQ + (t - N_META)) * 1024;
                for (int c = lane; c < 1024; c += 64) o[c] = pg8::bf_lo(merged[(size_t)row * 1024 + c]); } }
            return;
#endif
            tail_gemm(merged + (size_t)MMAIN * 1024, (const bf16*)(wreg + W_O), 1024, blk, lds, TailResid{hf + (size_t)MMAIN * 1024, ALPHA, 1.0f});
            { pg8::Gemm g{merged, (const bf16*)(wreg + W_O), MMAIN, 1024, 1024}; pg8::StaticOrder S; S.init(MMAIN, 1024, G, blk);
              pg8::EpiResid E{hf, ALPHA, 1.0f};
              pg8::gemm_phase<pg8::EpiResid, pg8::StaticOrder, true, true>(ring, g, S, E); }
            GRID_SYNC();
            OPQ();
            { const float* lg = ln_g + ((size_t)l * 3 + 1) * 1024; const float* lb = ln_b + ((size_t)l * 3 + 1) * 1024;
              for (int row = gw; row < MPAD; row += ngw) ln_row(hf + (size_t)row * 1024, lg, lb, hf + (size_t)row * 1024, hb + (size_t)row * 1024, lane);
              convert_ffn(ffn2_up + (size_t)l * 1024 * 2 * D_FF, ffn2_down + (size_t)l * D_FF * 1024, wreg, scr, gw, ngw, lane); }
            GRID_SYNC();
        }
    }
}

extern "C" void kernel_launch(void* const* d_in, const int* in_sizes, int n_in, void* d_out, int out_size, void* d_ws, size_t ws_size, hipStream_t stream) {
    static int grid = 0;
    if (grid == 0) {
        if (n_in != 18 || ws_size < WS_NEED) { fprintf(stderr, "kernel_launch: expected 18 inputs and >= %zu bytes of workspace; got %d, %zu\n", (size_t)WS_NEED, n_in, ws_size); grid = -1; return; }
        int dev = 0, cus = 0, per_cu = 0;
        hipGetDevice(&dev); hipDeviceGetAttribute(&cus, hipDeviceAttributeMultiprocessorCount, dev);
        if (hipFuncSetAttribute((const void*)mega_fwd, hipFuncAttributeMaxDynamicSharedMemorySize, LDS_BYTES) != hipSuccess) { fprintf(stderr, "kernel_launch: hipFuncSetAttribute failed\n"); grid = -1; return; }
        hipOccupancyMaxActiveBlocksPerMultiprocessor(&per_cu, (const void*)mega_fwd, NWAVES * 64, LDS_BYTES);
        (void)hipGetLastError();
        if (per_cu < 1) per_cu = 1;
        grid = cus;
    }
    if (grid < 0) return;
    (void)hipMemsetAsync((char*)d_ws + OFF_CTL, 0, 65536, stream);
    Args a{};
    for (int i = 0; i < 18; ++i) a.in[i] = (const float*)d_in[i];
    a.out = (float*)d_out; a.ws = (unsigned char*)d_ws;
    void* params[] = {&a};
    hipError_t e = hipLaunchCooperativeKernel((const void*)mega_fwd, dim3(grid), dim3(NWAVES * 64), params, LDS_BYTES, stream);
    if (e != hipSuccess) fprintf(stderr, "cooperative launch failed: %s (grid %d)\n", hipGetErrorString(e), grid);
}
```

```cpp
#include <hip/hip_runtime.h>
#include <cstdio>
#include <cstdint>
namespace pg8 {
#define PG8_LAS __attribute__((address_space(3)))
typedef unsigned short bf16_t;
typedef short bf16x8 __attribute__((ext_vector_type(8)));
typedef float f32x4 __attribute__((ext_vector_type(4)));
typedef unsigned u32x4 __attribute__((ext_vector_type(4)));
constexpr int BM = 256, BK = 64, HALF = 128, HTB = HALF * BK * 2  , STAGE_BYTES = 8 * HTB, NXCD = 8, WGM = 8;

__host__ __device__ __forceinline__ int lds_byte(int r, int c) { const int st = (r >> 4) * 2 + (c >> 5), rr = r & 15, cc = c & 31, ob = rr * 64 + cc * 2; return st * 1024 + (ob ^ (((ob >> 9) & 1) << 5)); }
__host__ __device__ __forceinline__ void stage_rc(int b, int& R, int& C) { const int st = b / 1024, sb = b % 1024, swz = sb ^ (((sb >> 9) & 1) << 5); R = (st >> 1) * 16 + swz / 64; C = (st & 1) * 32 + (swz % 64) / 2; }
__host__ __device__ __forceinline__ int perm32(int rho) { const int n = rho >> 4, i = rho & 15; return 8 * (i >> 2) + 4 * n + (i & 3); }

struct Unit { int pm, pn; };
struct Gemm { const bf16_t* A; const bf16_t* Bt; int M, N, K; };

struct StaticOrder {
    int nM, nN, nwg, G, c;
    __host__ __device__ void init(int M, int N, int G_, int c_) { nM = M / BM; nN = N / BM; nwg = nM * nN; G = G_; c = c_; }
    __host__ __device__ bool next(int i, Unit& u) const {
        const long L = (long)i * G + c; if (L >= nwg) return false;
        int wgid = (int)L; { const int q = nwg / NXCD, r = nwg % NXCD, xcd = wgid % NXCD, off = wgid / NXCD; wgid = (xcd < r ? xcd * (q + 1) : r * (q + 1) + (xcd - r) * q) + off; }
        const int nig = WGM * nN, gid = wgid / nig, fm = gid * WGM, gsz = (nM - fm) < WGM ? (nM - fm) : WGM;
        u.pm = fm + ((wgid % nig) % gsz); u.pn = (wgid % nig) / gsz; return true;
    }
    __device__ __forceinline__ void a_ready(const Unit&) const {}
    __device__ __forceinline__ void done(const Unit&) const {}
};

struct SignalOrder : StaticOrder {
    unsigned* tot_main; unsigned* tot_tail;
    __device__ __forceinline__ void done(const Unit& u) const {
        asm volatile("s_waitcnt vmcnt(0)" ::: "memory");
        if ((threadIdx.x & 63) == 0) __hip_atomic_fetch_add(u.pm < 128 ? tot_main : tot_tail, 1u, __ATOMIC_RELAXED, __HIP_MEMORY_SCOPE_AGENT);
    }
};
typedef float f32x2 __attribute__((ext_vector_type(2)));
typedef __bf16 bf16x2_cv __attribute__((ext_vector_type(2)));
__device__ __forceinline__ unsigned cvt_pk_bf16(float lo, float hi) { f32x2 v = {lo, hi}; bf16x2_cv b = __builtin_convertvector(v, bf16x2_cv); return __builtin_bit_cast(unsigned, b); }
__device__ __forceinline__ float fast_sigmoid(float x) { return __builtin_amdgcn_rcpf(1.0f + __builtin_amdgcn_exp2f(-1.4426950408889634f * x)); }
__device__ __forceinline__ u32x4 pack8(const f32x4 a, const f32x4 b) { u32x4 w; w.x = cvt_pk_bf16(a[0], a[1]); w.y = cvt_pk_bf16(a[2], a[3]); w.z = cvt_pk_bf16(b[0], b[1]); w.w = cvt_pk_bf16(b[2], b[3]); return w; }
typedef unsigned u32x2 __attribute__((ext_vector_type(2)));
__device__ __forceinline__ float bf_lo(unsigned w) { return __uint_as_float(w << 16); }
__device__ __forceinline__ float bf_hi(unsigned w) { return __uint_as_float(w & 0xffff0000u); }

struct EpiSwiGLU {
    static constexpr bool PERM = true, AFTER_DRAIN = false;
    bf16_t* O; int ldc;
    __device__ __forceinline__ void operator()(const f32x4 (&acc)[2][2][4][2], const Unit& u, int wr, int wc, int fr, int fq) const {
        const int row0 = u.pm * BM + wr * 64 + fr; const int col0 = u.pn * 128 + wc * 32 + 8 * fq;
#pragma unroll
        for (int ai = 0; ai < 2; ++ai)
#pragma unroll
            for (int m = 0; m < 4; ++m) {
                f32x4 v[2];
#pragma unroll
                for (int n = 0; n < 2; ++n) { const f32x4 g = acc[ai][0][m][n], up = acc[ai][1][m][n];
#pragma unroll
                    for (int j = 0; j < 4; ++j) v[n][j] = g[j] * fast_sigmoid(g[j]) * up[j]; }
                *(u32x4*)(O + (size_t)(row0 + ai * HALF + m * 16) * ldc + col0) = pack8(v[0], v[1]);
            }
    }
};
__device__ __forceinline__ void st_wt(float* p, const f32x4 v) { asm volatile("global_store_dwordx4 %0, %1, off sc0 sc1" :: "v"(p), "v"(v) : "memory"); }
struct EpiResid {
    static constexpr bool PERM = true, AFTER_DRAIN = false, WT = false;
    float* H; float alpha, coef;
    __device__ __forceinline__ void operator()(const f32x4 (&acc)[2][2][4][2], const Unit& u, int wr, int wc, int fr, int fq) const {
        const int row0 = u.pm * BM + wr * 64 + fr; const int col0 = u.pn * BM + wc * 32 + 8 * fq;
#pragma unroll
        for (int ai = 0; ai < 2; ++ai)
#pragma unroll
            for (int m = 0; m < 4; ++m) {
                float* rp = H + (size_t)(row0 + ai * HALF + m * 16) * 1024 + col0;
#pragma unroll
                for (int bj = 0; bj < 2; ++bj) {
                    f32x4 a = *(const f32x4*)(rp + bj * HALF), b = *(const f32x4*)(rp + bj * HALF + 4);
                    a = a * alpha + acc[ai][bj][m][0] * coef; b = b * alpha + acc[ai][bj][m][1] * coef;
                    if (WT) { st_wt(rp + bj * HALF, a); st_wt(rp + bj * HALF + 4, b); } else { *(f32x4*)(rp + bj * HALF) = a; *(f32x4*)(rp + bj * HALF + 4) = b; }
                }
            }
    }
};
struct EpiInProj {
    static constexpr bool PERM = true, AFTER_DRAIN = false;
    bf16_t* bch; float* lat; bf16_t* gates; const float* bgate;
    __device__ __forceinline__ void operator()(const f32x4 (&acc)[2][2][4][2], const Unit& u, int wr, int wc, int fr, int fq) const {
        const int row0 = u.pm * BM + wr * 64 + fr; const int cw = wc * 32 + 8 * fq; const int pn = u.pn;
        if (pn < 6) {
#pragma unroll
            for (int ai = 0; ai < 2; ++ai)
#pragma unroll
                for (int m = 0; m < 4; ++m) { bf16_t* rp = bch + (size_t)(row0 + ai * HALF + m * 16) * 1536 + pn * BM + cw;
#pragma unroll
                    for (int bj = 0; bj < 2; ++bj) *(u32x4*)(rp + bj * HALF) = pack8(acc[ai][bj][m][0], acc[ai][bj][m][1]); }
        } else if (pn < 8) {
#pragma unroll
            for (int ai = 0; ai < 2; ++ai)
#pragma unroll
                for (int m = 0; m < 4; ++m) { float* rp = lat + (size_t)(row0 + ai * HALF + m * 16) * 512 + (pn - 6) * BM + cw;
#pragma unroll
                    for (int bj = 0; bj < 2; ++bj) { *(f32x4*)(rp + bj * HALF) = acc[ai][bj][m][0]; *(f32x4*)(rp + bj * HALF + 4) = acc[ai][bj][m][1]; } }
        } else {
            const int gc = (pn - 8) * BM + cw;
            f32x4 bv[2][2];
#pragma unroll
            for (int bj = 0; bj < 2; ++bj)
#pragma unroll
                for (int n = 0; n < 2; ++n) bv[bj][n] = *(const f32x4*)(bgate + gc + bj * HALF + 4 * n);
#pragma unroll
            for (int ai = 0; ai < 2; ++ai)
#pragma unroll
                for (int m = 0; m < 4; ++m) { bf16_t* rp = gates + (size_t)(row0 + ai * HALF + m * 16) * 2048 + gc;
#pragma unroll
                    for (int bj = 0; bj < 2; ++bj) { f32x4 v[2];
#pragma unroll
                        for (int n = 0; n < 2; ++n) {
#ifdef PROBE_NO_BIAS
                            const f32x4 x = acc[ai][bj][m][n];
#else
                            const f32x4 x = acc[ai][bj][m][n] + bv[bj][n];
#endif
#pragma unroll
                            for (int j = 0; j < 4; ++j) {
#ifdef PROBE_PLAIN_GATES
                                v[n][j] = acc[ai][bj][m][n][j];
#elif defined(PROBE_BV_GATES)
                                v[n][j] = bv[bj][n][j] * 16.0f;
#else
                                v[n][j] = fast_sigmoid(x[j]);
#endif
                            } }
                        *(u32x4*)(rp + bj * HALF) = pack8(v[0], v[1]); } }
        }
    }
};
struct EpiPlain {
    static constexpr bool PERM = true, AFTER_DRAIN = false;
    bf16_t* O; int ldc; float scale;
    __device__ __forceinline__ void operator()(const f32x4 (&acc)[2][2][4][2], const Unit& u, int wr, int wc, int fr, int fq) const {
        const int row0 = u.pm * BM + wr * 64 + fr; const int col0 = u.pn * BM + wc * 32 + 8 * fq;
#pragma unroll
        for (int ai = 0; ai < 2; ++ai)
#pragma unroll
            for (int m = 0; m < 4; ++m) { bf16_t* rp = O + (size_t)(row0 + ai * HALF + m * 16) * ldc + col0;
#pragma unroll
                for (int bj = 0; bj < 2; ++bj) *(u32x4*)(rp + bj * HALF) = pack8(acc[ai][bj][m][0] * scale, acc[ai][bj][m][1] * scale); }
    }
};
struct EpiVt {
    static constexpr bool PERM = false, AFTER_DRAIN = false;
    bf16_t* Vt;
    __device__ __forceinline__ void operator()(const f32x4 (&acc)[2][2][4][2], const Unit& u, int wr, int wc, int fr, int fq) const {
        constexpr int T_ = 8208, TP_ = 8320, M_ = 4 * 8208;
        const int feat0 = u.pm * BM + wr * 64 + fr; const int pos = 8 * (fq & 1) + 4 * (fq >> 1);
#pragma unroll
        for (int bj = 0; bj < 2; ++bj)
#pragma unroll
            for (int n = 0; n < 2; ++n) {
                const int tok0 = u.pn * BM + bj * HALF + wc * 32 + n * 16;
                if (tok0 < M_) {
                    const int b = tok0 / T_, t0 = tok0 - b * T_;
                    bf16_t* vp = Vt + ((size_t)b * 512 + feat0) * TP_ + t0 + pos;
#pragma unroll
                    for (int ai = 0; ai < 2; ++ai)
#pragma unroll
                        for (int m = 0; m < 4; ++m) { const f32x4 x = acc[ai][bj][m][n]; u32x2 w; w.x = cvt_pk_bf16(x[0], x[1]); w.y = cvt_pk_bf16(x[2], x[3]);
                            *(u32x2*)(vp + (size_t)(ai * HALF + m * 16) * TP_) = w; }
                }
            }
    }
};
template <bool ACCUM> struct EpiGate {
    static constexpr bool PERM = true, AFTER_DRAIN = false;
    bf16_t* O; const bf16_t* G;
    __device__ __forceinline__ void operator()(const f32x4 (&acc)[2][2][4][2], const Unit& u, int wr, int wc, int fr, int fq) const {
        const int row0 = u.pm * BM + wr * 64 + fr; const int col0 = u.pn * BM + wc * 32 + 8 * fq;
#pragma unroll
        for (int ai = 0; ai < 2; ++ai)
#pragma unroll
            for (int m = 0; m < 4; ++m) { const size_t row = (size_t)(row0 + ai * HALF + m * 16);
#pragma unroll
                for (int bj = 0; bj < 2; ++bj) {
                    const u32x4 g = *(const u32x4*)(G + row * 2048 + col0 + bj * HALF);
                    f32x4 a = acc[ai][bj][m][0], b = acc[ai][bj][m][1];
                    a[0] *= bf_lo(g.x); a[1] *= bf_hi(g.x); a[2] *= bf_lo(g.y); a[3] *= bf_hi(g.y);
                    b[0] *= bf_lo(g.z); b[1] *= bf_hi(g.z); b[2] *= bf_lo(g.w); b[3] *= bf_hi(g.w);
                    bf16_t* op = O + row * 1024 + col0 + bj * HALF;
                    if (ACCUM) { const u32x4 p = *(const u32x4*)op;
                        a[0] += bf_lo(p.x); a[1] += bf_hi(p.x); a[2] += bf_lo(p.y); a[3] += bf_hi(p.y);
                        b[0] += bf_lo(p.z); b[1] += bf_hi(p.z); b[2] += bf_lo(p.w); b[3] += bf_hi(p.w); }
                    *(u32x4*)op = pack8(a, b);
                }
            }
    }
};

template <class Epi, class Sched, bool ALIGN_EPI = false, bool SP2 = false>
__device__ __forceinline__ void gemm_phase(PG8_LAS unsigned char* lds, const Gemm g, const Sched& S, const Epi& E) {
    int tid_ = threadIdx.x; asm volatile("" : "+v"(tid_));
    const int tid = tid_, wid = __builtin_amdgcn_readfirstlane(tid >> 6), lane = tid & 63, wr = wid >> 2, wc = wid & 3, fr = lane & 15, fq = lane >> 4;
    int K_ = g.K; asm volatile("" : "+s"(K_));
    const int K = K_, nt = K / BK;
    unsigned voffA[2], voffB[2];
#pragma unroll
    for (int i = 0; i < 2; ++i) { int R, C; stage_rc(tid * 16 + i * 8192, R, C); const int Rb = Epi::PERM ? ((R & ~31) + perm32(R & 31)) : R;
        voffA[i] = (unsigned)(R * K + C) * 2u; voffB[i] = (unsigned)(Rb * K + C) * 2u; }
    const size_t kstep = (size_t)(BK * 2);
    const size_t hstep = (size_t)HALF * K * 2;
    const size_t tstep = 2 * hstep;
    const unsigned ldsw = (unsigned)wid * 1024u;
    const int aoff = lds_byte(wr * 64 + fr, fq * 8), boff = lds_byte(wc * 32 + fr, fq * 8);
#define PG8_SA(b, h) (((b) * 2 + (h)) * HTB)
#define PG8_SB(b, h) ((4 + (b) * 2 + (h)) * HTB)
#define PG8_STAGE(bufoff, gbase, voff) do { _Pragma("unroll") for (int _i = 0; _i < 2; ++_i) \
        __builtin_amdgcn_global_load_lds((const unsigned*)((const char*)(gbase) + (voff)[_i]), (PG8_LAS unsigned*)(lds + (bufoff) + ldsw + _i * 8192), 16, 0, 0); } while (0)
#define PG8_LDA(dst, b, h) do { _Pragma("unroll") for (int m = 0; m < 4; ++m) _Pragma("unroll") for (int k = 0; k < 2; ++k) dst[m][k] = *(const PG8_LAS bf16x8*)(lds + PG8_SA(b, h) + aoff + m * 2048 + k * 1024); } while (0)
#define PG8_LDB(dst, b, h) do { _Pragma("unroll") for (int n = 0; n < 2; ++n) _Pragma("unroll") for (int k = 0; k < 2; ++k) dst[n][k] = *(const PG8_LAS bf16x8*)(lds + PG8_SB(b, h) + boff + n * 2048 + k * 1024); } while (0)
#define PG8_MMA(ai, bj, At, Bt) do { __builtin_amdgcn_s_setprio(1); _Pragma("unroll") for (int m = 0; m < 4; ++m) _Pragma("unroll") for (int n = 0; n < 2; ++n) _Pragma("unroll") for (int k = 0; k < 2; ++k) \
        acc[ai][bj][m][n] = __builtin_amdgcn_mfma_f32_16x16x32_bf16(Bt[n][k], At[m][k], acc[ai][bj][m][n], 0, 0, 0); __builtin_amdgcn_s_setprio(0); } while (0)
#define PG8_WAIT_V(n) asm volatile("s_waitcnt vmcnt(" #n ")" ::: "memory")
#define PG8_WAIT_L(n) asm volatile("s_waitcnt lgkmcnt(" #n ")" ::: "memory")
#define PG8_BAR __builtin_amdgcn_s_barrier()
#define PG8_SCHED __builtin_amdgcn_sched_barrier(0)
    Unit cur, nxt; int ui = 0;
    if (!S.next(0, cur)) return;
    f32x4 acc[2][2][4][2];
#pragma unroll
    for (int a = 0; a < 2; ++a)
#pragma unroll
        for (int b = 0; b < 2; ++b)
#pragma unroll
            for (int m = 0; m < 4; ++m)
#pragma unroll
                for (int n = 0; n < 2; ++n) acc[a][b][m][n] = (f32x4){0.f, 0.f, 0.f, 0.f};
    bf16x8 At[4][2], B0[2][2], B1[2][2];
    const char* cA = (const char*)g.A + (size_t)cur.pm * tstep; const char* cB = (const char*)g.Bt + (size_t)cur.pn * tstep;
    S.a_ready(cur);
    if constexpr (SP2) {
        PG8_STAGE(PG8_SB(0, 0), cB, voffB); PG8_STAGE(PG8_SB(0, 1), cB + hstep, voffB); PG8_STAGE(PG8_SA(0, 0), cA, voffA); PG8_STAGE(PG8_SA(0, 1), cA + hstep, voffA);
        if (wr == 1) PG8_BAR;
        PG8_WAIT_V(2); PG8_BAR;
        PG8_STAGE(PG8_SB(1, 0), cB + kstep, voffB); PG8_STAGE(PG8_SA(1, 0), cA + kstep, voffA); PG8_STAGE(PG8_SB(1, 1), cB + hstep + kstep, voffB);
        PG8_WAIT_V(6); PG8_BAR;
    } else {
        PG8_STAGE(PG8_SB(0, 0), cB, voffB); PG8_STAGE(PG8_SA(0, 0), cA, voffA); PG8_STAGE(PG8_SB(0, 1), cB + hstep, voffB); PG8_STAGE(PG8_SA(0, 1), cA + hstep, voffA);
        if (wr == 1) PG8_BAR;
        PG8_WAIT_V(4); PG8_BAR;
        PG8_STAGE(PG8_SB(1, 0), cB + kstep, voffB); PG8_STAGE(PG8_SA(1, 0), cA + kstep, voffA); PG8_STAGE(PG8_SB(1, 1), cB + hstep + kstep, voffB);
        PG8_WAIT_V(6); PG8_BAR;
    }
    for (;;) {
        const bool has_next = S.next(ui + 1, nxt);
        const char* nA = has_next ? (const char*)g.A + (size_t)nxt.pm * tstep : cA; const char* nB = has_next ? (const char*)g.Bt + (size_t)nxt.pn * tstep : cB;
        for (int t = 0; t < nt; t += 2) {
            const bool last = (t == nt - 2);
            const char* a1 = cA + (size_t)(t + 1) * kstep;
            const char* a2 = last ? nA : cA + (size_t)(t + 2) * kstep; const char* b2 = last ? nB : cB + (size_t)(t + 2) * kstep;
            const char* a3 = a2 + kstep; const char* b3 = b2 + kstep;
            if (last && has_next) S.a_ready(nxt);
            if constexpr (SP2) {
            PG8_LDB(B0, 0, 0); PG8_LDB(B1, 0, 1); PG8_SCHED; PG8_LDA(At, 0, 0); PG8_STAGE(PG8_SA(1, 1), a1 + hstep, voffA);
            PG8_WAIT_V(8); PG8_WAIT_L(0); PG8_BAR; PG8_MMA(0, 0, At, B0); PG8_MMA(0, 1, At, B1); PG8_BAR; PG8_SCHED;
            PG8_LDA(At, 0, 1); PG8_STAGE(PG8_SB(0, 0), b2, voffB); PG8_STAGE(PG8_SB(0, 1), b2 + hstep, voffB); PG8_STAGE(PG8_SA(0, 0), a2, voffA);
            PG8_WAIT_V(8); PG8_WAIT_L(0); PG8_BAR; PG8_MMA(1, 0, At, B0); PG8_MMA(1, 1, At, B1); PG8_BAR; PG8_SCHED;
            PG8_LDB(B0, 1, 0); PG8_LDB(B1, 1, 1); PG8_SCHED; PG8_LDA(At, 1, 0); PG8_STAGE(PG8_SA(0, 1), a2 + hstep, voffA);
            PG8_WAIT_V(8); PG8_WAIT_L(0); PG8_BAR; PG8_MMA(0, 0, At, B0); PG8_MMA(0, 1, At, B1); PG8_BAR; PG8_SCHED;
            PG8_LDA(At, 1, 1); PG8_STAGE(PG8_SB(1, 0), b3, voffB); PG8_STAGE(PG8_SB(1, 1), b3 + hstep, voffB); PG8_STAGE(PG8_SA(1, 0), a3, voffA);
            PG8_WAIT_V(8); PG8_WAIT_L(0); PG8_BAR; PG8_MMA(1, 0, At, B0); PG8_MMA(1, 1, At, B1); PG8_BAR; PG8_SCHED;
            } else {
            PG8_LDB(B0, 0, 0); PG8_SCHED; PG8_LDA(At, 0, 0); PG8_STAGE(PG8_SA(1, 1), a1 + hstep, voffA);
            PG8_WAIT_L(8); PG8_BAR; PG8_WAIT_L(0); PG8_MMA(0, 0, At, B0); PG8_BAR; PG8_SCHED;
            PG8_LDB(B1, 0, 1); PG8_STAGE(PG8_SB(0, 0), b2, voffB);
            PG8_BAR; PG8_WAIT_L(0); PG8_MMA(0, 1, At, B1); PG8_BAR;
            PG8_LDA(At, 0, 1); PG8_STAGE(PG8_SA(0, 0), a2, voffA);
            PG8_BAR; PG8_WAIT_L(0); PG8_MMA(1, 0, At, B0); PG8_BAR; PG8_SCHED;
            PG8_STAGE(PG8_SB(0, 1), b2 + hstep, voffB);
            PG8_WAIT_V(6); PG8_BAR; PG8_MMA(1, 1, At, B1); PG8_BAR;
            PG8_LDB(B0, 1, 0); PG8_SCHED; PG8_LDA(At, 1, 0); PG8_STAGE(PG8_SA(0, 1), a2 + hstep, voffA);
            PG8_WAIT_L(8); PG8_BAR; PG8_WAIT_L(0); PG8_MMA(0, 0, At, B0); PG8_BAR; PG8_SCHED;
            PG8_LDB(B1, 1, 1); PG8_STAGE(PG8_SB(1, 0), b3, voffB);
            PG8_BAR; PG8_WAIT_L(0); PG8_MMA(0, 1, At, B1); PG8_BAR;
            PG8_LDA(At, 1, 1); PG8_STAGE(PG8_SA(1, 0), a3, voffA);
            PG8_BAR; PG8_WAIT_L(0); PG8_MMA(1, 0, At, B0); PG8_BAR; PG8_SCHED;
            PG8_STAGE(PG8_SB(1, 1), b3 + hstep, voffB);
            PG8_WAIT_V(6); PG8_BAR; PG8_MMA(1, 1, At, B1); PG8_BAR;
            }
        }
        if constexpr (ALIGN_EPI) { if (wr == 0) PG8_BAR; }
        if constexpr (!Epi::AFTER_DRAIN) { E(acc, cur, wr, wc, fr, fq); S.done(cur); }
        if (!has_next) break;
#pragma unroll
        for (int a = 0; a < 2; ++a)
#pragma unroll
            for (int b = 0; b < 2; ++b)
#pragma unroll
                for (int m = 0; m < 4; ++m)
#pragma unroll
                    for (int n = 0; n < 2; ++n) acc[a][b][m][n] = (f32x4){0.f, 0.f, 0.f, 0.f};
        cur = nxt; cA = nA; cB = nB; ++ui;
        if constexpr (ALIGN_EPI) { if (wr == 1) PG8_BAR; }
    }
    PG8_WAIT_V(0);
    if constexpr (!ALIGN_EPI) { if (wr == 0) PG8_BAR; }
    PG8_BAR;
    if constexpr (Epi::AFTER_DRAIN) { E.fused(acc, cur, wr, wc, fr, fq, lds, wid, lane); S.done(cur); }
#undef PG8_SA
#undef PG8_SB
#undef PG8_STAGE
#undef PG8_LDA
#undef PG8_LDB
#undef PG8_MMA
#undef PG8_WAIT_V
#undef PG8_WAIT_L
#undef PG8_BAR
#undef PG8_SCHED
}
}

#include <hip/hip_cooperative_groups.h>
namespace cg = cooperative_groups;

constexpr int D_MODEL = 1024, BATCH = 4, SEQ = 8192, DEPTH = 2, N_META = 16, T = SEQ + N_META  , M = BATCH * T  , MPAD = 33024  , MMAIN = 32768  ;
constexpr int D_CONV = 512, D_FF = 2816, D_IN = 4000, D_INP = 4096, NHEAD = 8, TP = 8320;
constexpr float ALPHA = 1.4142135623730951f;
constexpr float LN_EPS = 1e-5f, RMS_EPS = 1e-6f;
constexpr float QSCALE = 0.10206207261596575f * 1.4426950408889634f;
constexpr int NWAVES = 8;

constexpr size_t OFF_CTL = 0;
constexpr size_t OFF_ROPE = 65536;
constexpr size_t OFF_HF = 2097152;
constexpr size_t SZ_HF = (size_t)MPAD * 1024 * 4;
constexpr size_t OFF_W = OFF_HF + SZ_HF;
constexpr size_t SZ_W = 17825792;
constexpr size_t OFF_S = OFF_W + SZ_W;
constexpr size_t SZ_HB = (size_t)MPAD * 1024 * 2;
constexpr size_t S_HB = OFF_S;
constexpr size_t S_GATES = OFF_S + SZ_HB;
constexpr size_t S_ACT = S_GATES;
constexpr size_t S_BCH = S_GATES + (size_t)MPAD * 2048 * 2;
constexpr size_t S_LAT = S_BCH + (size_t)MPAD * 1536 * 2;
constexpr size_t S_END4 = S_LAT + (size_t)MPAD * 512 * 4;
constexpr size_t S_YCONV = S_HB;
constexpr size_t S_CQN = S_YCONV + (size_t)MPAD * 512 * 2;
constexpr size_t S_CKVN = S_CQN + (size_t)MPAD * 256 * 2;
static_assert(S_CKVN + (size_t)MPAD * 256 * 2 <= S_GATES, "row-prep outputs fit in hb's region");
constexpr size_t S_Q = S_BCH;
constexpr size_t S_KN = S_Q + (size_t)MPAD * 768 * 2;
constexpr size_t S_VT = S_KN + (size_t)MPAD * 512 * 2;
constexpr size_t S_YMLA = S_VT + (size_t)BATCH * NHEAD * 64 * TP * 2;
static_assert(S_YMLA + (size_t)MPAD * 512 * 2 <= S_END4, "attention tensors fit in bch|lat's region");
constexpr size_t S_MERGED = S_Q;
static_assert(S_MERGED + (size_t)MPAD * 1024 * 2 <= S_VT + 0 * S_YMLA && S_ACT + (size_t)MPAD * 2816 * 2 <= S_END4, "overlays");
constexpr size_t S_KR = S_END4;
constexpr size_t WS_NEED = S_KR + (size_t)MPAD * 32 * 2;
static_assert(WS_NEED <= 536870912, "fits the guaranteed workspace");
constexpr size_t W_UP = 0, W_DOWN = (size_t)5632 * 1024 * 2;
constexpr size_t W_IN = 0, W_UQ = (size_t)4096 * 1024 * 2, W_UKV = W_UQ + 768 * 256 * 2, W_BC = W_UKV + 1024 * 256 * 2, W_BM = W_BC + 1024 * 512 * 2, W_O = W_BM + 1024 * 512 * 2;
static_assert(W_O + 1024 * 1024 * 2 <= SZ_W && W_DOWN + (size_t)1024 * 2816 * 2 <= SZ_W, "weight region");
constexpr int RING_BYTES = 131072, LDS_MISC = RING_BYTES, LDS_BYTES = RING_BYTES + 256;

#define LAS __attribute__((address_space(3)))
typedef unsigned short bf16;
typedef unsigned v4u __attribute__((ext_vector_type(4)));
typedef unsigned v2u __attribute__((ext_vector_type(2)));
typedef float f32x4 __attribute__((ext_vector_type(4)));
typedef float f32x2 __attribute__((ext_vector_type(2)));
typedef float f32x16 __attribute__((ext_vector_type(16)));
typedef short bf16x8 __attribute__((ext_vector_type(8)));
#define LDS_WAIT() asm volatile("s_waitcnt lgkmcnt(0)" ::: "memory")

__device__ __forceinline__ unsigned pk2(float lo, float hi) { return pg8::cvt_pk_bf16(lo, hi); }
__device__ __forceinline__ float wave_sum(float v) {
#pragma unroll
    for (int o = 1; o < 64; o <<= 1) v += __shfl_xor(v, o);
    return v;
}

__device__ __forceinline__ float inv_freq_of(int k) {
    switch (k) { case 0: return 1.000000000e+00f; case 1: return 5.623413324e-01f; case 2: return 3.162277639e-01f; case 3: return 1.778279394e-01f; case 4: return 1.000000015e-01f; case 5: return 5.623412877e-02f;
        case 6: return 3.162277862e-02f; case 7: return 1.778279431e-02f; case 8: return 9.999999776e-03f; case 9: return 5.623413250e-03f; case 10: return 3.162277862e-03f; case 11: return 1.778279431e-03f;
        case 12: return 1.000000047e-03f; case 13: return 5.623413017e-04f; case 14: return 3.162277862e-04f; default: return 1.778279402e-04f; }
}
__device__ __forceinline__ void transpose_item(const float* W, int N, int k0, int scol0, bf16* dst, int ldk, int drow0, LAS float* scr, int lane) {
    if (scol0 >= 0) {
#pragma unroll 8
        for (int i = 0; i < 32; ++i) { const int kk = 2 * i + (lane >> 5); scr[kk * 33 + (lane & 31)] = W[(size_t)(k0 + kk) * N + scol0 + (lane & 31)]; }
    } else {
#pragma unroll 8
        for (int i = 0; i < 32; ++i) { const int kk = 2 * i + (lane >> 5); scr[kk * 33 + (lane & 31)] = 0.f; }
    }
    LDS_WAIT(); asm volatile("" ::: "memory");
    const int c = lane & 7;
#pragma unroll
    for (int j = 0; j < 4; ++j) { const int n = (lane >> 3) + 8 * j; const LAS float* s = scr + (8 * c) * 33 + n;
        v4u o; o.x = pk2(s[0 * 33], s[1 * 33]); o.y = pk2(s[2 * 33], s[3 * 33]); o.z = pk2(s[4 * 33], s[5 * 33]); o.w = pk2(s[6 * 33], s[7 * 33]);
        *(v4u*)(dst + (size_t)(drow0 + n) * ldk + k0 + 8 * c) = o; }
    LDS_WAIT(); asm volatile("" ::: "memory");
}
__device__ __forceinline__ void convert_ffn(const float* w_up, const float* w_down, unsigned char* wreg, LAS float* scr, int gw, int ngw, int lane) {
    constexpr int I_UP = 16 * 176, I_DN = 44 * 32;
    for (int it = gw; it < I_UP + I_DN; it += ngw) {
        if (it < I_UP) { const int kb = it / 176, g = it % 176, tile = g >> 3, sub = g & 7;
            const int scol = sub < 4 ? tile * 128 + sub * 32 : D_FF + tile * 128 + (sub - 4) * 32;
            transpose_item(w_up, 2 * D_FF, kb * 64, scol, (bf16*)(wreg + W_UP), 1024, g * 32, scr, lane); }
        else { const int r = it - I_UP, kb = r / 32, g = r % 32; transpose_item(w_down, 1024, kb * 64, g * 32, (bf16*)(wreg + W_DOWN), D_FF, g * 32, scr, lane); }
    }
}
__device__ __forceinline__ void convert_mixer(const float* w_in, const float* w_uq, const float* w_ukv, const float* w_bc, const float* w_bm, const float* w_o, unsigned char* wreg, LAS float* scr, int gw, int ngw, int lane) {
    constexpr int I_IN = 16 * 128, I_UQ = 4 * 24, I_UKV = 4 * 32, I_BR = 8 * 32, I_O = 16 * 32;
    for (int it = gw; it < I_IN + I_UQ + I_UKV + 2 * I_BR + I_O; it += ngw) {
        int r = it;
        if (r < I_IN) { const int kb = r / 128, g = r % 128, n = g * 32; const int scol = n < 1952 ? n : (n < 2048 ? -1 : (n < 3072 ? 1952 + (n - 2048) : 2976 + (n - 3072)));
            transpose_item(w_in, D_IN, kb * 64, scol, (bf16*)(wreg + W_IN), 1024, n, scr, lane); continue; } r -= I_IN;
        if (r < I_UQ) { const int kb = r / 24, g = r % 24; transpose_item(w_uq, 768, kb * 64, g * 32, (bf16*)(wreg + W_UQ), 256, g * 32, scr, lane); continue; } r -= I_UQ;
        if (r < I_UKV) { const int kb = r / 32, g = r % 32, gg = g & 15; const int scol = (gg >> 1) * 128 + (g >> 4) * 64 + (gg & 1) * 32;
            transpose_item(w_ukv, 1024, kb < 2 ? kb * 64 : 0, kb < 2 ? scol : -1, (bf16*)(wreg + W_UKV) + (kb < 2 ? 0 : kb * 64), 256, g * 32, scr, lane); continue; } r -= I_UKV;
        if (r < I_BR) { const int kb = r / 32, g = r % 32; transpose_item(w_bc, 1024, kb * 64, g * 32, (bf16*)(wreg + W_BC), 512, g * 32, scr, lane); continue; } r -= I_BR;
        if (r < I_BR) { const int kb = r / 32, g = r % 32; transpose_item(w_bm, 1024, kb * 64, g * 32, (bf16*)(wreg + W_BM), 512, g * 32, scr, lane); continue; } r -= I_BR;
        { const int kb = r / 32, g = r % 32; transpose_item(w_o, 1024, kb * 64, g * 32, (bf16*)(wreg + W_O), 1024, g * 32, scr, lane); }
    }
}

__device__ __forceinline__ void ln_row(const float* xin, const float* g, const float* bt, float* of32, bf16* ob16, int lane) {
    const f32x4* xr = (const f32x4*)xin + lane;
    f32x4 v[4]; float s = 0.f;
#pragma unroll
    for (int j = 0; j < 4; ++j) { v[j] = xr[64 * j]; s += (v[j].x + v[j].y) + (v[j].z + v[j].w); }
    const float mean = wave_sum(s) * (1.f / 1024.f); float s2 = 0.f;
#pragma unroll
    for (int j = 0; j < 4; ++j) { v[j] = v[j] - mean; s2 += (v[j].x * v[j].x + v[j].y * v[j].y) + (v[j].z * v[j].z + v[j].w * v[j].w); }
    const float rstd = 1.f / sqrtf(wave_sum(s2) * (1.f / 1024.f) + LN_EPS);
#pragma unroll
    for (int j = 0; j < 4; ++j) { const f32x4 gg = ((const f32x4*)g)[lane + 64 * j], bb = ((const f32x4*)bt)[lane + 64 * j]; v[j] = v[j] * rstd * gg + bb; }
    if (of32) {
#pragma unroll
        for (int j = 0; j < 4; ++j) ((f32x4*)of32)[lane + 64 * j] = v[j]; }
    if (ob16) {
#pragma unroll
        for (int j = 0; j < 4; ++j) { v2u w; w.x = pk2(v[j].x, v[j].y); w.y = pk2(v[j].z, v[j].w); ((v2u*)ob16)[lane + 64 * j] = w; } }
}

struct TailResid { float* H; float alpha, coef;
    __device__ __forceinline__ void operator()(int token, int col, const f32x4 s) const { float* p = H + (size_t)token * 1024 + col; const f32x4 h = *(const f32x4*)p; *(f32x4*)p = h * alpha + s * coef; } };
template <bool ACCUM> struct TailGate { bf16* O; const bf16* G;
    __device__ __forceinline__ void operator()(int token, int col, f32x4 s) const {
        const v2u g = *(const v2u*)(G + (size_t)token * 2048 + col); bf16* op = O + (size_t)token * 1024 + col;
        s[0] *= pg8::bf_lo(g.x); s[1] *= pg8::bf_hi(g.x); s[2] *= pg8::bf_lo(g.y); s[3] *= pg8::bf_hi(g.y);
        if (ACCUM) { const v2u p = *(const v2u*)op; s[0] += pg8::bf_lo(p.x); s[1] += pg8::bf_hi(p.x); s[2] += pg8::bf_lo(p.y); s[3] += pg8::bf_hi(p.y); }
        v2u w; w.x = pk2(s[0], s[1]); w.y = pk2(s[2], s[3]); *(v2u*)op = w; } };
template <int NB, class F> __device__ __forceinline__ void tail_gemm_nb(const bf16* A, const bf16* Bt, int K, int blk, int nstrip, const int (&brow)[NB], LAS unsigned char* lds, const F& epi) {
    if (blk >= nstrip) return;
    int tid_ = threadIdx.x; asm volatile("" : "+v"(tid_));
    const int lane = tid_ & 63, wid = tid_ >> 6, fr = lane & 15, fq = lane >> 4, kw = K >> 3;
    const bf16* ap = A + (size_t)fr * K + wid * kw + fq * 8;
    f32x4 acc[NB][4];
#pragma unroll
    for (int j = 0; j < NB; ++j)
#pragma unroll
        for (int m = 0; m < 4; ++m) acc[j][m] = (f32x4){0.f, 0.f, 0.f, 0.f};
    for (int k = 0; k < kw; k += 32) {
        bf16x8 a[4];
#pragma unroll
        for (int m = 0; m < 4; ++m) a[m] = *(const bf16x8*)(ap + (size_t)m * 16 * K + k);
#pragma unroll
        for (int j = 0; j < NB; ++j) { const bf16x8 b = *(const bf16x8*)(Bt + (size_t)(brow[j] + fr) * K + wid * kw + fq * 8 + k);
#pragma unroll
            for (int m = 0; m < 4; ++m) acc[j][m] = __builtin_amdgcn_mfma_f32_16x16x32_bf16(b, a[m], acc[j][m], 0, 0, 0); }
    }
    LAS f32x4* red = (LAS f32x4*)lds;
#pragma unroll
    for (int j = 0; j < NB; ++j)
#pragma unroll
        for (int m = 0; m < 4; ++m) red[((wid * NB + j) * 4 + m) * 64 + lane] = acc[j][m];
    __syncthreads();
    if (wid < 4) { f32x4 s[NB];
#pragma unroll
        for (int j = 0; j < NB; ++j) { s[j] = red[(j * 4 + wid) * 64 + lane];
#pragma unroll
            for (int w = 1; w < 8; ++w) s[j] = s[j] + red[((w * NB + j) * 4 + wid) * 64 + lane]; }
        epi(wid * 16 + fr, fq * 4, s); }
    __syncthreads();
}
template <class F> struct TailOne { const F& f; int n0; __device__ __forceinline__ void operator()(int token, int c4, const f32x4 (&s)[1]) const { f(token, n0 + c4, s[0]); } };
template <class F> __device__ __forceinline__ void tail_gemm(const bf16* A, const bf16* Bt, int K, int blk, LAS unsigned char* lds, const F& epi) {
    const int brow[1] = {blk * 16}; const TailOne<F> e{epi, blk * 16};
    tail_gemm_nb<1>(A, Bt, K, blk, 64, brow, lds, e);
}
struct TailSwiGLU { bf16* O; int c0;
    __device__ __forceinline__ void operator()(int token, int c4, const f32x4 (&s)[2]) const { f32x4 v;
#pragma unroll
        for (int i = 0; i < 4; ++i) v[i] = s[0][i] * pg8::fast_sigmoid(s[0][i]) * s[1][i];
        v2u w; w.x = pk2(v[0], v[1]); w.y = pk2(v[2], v[3]); *(v2u*)(O + (size_t)token * D_FF + c0 + c4) = w; } };
struct TailInProj { bf16* bch_; float* lat_; bf16* gates_; const float* bgate; int c0;
    __device__ __forceinline__ void operator()(int token, int c4, const f32x4 (&s)[1]) const { const int c = c0 + c4; f32x4 v = s[0];
        if (c < 1536) { v2u w; w.x = pk2(v[0], v[1]); w.y = pk2(v[2], v[3]); *(v2u*)(bch_ + (size_t)token * 1536 + c) = w; }
        else if (c < 2048) { *(f32x4*)(lat_ + (size_t)token * 512 + (c - 1536)) = v; }
        else { const f32x4 bv = *(const f32x4*)(bgate + (c - 2048));
#pragma unroll
            for (int i = 0; i < 4; ++i) v[i] = pg8::fast_sigmoid(v[i] + bv[i]);
            v2u w; w.x = pk2(v[0], v[1]); w.y = pk2(v[2], v[3]); *(v2u*)(gates_ + (size_t)token * 2048 + (c - 2048)) = w; } } };

namespace att {
constexpr int KB = 12288, VB = 8192, OFF_V = 2 * KB, OFF_WS = 2 * KB + 3 * VB, OFF_Q = OFF_WS + 8 * 256;
__device__ __forceinline__ int crow(int r, int hi) { return (r & 3) + 8 * (r >> 2) + 4 * hi; }
__device__ __forceinline__ void attn_unit(int b, int h, int qb, const bf16* Q, const bf16* Kn, const bf16* Kr, const bf16* Vt, const float* rope, bf16* Y, LAS unsigned char* lds) {
    int tid_ = threadIdx.x; asm volatile("" : "+v"(tid_));
    const int tid = tid_, lane = tid & 63, r32 = lane & 31, hi = lane >> 5; const int wid = __builtin_amdgcn_readfirstlane(tid >> 6);
    const int q0 = qb * 256, q0w = q0 + wid * 32;
    const size_t rowbase = (size_t)b * T;
    int NT = (q0 + 256) / 64; if (NT > (T + 63) / 64) NT = (T + 63) / 64;
    int ntw = 0; if (q0w < T) { ntw = (q0w + 31) / 64 + 1; if (ntw > NT) ntw = NT; }
    bf16x8 qr[6];
    { int tq = q0w + r32; if (tq > T - 1) tq = T - 1; const bf16* qp = Q + (rowbase + tq) * 768 + h * 96 + hi * 8;
#pragma unroll
      for (int d0 = 0; d0 < 6; ++d0) qr[d0] = *(const bf16x8*)(qp + d0 * 16);
      const float* rt = rope + (size_t)tq * 32 + 8 * hi; const f32x4 c0 = *(const f32x4*)rt, c1 = *(const f32x4*)(rt + 4), s0 = *(const f32x4*)(rt + 16), s1 = *(const f32x4*)(rt + 20);
      v4u a = __builtin_bit_cast(v4u, qr[4]), bb = __builtin_bit_cast(v4u, qr[5]), oa, ob;
#define ROT2(AW, BW, CA, CB, SA, SB, OA, OB) do { const float x1l = pg8::bf_lo(AW), x1h = pg8::bf_hi(AW), x2l = pg8::bf_lo(BW), x2h = pg8::bf_hi(BW); \
        OA = pk2(x1l * (CA) - x2l * (SA), x1h * (CB) - x2h * (SB)); OB = pk2(x2l * (CA) + x1l * (SA), x2h * (CB) + x1h * (SB)); } while (0)
      ROT2(a.x, bb.x, c0[0], c0[1], s0[0], s0[1], oa.x, ob.x); ROT2(a.y, bb.y, c0[2], c0[3], s0[2], s0[3], oa.y, ob.y);
      ROT2(a.z, bb.z, c1[0], c1[1], s1[0], s1[1], oa.z, ob.z); ROT2(a.w, bb.w, c1[2], c1[3], s1[2], s1[3], oa.w, ob.w);
#undef ROT2
      qr[4] = __builtin_bit_cast(bf16x8, oa); qr[5] = __builtin_bit_cast(bf16x8, ob); }
    const bf16* kn_src = Kn + (rowbase + lane) * 512 + h * 64 + wid * 8;
    const bf16* kr_src = Kr + (rowbase + lane) * 32 + (wid & 3) * 8;
    const bf16* v_src = Vt + ((size_t)(b * 8 + h) * 64 + lane) * TP + wid * 8;
    v4u kreg, krreg = (v4u){0u, 0u, 0u, 0u}, vreg;
#define ATT_LOAD(kt) do { kreg = *(const v4u*)(kn_src + (size_t)(kt) * 64 * 512); if (wid < 4) krreg = *(const v4u*)(kr_src + (size_t)(kt) * 64 * 32); vreg = *(const v4u*)(v_src + (size_t)(kt) * 64); } while (0)
#define ATT_STORE(buf, vslot) do { *(LAS v4u*)(lds + (buf) * KB + wid * 1024 + lane * 16) = kreg; if (wid < 4) *(LAS v4u*)(lds + (buf) * KB + (8 + wid) * 1024 + lane * 16) = krreg; \
        *(LAS v4u*)(lds + OFF_V + (vslot) * VB + wid * 1024 + lane * 16) = vreg; } while (0)
    LAS float* wsf = (LAS float*)(lds + OFF_WS + wid * 256);
    ATT_LOAD(0); ATT_STORE(0, 0);
    __syncthreads();
    const bool skew = wid >= 4;
    bf16x8 pw[4];
    int vs_cur = 0, vs_prev = 2, vs_next = 1;
#define ATT_PV(vslot) do { const LAS unsigned char* vb_ = lds + OFF_V + (vslot) * VB + hi * 1024 + r32 * 16; \
        _Pragma("unroll") for (int ks = 0; ks < 4; ++ks) { \
            const bf16x8 v0 = *(const LAS bf16x8*)(vb_ + ks * 2048), v1 = *(const LAS bf16x8*)(vb_ + ks * 2048 + 512); \
            o0 = __builtin_amdgcn_mfma_f32_32x32x16_bf16(pw[ks], v0, o0, 0, 0, 0); \
            o1 = __builtin_amdgcn_mfma_f32_32x32x16_bf16(pw[ks], v1, o1, 0, 0, 0); } } while (0)
    float mrow = 0.f, lsum = 0.f;
    f32x16 o0, o1, negm;
#pragma unroll
    for (int r = 0; r < 16; ++r) { o0[r] = 0.f; o1[r] = 0.f; negm[r] = 0.f; }
    for (int kt = 0; kt < NT; ++kt) {
        const int cur = kt & 1;
        if (kt + 1 < NT) ATT_LOAD(kt + 1);
        if (skew && kt >= 1 && kt - 1 < ntw) ATT_PV(vs_prev);
        if (kt < ntw) {
            const LAS unsigned char* kb = lds + cur * KB + hi * 1024 + r32 * 16;
            f32x16 p0, p1;
#pragma unroll
            for (int d0 = 0; d0 < 6; ++d0) {
                const bf16x8 a0 = *(const LAS bf16x8*)(kb + d0 * 2048), a1 = *(const LAS bf16x8*)(kb + d0 * 2048 + 512);
                p0 = __builtin_amdgcn_mfma_f32_32x32x16_bf16(a0, qr[d0], d0 == 0 ? negm : p0, 0, 0, 0);
                p1 = __builtin_amdgcn_mfma_f32_32x32x16_bf16(a1, qr[d0], d0 == 0 ? negm : p1, 0, 0, 0);
            }
            if (64 * kt + 63 > q0w) {
                const int q = q0w + r32, kbase = 64 * kt + 4 * hi;
#pragma unroll
                for (int r = 0; r < 16; ++r) { const int key = kbase + (r & 3) + 8 * (r >> 2); if (key > q) p0[r] = -1e30f; if (key + 32 > q) p1[r] = -1e30f; }
            }
            float mx = fmaxf(p0[0], p1[0]);
#pragma unroll
            for (int r = 1; r < 16; ++r) mx = fmaxf(mx, fmaxf(p0[r], p1[r]));
            mx = fmaxf(mx, __shfl_xor(mx, 32));
            if (kt == 0 || __any(mx > 8.0f)) {
                const float dl = (kt == 0) ? mx : fmaxf(mx, 0.f), alpha = __builtin_amdgcn_exp2f(-dl);
                mrow += dl; lsum *= alpha;
#pragma unroll
                for (int r = 0; r < 16; ++r) { p0[r] -= dl; p1[r] -= dl; negm[r] = -mrow; }
                if (hi == 0) wsf[r32] = alpha;
                LDS_WAIT();
#pragma unroll
                for (int i = 0; i < 4; ++i) { const f32x4 a = *(const LAS f32x4*)(wsf + 8 * i + 4 * hi);
#pragma unroll
                    for (int j = 0; j < 4; ++j) { o0[4 * i + j] *= a[j]; o1[4 * i + j] *= a[j]; } }
            }
            float s = 0.f;
#pragma unroll
            for (int r = 0; r < 16; ++r) { p0[r] = __builtin_amdgcn_exp2f(p0[r]); p1[r] = __builtin_amdgcn_exp2f(p1[r]); s += p0[r] + p1[r]; }
            lsum += s;
#pragma unroll
            for (int ks = 0; ks < 4; ++ks) { v4u w;
                if (ks < 2) { w.x = pk2(p0[8 * ks + 0], p0[8 * ks + 1]); w.y = pk2(p0[8 * ks + 2], p0[8 * ks + 3]); w.z = pk2(p0[8 * ks + 4], p0[8 * ks + 5]); w.w = pk2(p0[8 * ks + 6], p0[8 * ks + 7]); }
                else { const int k2 = ks - 2; w.x = pk2(p1[8 * k2 + 0], p1[8 * k2 + 1]); w.y = pk2(p1[8 * k2 + 2], p1[8 * k2 + 3]); w.z = pk2(p1[8 * k2 + 4], p1[8 * k2 + 5]); w.w = pk2(p1[8 * k2 + 6], p1[8 * k2 + 7]); }
                pw[ks] = __builtin_bit_cast(bf16x8, w); }
            if (!skew) ATT_PV(vs_cur);
        }
        if (kt + 1 < NT) ATT_STORE(cur ^ 1, vs_next);
        { const int t_ = vs_prev; vs_prev = vs_cur; vs_cur = vs_next; vs_next = t_; }
        __syncthreads();
    }
    if (skew && NT - 1 < ntw) ATT_PV(vs_prev);
#undef ATT_PV
    if (ntw > 0) {
        lsum += __shfl_xor(lsum, 32);
        if (hi == 0) wsf[32 + r32] = 1.0f / lsum;
        LDS_WAIT();
        bf16* yp = Y + (rowbase + q0w) * 512 + h * 64 + r32;
#pragma unroll
        for (int i = 0; i < 4; ++i) { const f32x4 a = *(const LAS f32x4*)(wsf + 32 + 8 * i + 4 * hi);
#pragma unroll
            for (int j = 0; j < 4; ++j) { const int r = 4 * i + j, q = crow(r, hi);
                if (q0w + q < T) { const unsigned w = pk2(o0[r] * a[j], o1[r] * a[j]); yp[(size_t)q * 512] = (bf16)(w & 0xffffu); yp[(size_t)q * 512 + 32] = (bf16)(w >> 16); } } }
        LDS_WAIT();
    }
#undef ATT_LOAD
#undef ATT_STORE
}
}

#define GAS __attribute__((address_space(1)))
#ifdef PROBE_SYS_SCOPE
#define XB_SCOPE ""
#else
#define XB_SCOPE "agent"
#endif
#define XB_TMO      128
#define XB_XCNT(j)  (256  + 64 * (j))
#define XB_XSUB(j)  (1280 + 64 * (j))
#define XB_XGEN(j)  (2304 + 64 * (j))
#define XB_TOP      3328
#define XB_TOPGEN   3392
#define XCD_BAR_WORDS 3456
#define XB_SPIN_CAP (1u << 18)

__device__ __forceinline__ unsigned xb_ld(unsigned* p)              { return __hip_atomic_load(p, __ATOMIC_RELAXED, __HIP_MEMORY_SCOPE_AGENT); }
__device__ __forceinline__ unsigned xb_add(unsigned* p, unsigned v) { return __hip_atomic_fetch_add(p, v, __ATOMIC_RELAXED, __HIP_MEMORY_SCOPE_AGENT); }
__device__ __forceinline__ unsigned xb_xcc_id() { return (unsigned)__builtin_amdgcn_s_getreg((3 << 11) | 20) & 0xFu; }
#define XB_SPIN(cond, bar) do { unsigned _sp = 0; while (cond) { __builtin_amdgcn_s_sleep(1); \
    if ((++_sp & 255u) == 0u) { if (xb_ld(&(bar)[XB_TMO])) break; if (_sp > XB_SPIN_CAP) { atomicAdd(&(bar)[XB_TMO], 1u); break; } } } } while (0)

struct XcdBarrier {
    unsigned* bar; unsigned x;
    volatile LAS unsigned* st;
};

__device__ __forceinline__ XcdBarrier xcd_barrier_post(unsigned* bar, volatile LAS unsigned* st) {
    XcdBarrier b; b.bar = bar; b.x = xb_xcc_id(); b.st = st;
    if (threadIdx.x == 0) (void)xb_add(&bar[XB_XCNT(b.x)], 1u);
    return b;
}
__device__ __forceinline__ void xcd_barrier_complete(unsigned* bar, unsigned x, unsigned& nloc, unsigned& nx) {
    const unsigned G = gridDim.x * gridDim.y * gridDim.z;
    unsigned sum, cnt, mine, sp = 0u;
    for (;;) {
        sum = 0u; cnt = 0u; mine = 0u;
#pragma unroll
        for (unsigned j = 0; j < 16; ++j) { const unsigned c = xb_ld(&bar[XB_XCNT(j)]); sum += c; cnt += (c > 0u) ? 1u : 0u; mine = (j == x) ? c : mine; }
        if (sum == G) break;
        __builtin_amdgcn_s_sleep(1);
        if ((++sp & 255u) == 0u) { if (xb_ld(&bar[XB_TMO])) break; if (sp > XB_SPIN_CAP) { atomicAdd(&bar[XB_TMO], 1u); break; } }
    }
    nloc = mine > 0u ? mine : 1u; nx = cnt > 0u ? cnt : 1u;
}

__device__ __forceinline__ void xcd_barrier(const XcdBarrier& b) {
    asm volatile("s_waitcnt vmcnt(0)" ::: "memory");
    __syncthreads();
    if (threadIdx.x == 0) {
        unsigned* bar = b.bar;
        __builtin_amdgcn_s_waitcnt(0);
        unsigned nloc = b.st[0], nx = b.st[1];
        if (nloc == 0u) { xcd_barrier_complete(bar, b.x, nloc, nx); b.st[0] = nloc; b.st[1] = nx; }
        const unsigned old = xb_add(&bar[XB_XSUB(b.x)], 1u);
        const unsigned gen = old / nloc;
        if (old + 1u == (gen + 1u) * nloc) {
            __builtin_amdgcn_fence(__ATOMIC_RELEASE, XB_SCOPE);
            asm volatile("s_waitcnt vmcnt(0)" ::: "memory");
            const unsigned og = xb_add(&bar[XB_TOP], 1u);
            const unsigned tg = og / nx;
            if (og + 1u == (tg + 1u) * nx) xb_add(&bar[XB_TOPGEN], 1u);
            else XB_SPIN(xb_ld(&bar[XB_TOPGEN]) == tg, bar);
            __builtin_amdgcn_fence(__ATOMIC_ACQUIRE, XB_SCOPE);
            xb_add(&bar[XB_XGEN(b.x)], 1u);
            asm volatile("s_waitcnt vmcnt(0)" ::: "memory");
        } else {
            XB_SPIN(xb_ld(&bar[XB_XGEN(b.x)]) == gen, bar);
            __builtin_amdgcn_fence(__ATOMIC_ACQUIRE, XB_SCOPE);
            asm volatile("s_waitcnt vmcnt(0)" ::: "memory");
        }
    }
    __syncthreads();
}

struct Args { const float* in[18]; float* out; unsigned char* ws; };
static_assert(sizeof(Args) == 160, "Args layout");

__global__ void __launch_bounds__(NWAVES * 64, 2) mega_fwd(Args args) {
    extern __shared__ __attribute__((aligned(16))) unsigned char lds_raw[];
    cg::grid_group grid = cg::this_grid();
    LAS unsigned char* lds = (LAS unsigned char*)lds_raw;
    int tid = threadIdx.x, lane = tid & 63; const int wave = __builtin_amdgcn_readfirstlane(tid >> 6);
#define GRID_SYNC() do { XcdBarrier xb_; xb_.bar = ctl + 4096; xb_.x = xb_xcc_id(); xb_.st = (volatile LAS unsigned*)(lds + LDS_MISC) + 8; xcd_barrier(xb_); REBASE(); } while (0)
#define OPQ() do { asm volatile("" : "+v"(tid)); lane = tid & 63; } while (0)
    const int G = gridDim.x, blk = blockIdx.x;
    const int gw = blk * NWAVES + wave, ngw = G * NWAVES;
    const unsigned char* ka = (const unsigned char*)__builtin_amdgcn_kernarg_segment_ptr();
    unsigned char* ws = args.ws;
#define REBASE() do { asm volatile("" : "+s"(ka)); asm volatile("" : "+s"(ws)); } while (0)
#define INP(i) (*(const float* const*)(ka + 8 * (i)))
#define X_IN INP(0)
#define meta INP(1)
#define ffn1_up INP(2)
#define ffn1_down INP(3)
#define w_in INP(4)
#define b_gate INP(5)
#define conv_w INP(6)
#define q_norm_g INP(7)
#define w_uq INP(8)
#define kv_norm_g INP(9)
#define w_ukv INP(10)
#define w_br_conv INP(11)
#define w_br_mla INP(12)
#define w_o INP(13)
#define ffn2_up INP(14)
#define ffn2_down INP(15)
#define ln_g INP(16)
#define ln_b INP(17)
#define OUTP (*(float* const*)(ka + 144))
#define ctl ((unsigned*)(ws + OFF_CTL))
#define rope ((float*)(ws + OFF_ROPE))
#define hf ((float*)(ws + OFF_HF))
#define wreg (ws + OFF_W)
#define hb ((bf16*)(ws + S_HB))
#define act ((bf16*)(ws + S_ACT))
#define gates ((bf16*)(ws + S_GATES))
#define bch ((bf16*)(ws + S_BCH))
#define lat ((float*)(ws + S_LAT))
#define yconv ((bf16*)(ws + S_YCONV))
#define cqn ((bf16*)(ws + S_CQN))
#define ckvn ((bf16*)(ws + S_CKVN))
#define krb ((bf16*)(ws + S_KR))
#define Qb ((bf16*)(ws + S_Q))
#define Knb ((bf16*)(ws + S_KN))
#define Vtb ((bf16*)(ws + S_VT))
#define ymla ((bf16*)(ws + S_YMLA))
#define merged ((bf16*)(ws + S_MERGED))
    LAS float* scr = (LAS float*)(lds + wave * 16384);
    LAS unsigned char* ring = lds;
    if (threadIdx.x < 64) ((LAS unsigned*)(lds + LDS_MISC))[threadIdx.x] = 0u;
    __syncthreads();
    (void)xcd_barrier_post(ctl + 4096, (volatile LAS unsigned*)(lds + LDS_MISC) + 8);
    grid.sync();

#ifdef PROBE_DUMP_BIAS
    OPQ();
    for (int row = gw; row < BATCH * SEQ; row += ngw) { float* o = OUTP + (size_t)row * 1024; for (int c = lane; c < 1024; c += 64) o[c] = b_gate[c] + 2.0f * b_gate[1024 + c] + 4.0f * b_gate[2048 + c] + 8.0f * b_gate[3072 + c]; }
    return;
#endif
    OPQ();
    for (int row = gw; row < MPAD; row += ngw) {
        f32x4 v[4];
        if (row < M) { const int b = row / T, t = row - b * T; const f32x4* src = (const f32x4*)(t < N_META ? meta + (size_t)t * 1024 : X_IN + ((size_t)b * SEQ + (t - N_META)) * 1024) + lane;
#pragma unroll
            for (int j = 0; j < 4; ++j) v[j] = src[64 * j]; }
        else {
#pragma unroll
            for (int j = 0; j < 4; ++j) v[j] = (f32x4){0.f, 0.f, 0.f, 0.f}; }
#pragma unroll
        for (int j = 0; j < 4; ++j) { ((f32x4*)(hf + (size_t)row * 1024))[lane + 64 * j] = v[j]; v2u w; w.x = pk2(v[j].x, v[j].y); w.y = pk2(v[j].z, v[j].w); ((v2u*)(hb + (size_t)row * 1024))[lane + 64 * j] = w; }
    }
    for (int i = blk * 512 + tid; i < T * 16; i += G * 512) { const int t = i >> 4, k = i & 15;
        const float inv_freq = inv_freq_of(k); const float ang = (float)t * inv_freq;
        const double rev = (double)ang * 0.15915494309189535; const float fr = (float)(rev - floor(rev));
        rope[t * 32 + k] = __builtin_amdgcn_cosf(fr); rope[t * 32 + 16 + k] = __builtin_amdgcn_sinf(fr); }
    convert_ffn(ffn1_up, ffn1_down, wreg, scr, gw, ngw, lane);
    GRID_SYNC();

    for (int step = 0; step < 3 * DEPTH; ++step) {
        const int l = step / 3, sub = step % 3;
#ifdef PROBE_STEPS
        if (step == PROBE_STEPS) {
            OPQ();
            for (int row = gw; row < M; row += ngw) { const int b = row / T, t = row - b * T; if (t >= N_META) {
#pragma unroll
                for (int j = 0; j < 4; ++j) ((f32x4*)(OUTP + ((size_t)b * SEQ + (t - N_META)) * 1024))[lane + 64 * j] = ((const f32x4*)(hf + (size_t)row * 1024))[lane + 64 * j]; } }
            return;
        }
#endif
        if (sub != 1) {
            { const int c0 = blk * 16, tl = c0 >> 7, j0 = c0 & 127; const int brow[2] = {256 * tl + j0, 256 * tl + 128 + j0};
              tail_gemm_nb<2>(hb + (size_t)MMAIN * 1024, (const bf16*)(wreg + W_UP), 1024, blk, D_FF / 16, brow, lds, TailSwiGLU{act + (size_t)MMAIN * D_FF, c0}); }
            { pg8::Gemm g{hb, (const bf16*)(wreg + W_UP), MMAIN, 2 * D_FF, 1024}; pg8::StaticOrder S; S.init(MMAIN, 2 * D_FF, G, blk);
              pg8::EpiSwiGLU E{act, D_FF};
              pg8::gemm_phase<pg8::EpiSwiGLU, pg8::StaticOrder, true, true>(ring, g, S, E); }
            GRID_SYNC();
            tail_gemm(act + (size_t)MMAIN * D_FF, (const bf16*)(wreg + W_DOWN), D_FF, blk, lds, TailResid{hf + (size_t)MMAIN * 1024, ALPHA, 0.5f});
            { pg8::Gemm g{act, (const bf16*)(wreg + W_DOWN), MMAIN, 1024, D_FF}; pg8::StaticOrder S; S.init(MMAIN, 1024, G, blk);
              pg8::EpiResid E{hf, ALPHA, 0.5f};
              pg8::gemm_phase<pg8::EpiResid, pg8::StaticOrder, true, true>(ring, g, S, E); }
            GRID_SYNC();
            OPQ();
            const int li = (sub == 0) ? 0 : 2; const float* lg = ln_g + ((size_t)l * 3 + li) * 1024; const float* lb = ln_b + ((size_t)l * 3 + li) * 1024;
            const bool final_ln = (step == 3 * DEPTH - 1);
            for (int row = gw; row < MPAD; row += ngw) {
                if (!final_ln) ln_row(hf + (size_t)row * 1024, lg, lb, hf + (size_t)row * 1024, hb + (size_t)row * 1024, lane);
                else if (row < M) { const int b = row / T, t = row - b * T; if (t >= N_META) ln_row(hf + (size_t)row * 1024, lg, lb, OUTP + ((size_t)b * SEQ + (t - N_META)) * 1024, nullptr, lane); }
            }
            if (sub == 0) convert_mixer(w_in + (size_t)l * 1024 * D_IN, w_uq + (size_t)l * 256 * 768, w_ukv + (size_t)l * 128 * 1024, w_br_conv + (size_t)l * 512 * 1024, w_br_mla + (size_t)l * 512 * 1024, w_o + (size_t)l * 1024 * 1024, wreg, scr, gw, ngw, lane);
            else if (!final_ln) convert_ffn(ffn1_up + (size_t)(l + 1) * 1024 * 2 * D_FF, ffn1_down + (size_t)(l + 1) * D_FF * 1024, wreg, scr, gw, ngw, lane);
            if (!final_ln) GRID_SYNC();
        } else {
#ifdef PROBE_DUMP_BIAS1
            OPQ();
            for (int row = gw; row < BATCH * SEQ; row += ngw) { float* o = OUTP + (size_t)row * 1024; for (int c = lane; c < 1024; c += 64) o[c] = b_gate[c] + 2.0f * b_gate[1024 + c] + 4.0f * b_gate[2048 + c] + 8.0f * b_gate[3072 + c]; }
            return;
#endif
            { const int brow[1] = {blk * 16};
              tail_gemm_nb<1>(hb + (size_t)MMAIN * 1024, (const bf16*)(wreg + W_IN), 1024, blk, D_INP / 16, brow, lds,
                              TailInProj{bch + (size_t)MMAIN * 1536, lat + (size_t)MMAIN * 512, gates + (size_t)MMAIN * 2048, b_gate + (size_t)l * 2048, blk * 16}); }
            { pg8::Gemm g{hb, (const bf16*)(wreg + W_IN), MMAIN, D_INP, 1024}; pg8::StaticOrder S; S.init(MMAIN, D_INP, G, blk);
              pg8::EpiInProj E{bch, lat, gates, b_gate + (size_t)l * 2048};
              pg8::gemm_phase<pg8::EpiInProj, pg8::StaticOrder, true, true>(ring, g, S, E); }
            GRID_SYNC();
#ifdef PROBE_DUMP_GATES0
            OPQ();
            for (int row = gw; row < M; row += ngw) { const int b = row / T, t = row - b * T; if (t >= N_META) { float* o = OUTP + ((size_t)b * SEQ + (t - N_META)) * 1024;
                for (int c = lane; c < 1024; c += 64) o[c] = pg8::bf_lo(gates[(size_t)row * 2048 + c]) + 2.0f * pg8::bf_lo(gates[(size_t)row * 2048 + 1024 + c]); } }
            return;
#endif
            OPQ();
            { const float* cw = conv_w + (size_t)l * 3 * 512; const float* qg = q_norm_g + (size_t)l * 256; const float* kg = kv_norm_g + (size_t)l * 128;
              for (int row = gw; row < MPAD; row += ngw) {
                int rr = row < M ? row : M - 1; const int b = rr / T, t = rr - b * T;
                f32x4 ua[2] = {(f32x4){0.f, 0.f, 0.f, 0.f}, (f32x4){0.f, 0.f, 0.f, 0.f}};
#pragma unroll
                for (int k = 0; k < 3; ++k) { const int dt = 2 - k;
                    if (t - dt >= 0 && row < M) { const bf16* rp = bch + (size_t)(row - dt) * 1536 + 8 * lane; const v4u c = *(const v4u*)(rp + 512), hh = *(const v4u*)(rp + 1024);
                        const f32x4 w0 = *(const f32x4*)(cw + k * 512 + 8 * lane), w1 = *(const f32x4*)(cw + k * 512 + 8 * lane + 4);
                        ua[0][0] += w0[0] * pg8::bf_lo(c.x) * pg8::bf_lo(hh.x); ua[0][1] += w0[1] * pg8::bf_hi(c.x) * pg8::bf_hi(hh.x);
                        ua[0][2] += w0[2] * pg8::bf_lo(c.y) * pg8::bf_lo(hh.y); ua[0][3] += w0[3] * pg8::bf_hi(c.y) * pg8::bf_hi(hh.y);
                        ua[1][0] += w1[0] * pg8::bf_lo(c.z) * pg8::bf_lo(hh.z); ua[1][1] += w1[1] * pg8::bf_hi(c.z) * pg8::bf_hi(hh.z);
                        ua[1][2] += w1[2] * pg8::bf_lo(c.w) * pg8::bf_lo(hh.w); ua[1][3] += w1[3] * pg8::bf_hi(c.w) * pg8::bf_hi(hh.w); } }
                { const v4u bb = *(const v4u*)(bch + (size_t)row * 1536 + 8 * lane);
                  v4u o; o.x = pk2(ua[0][0] * pg8::bf_lo(bb.x), ua[0][1] * pg8::bf_hi(bb.x)); o.y = pk2(ua[0][2] * pg8::bf_lo(bb.y), ua[0][3] * pg8::bf_hi(bb.y));
                  o.z = pk2(ua[1][0] * pg8::bf_lo(bb.z), ua[1][1] * pg8::bf_hi(bb.z)); o.w = pk2(ua[1][2] * pg8::bf_lo(bb.w), ua[1][3] * pg8::bf_hi(bb.w));
                  *(v4u*)(yconv + (size_t)row * 512 + 8 * lane) = o; }
                const float* lr = lat + (size_t)row * 512;
                { const f32x4 v = *(const f32x4*)(lr + 4 * lane); const float ss = wave_sum((v.x * v.x + v.y * v.y) + (v.z * v.z + v.w * v.w));
                  const float rs = 1.f / sqrtf(ss * (1.f / 256.f) + RMS_EPS); const f32x4 gg = *(const f32x4*)(qg + 4 * lane);
                  v2u w; w.x = pk2(v.x * rs * gg.x, v.y * rs * gg.y); w.y = pk2(v.z * rs * gg.z, v.w * rs * gg.w); *(v2u*)(cqn + (size_t)row * 256 + 4 * lane) = w; }
                { const f32x2 v = *(const f32x2*)(lr + 256 + 2 * lane); const float ss = wave_sum(v.x * v.x + v.y * v.y);
                  const float rs = 1.f / sqrtf(ss * (1.f / 128.f) + RMS_EPS); const f32x2 gg = *(const f32x2*)(kg + 2 * lane);
                  *(unsigned*)(ckvn + (size_t)row * 256 + 2 * lane) = pk2(v.x * rs * gg.x, v.y * rs * gg.y); *(unsigned*)(ckvn + (size_t)row * 256 + 128 + 2 * lane) = 0u; }
                if (lane < 16) { const float x1 = lr[384 + lane], x2 = lr[400 + lane], cs = rope[t * 32 + lane], sn = rope[t * 32 + 16 + lane];
                  const unsigned w = pk2(x1 * cs - x2 * sn, x2 * cs + x1 * sn); krb[(size_t)row * 32 + lane] = (bf16)(w & 0xffffu); krb[(size_t)row * 32 + 16 + lane] = (bf16)(w >> 16); }
              } }
            GRID_SYNC();
#ifdef PROBE_DUMP_GATES
            OPQ();
            for (int row = gw; row < M; row += ngw) { const int b = row / T, t = row - b * T; if (t >= N_META) { float* o = OUTP + ((size_t)b * SEQ + (t - N_META)) * 1024;
                for (int c = lane; c < 1024; c += 64) o[c] = pg8::bf_lo(gates[(size_t)row * 2048 + c]) + 2.0f * pg8::bf_lo(gates[(size_t)row * 2048 + 1024 + c]); } }
            return;
#endif
#ifdef PROBE_DUMP_ROWPREP
            OPQ();
            for (int row = gw; row < M; row += ngw) { const int b = row / T, t = row - b * T; if (t >= N_META) { float* o = OUTP + ((size_t)b * SEQ + (t - N_META)) * 1024;
                for (int c = lane; c < 1024; c += 64) { float v = 0.f;
                    if (c < 512) v = pg8::bf_lo(yconv[(size_t)row * 512 + c]); else if (c < 768) v = pg8::bf_lo(cqn[(size_t)row * 256 + c - 512]); else if (c < 896) v = pg8::bf_lo(ckvn[(size_t)row * 256 + c - 768]); else if (c < 928) v = pg8::bf_lo(krb[(size_t)row * 32 + c - 896]);
                    else if (c < 960) v = lat[(size_t)row * 512 + 384 + c - 928];
                    o[c] = v; } } }
            return;
#endif
            OPQ();
            for (int i = blk * 512 + tid; i < BATCH * NHEAD * 64 * (TP - T); i += G * 512) { const int r = i / (TP - T), c = i % (TP - T); Vtb[(size_t)r * TP + T + c] = 0; }
            { pg8::Gemm g{cqn, (const bf16*)(wreg + W_UQ), MPAD, 768, 256}; pg8::StaticOrder S; S.init(MPAD, 768, G, blk);
              pg8::EpiPlain E{Qb, 768, QSCALE};
              pg8::gemm_phase<pg8::EpiPlain, pg8::StaticOrder, true, true>(ring, g, S, E); }
            { pg8::Gemm g{ckvn, (const bf16*)(wreg + W_UKV), MPAD, 512, 256}; pg8::StaticOrder S; S.init(MPAD, 512, G, blk);
              pg8::EpiPlain E{Knb, 512, 1.0f};
              pg8::gemm_phase<pg8::EpiPlain, pg8::StaticOrder, true, true>(ring, g, S, E); }
            { pg8::Gemm g{(const bf16*)(wreg + W_UKV) + 512 * 256, ckvn, 512, MPAD, 256}; pg8::StaticOrder S; S.init(512, MPAD, G, blk);
              pg8::EpiVt E{Vtb};
              pg8::gemm_phase<pg8::EpiVt, pg8::StaticOrder, true, true>(ring, g, S, E); }
            GRID_SYNC();
            OPQ();
#ifdef PROBE_NOATTN
            for (size_t i = (size_t)blk * 512 + tid; i < (size_t)MPAD * 512 / 8; i += (size_t)G * 512) ((v4u*)ymla)[i] = (v4u){0u, 0u, 0u, 0u};
            if (false)
#endif
#ifdef PROBE_ATTN_TWICE
            for (int rep = 0; rep < 2; ++rep)
            { const int grp = blk & 7; unsigned* qctr = ctl + 64 * (rep * 16 + l * 8 + grp);
#else
            { const int grp = blk & 7; unsigned* qctr = ctl + 64 * (l * 8 + grp);
#endif
              volatile LAS unsigned* bc = (volatile LAS unsigned*)(lds + LDS_MISC);
              for (;;) {
                  if (tid == 0) bc[0] = atomicAdd(qctr, 1u);
                  __syncthreads();
                  const unsigned u = bc[0];
                  __syncthreads();
                  if (u >= 132u) break;
                  const int qb = 32 - (int)(u >> 2), bh = grp * 4 + (int)(u & 3u);
                  att::attn_unit(bh >> 3, bh & 7, qb, Qb, Knb, krb, Vtb, rope, ymla, lds);
              } }
            GRID_SYNC();
            tail_gemm(yconv + (size_t)MMAIN * 512, (const bf16*)(wreg + W_BC), 512, blk, lds, TailGate<false>{merged + (size_t)MMAIN * 1024, gates + (size_t)MMAIN * 2048});
            tail_gemm(ymla + (size_t)MMAIN * 512, (const bf16*)(wreg + W_BM), 512, blk, lds, TailGate<true>{merged + (size_t)MMAIN * 1024, gates + (size_t)MMAIN * 2048 + 1024});
            { pg8::Gemm g{yconv, (const bf16*)(wreg + W_BC), MMAIN, 1024, 512}; pg8::StaticOrder S; S.init(MMAIN, 1024, G, blk);
              pg8::EpiGate<false> E{merged, gates};
              pg8::gemm_phase<pg8::EpiGate<false>, pg8::StaticOrder, true, true>(ring, g, S, E); }
#ifdef PROBE_SYNC_BETWEEN
            GRID_SYNC();
#endif
#ifndef PROBE_SKIP_BR2
            { pg8::Gemm g{ymla, (const bf16*)(wreg + W_BM), MMAIN, 1024, 512}; pg8::StaticOrder S; S.init(MMAIN, 1024, G, blk);
              pg8::EpiGate<true> E{merged, gates + 1024};
              pg8::gemm_phase<pg8::EpiGate<true>, pg8::StaticOrder, true, true>(ring, g, S, E); }
#endif
            GRID_SYNC();
#ifdef PROBE_DUMP_MERGED
            OPQ();
            for (int row = gw; row < M; row += ngw) { const int b = row / T, t = row - b * T; if (t >= N_META) { float* o = OUTP + ((size_t)b * SEQ + (t - N_META)) * 1024;
                for (int c = lane; c < 1024; c += 64) o[c] = pg8::bf_lo(merged[(size_t)row * 1024 + c]); } }
            return;
#endif
            tail_gemm(merged + (size_t)MMAIN * 1024, (const bf16*)(wreg + W_O), 1024, blk, lds, TailResid{hf + (size_t)MMAIN * 1024, ALPHA, 1.0f});
            { pg8::Gemm g{merged, (const bf16*)(wreg + W_O), MMAIN, 1024, 1024}; pg8::StaticOrder S; S.init(MMAIN, 1024, G, blk);
              pg8::EpiResid E{hf, ALPHA, 1.0f};
              pg8::gemm_phase<pg8::EpiResid, pg8::StaticOrder, true, true>(ring, g, S, E); }
            GRID_SYNC();
            OPQ();
            { const float* lg = ln_g + ((size_t)l * 3 + 1) * 1024; const float* lb = ln_b + ((size_t)l * 3 + 1) * 1024;
              for (int row = gw; row < MPAD; row += ngw) ln_row(hf + (size_t)row * 1024, lg, lb, hf + (size_t)row * 1024, hb + (size_t)row * 1024, lane);
              convert_ffn(ffn2_up + (size_t)l * 1024 * 2 * D_FF, ffn2_down + (size_t)l * D_FF * 1024, wreg, scr, gw, ngw, lane); }
            GRID_SYNC();
        }
    }
}

extern "C" void kernel_launch(void* const* d_in, const int* in_sizes, int n_in, void* d_out, int out_size, void* d_ws, size_t ws_size, hipStream_t stream) {
    static int grid = 0;
    if (grid == 0) {
        if (n_in != 18 || ws_size < WS_NEED) { fprintf(stderr, "kernel_launch: expected 18 inputs and >= %zu bytes of workspace; got %d, %zu\n", (size_t)WS_NEED, n_in, ws_size); grid = -1; return; }
        int dev = 0, cus = 0, per_cu = 0;
        hipGetDevice(&dev); hipDeviceGetAttribute(&cus, hipDeviceAttributeMultiprocessorCount, dev);
        if (hipFuncSetAttribute((const void*)mega_fwd, hipFuncAttributeMaxDynamicSharedMemorySize, LDS_BYTES) != hipSuccess) { fprintf(stderr, "kernel_launch: hipFuncSetAttribute failed\n"); grid = -1; return; }
        hipOccupancyMaxActiveBlocksPerMultiprocessor(&per_cu, (const void*)mega_fwd, NWAVES * 64, LDS_BYTES);
        (void)hipGetLastError();
        if (per_cu < 1) per_cu = 1;
        grid = cus;
    }
    if (grid < 0) return;
    (void)hipMemsetAsync((char*)d_ws + OFF_CTL, 0, 65536, stream);
    Args a{};
    for (int i = 0; i < 18; ++i) a.in[i] = (const float*)d_in[i];
    a.out = (float*)d_out; a.ws = (unsigned char*)d_ws;
    void* params[] = {&a};
    hipError_t e = hipLaunchCooperativeKernel((const void*)mega_fwd, dim3(grid), dim3(NWAVES * 64), params, LDS_BYTES, stream);
    if (e != hipSuccess) fprintf(stderr, "cooperative launch failed: %s (grid %d)\n", hipGetErrorString(e), grid);
}
```

```cpp
#include <hip/hip_runtime.h>
#include <cstdio>
#include <cstdint>
namespace pg8 {
#define PG8_LAS __attribute__((address_space(3)))
typedef unsigned short bf16_t;
typedef short bf16x8 __attribute__((ext_vector_type(8)));
typedef float f32x4 __attribute__((ext_vector_type(4)));
typedef unsigned u32x4 __attribute__((ext_vector_type(4)));
constexpr int BM = 256, BK = 64, HALF = 128, HTB = HALF * BK * 2  , STAGE_BYTES = 8 * HTB, NXCD = 8, WGM = 8;

__host__ __device__ __forceinline__ int lds_byte(int r, int c) { const int st = (r >> 4) * 2 + (c >> 5), rr = r & 15, cc = c & 31, ob = rr * 64 + cc * 2; return st * 1024 + (ob ^ (((ob >> 9) & 1) << 5)); }
__host__ __device__ __forceinline__ void stage_rc(int b, int& R, int& C) { const int st = b / 1024, sb = b % 1024, swz = sb ^ (((sb >> 9) & 1) << 5); R = (st >> 1) * 16 + swz / 64; C = (st & 1) * 32 + (swz % 64) / 2; }
__host__ __device__ __forceinline__ int perm32(int rho) { const int n = rho >> 4, i = rho & 15; return 8 * (i >> 2) + 4 * n + (i & 3); }

struct Unit { int pm, pn; };
struct Gemm { const bf16_t* A; const bf16_t* Bt; int M, N, K; };

struct StaticOrder {
    int nM, nN, nwg, G, c;
    __host__ __device__ void init(int M, int N, int G_, int c_) { nM = M / BM; nN = N / BM; nwg = nM * nN; G = G_; c = c_; }
    __host__ __device__ bool next(int i, Unit& u) const {
        const long L = (long)i * G + c; if (L >= nwg) return false;
        int wgid = (int)L; { const int q = nwg / NXCD, r = nwg % NXCD, xcd = wgid % NXCD, off = wgid / NXCD; wgid = (xcd < r ? xcd * (q + 1) : r * (q + 1) + (xcd - r) * q) + off; }
        const int nig = WGM * nN, gid = wgid / nig, fm = gid * WGM, gsz = (nM - fm) < WGM ? (nM - fm) : WGM;
        u.pm = fm + ((wgid % nig) % gsz); u.pn = (wgid % nig) / gsz; return true;
    }
    __device__ __forceinline__ void a_ready(const Unit&) const {}
    __device__ __forceinline__ void done(const Unit&) const {}
};

struct SignalOrder : StaticOrder {
    unsigned* tot_main; unsigned* tot_tail;
    __device__ __forceinline__ void done(const Unit& u) const {
        asm volatile("s_waitcnt vmcnt(0)" ::: "memory");
        if ((threadIdx.x & 63) == 0) __hip_atomic_fetch_add(u.pm < 128 ? tot_main : tot_tail, 1u, __ATOMIC_RELAXED, __HIP_MEMORY_SCOPE_AGENT);
    }
};
typedef float f32x2 __attribute__((ext_vector_type(2)));
typedef __bf16 bf16x2_cv __attribute__((ext_vector_type(2)));
__device__ __forceinline__ unsigned cvt_pk_bf16(float lo, float hi) { f32x2 v = {lo, hi}; bf16x2_cv b = __builtin_convertvector(v, bf16x2_cv); return __builtin_bit_cast(unsigned, b); }
__device__ __forceinline__ float fast_sigmoid(float x) { return __builtin_amdgcn_rcpf(1.0f + __builtin_amdgcn_exp2f(-1.4426950408889634f * x)); }
__device__ __forceinline__ u32x4 pack8(const f32x4 a, const f32x4 b) { u32x4 w; w.x = cvt_pk_bf16(a[0], a[1]); w.y = cvt_pk_bf16(a[2], a[3]); w.z = cvt_pk_bf16(b[0], b[1]); w.w = cvt_pk_bf16(b[2], b[3]); return w; }
typedef unsigned u32x2 __attribute__((ext_vector_type(2)));
__device__ __forceinline__ float bf_lo(unsigned w) { return __uint_as_float(w << 16); }
__device__ __forceinline__ float bf_hi(unsigned w) { return __uint_as_float(w & 0xffff0000u); }

struct EpiSwiGLU {
    static constexpr bool PERM = true, AFTER_DRAIN = false;
    bf16_t* O; int ldc;
    __device__ __forceinline__ void operator()(const f32x4 (&acc)[2][2][4][2], const Unit& u, int wr, int wc, int fr, int fq) const {
        const int row0 = u.pm * BM + wr * 64 + fr; const int col0 = u.pn * 128 + wc * 32 + 8 * fq;
#pragma unroll
        for (int ai = 0; ai < 2; ++ai)
#pragma unroll
            for (int m = 0; m < 4; ++m) {
                f32x4 v[2];
#pragma unroll
                for (int n = 0; n < 2; ++n) { const f32x4 g = acc[ai][0][m][n], up = acc[ai][1][m][n];
#pragma unroll
                    for (int j = 0; j < 4; ++j) v[n][j] = g[j] * fast_sigmoid(g[j]) * up[j]; }
                *(u32x4*)(O + (size_t)(row0 + ai * HALF + m * 16) * ldc + col0) = pack8(v[0], v[1]);
            }
    }
};
__device__ __forceinline__ void st_wt(float* p, const f32x4 v) { asm volatile("global_store_dwordx4 %0, %1, off sc0 sc1" :: "v"(p), "v"(v) : "memory"); }
struct EpiResid {
    static constexpr bool PERM = true, AFTER_DRAIN = false, WT = false;
    float* H; float alpha, coef;
    __device__ __forceinline__ void operator()(const f32x4 (&acc)[2][2][4][2], const Unit& u, int wr, int wc, int fr, int fq) const {
        const int row0 = u.pm * BM + wr * 64 + fr; const int col0 = u.pn * BM + wc * 32 + 8 * fq;
#pragma unroll
        for (int ai = 0; ai < 2; ++ai)
#pragma unroll
            for (int m = 0; m < 4; ++m) {
                float* rp = H + (size_t)(row0 + ai * HALF + m * 16) * 1024 + col0;
#pragma unroll
                for (int bj = 0; bj < 2; ++bj) {
                    f32x4 a = *(const f32x4*)(rp + bj * HALF), b = *(const f32x4*)(rp + bj * HALF + 4);
                    a = a * alpha + acc[ai][bj][m][0] * coef; b = b * alpha + acc[ai][bj][m][1] * coef;
                    if (WT) { st_wt(rp + bj * HALF, a); st_wt(rp + bj * HALF + 4, b); } else { *(f32x4*)(rp + bj * HALF) = a; *(f32x4*)(rp + bj * HALF + 4) = b; }
                }
            }
    }
};
struct EpiInProj {
    static constexpr bool PERM = true, AFTER_DRAIN = false;
    bf16_t* bch; float* lat; bf16_t* gates; const float* bgate;
    __device__ __forceinline__ void operator()(const f32x4 (&acc)[2][2][4][2], const Unit& u, int wr, int wc, int fr, int fq) const {
        const int row0 = u.pm * BM + wr * 64 + fr; const int cw = wc * 32 + 8 * fq; const int pn = u.pn;
        if (pn < 6) {
#pragma unroll
            for (int ai = 0; ai < 2; ++ai)
#pragma unroll
                for (int m = 0; m < 4; ++m) { bf16_t* rp = bch + (size_t)(row0 + ai * HALF + m * 16) * 1536 + pn * BM + cw;
#pragma unroll
                    for (int bj = 0; bj < 2; ++bj) *(u32x4*)(rp + bj * HALF) = pack8(acc[ai][bj][m][0], acc[ai][bj][m][1]); }
        } else if (pn < 8) {
#pragma unroll
            for (int ai = 0; ai < 2; ++ai)
#pragma unroll
                for (int m = 0; m < 4; ++m) { float* rp = lat + (size_t)(row0 + ai * HALF + m * 16) * 512 + (pn - 6) * BM + cw;
#pragma unroll
                    for (int bj = 0; bj < 2; ++bj) { *(f32x4*)(rp + bj * HALF) = acc[ai][bj][m][0]; *(f32x4*)(rp + bj * HALF + 4) = acc[ai][bj][m][1]; } }
        } else {
            const int gc = (pn - 8) * BM + cw;
            f32x4 bv[2][2];
#pragma unroll
            for (int bj = 0; bj < 2; ++bj)
#pragma unroll
                for (int n = 0; n < 2; ++n) bv[bj][n] = *(const f32x4*)(bgate + gc + bj * HALF + 4 * n);
#pragma unroll
            for (int ai = 0; ai < 2; ++ai)
#pragma unroll
                for (int m = 0; m < 4; ++m) { bf16_t* rp = gates + (size_t)(row0 + ai * HALF + m * 16) * 2048 + gc;
#pragma unroll
                    for (int bj = 0; bj < 2; ++bj) { f32x4 v[2];
#pragma unroll
                        for (int n = 0; n < 2; ++n) {
#ifdef PROBE_NO_BIAS
                            const f32x4 x = acc[ai][bj][m][n];
#else
                            const f32x4 x = acc[ai][bj][m][n] + bv[bj][n];
#endif
#pragma unroll
                            for (int j = 0; j < 4; ++j) {
#ifdef PROBE_PLAIN_GATES
                                v[n][j] = acc[ai][bj][m][n][j];
#elif defined(PROBE_BV_GATES)
                                v[n][j] = bv[bj][n][j] * 16.0f;
#else
                                v[n][j] = fast_sigmoid(x[j]);
#endif
                            } }
                        *(u32x4*)(rp + bj * HALF) = pack8(v[0], v[1]); } }
        }
    }
};
struct EpiPlain {
    static constexpr bool PERM = true, AFTER_DRAIN = false;
    bf16_t* O; int ldc; float scale;
    __device__ __forceinline__ void operator()(const f32x4 (&acc)[2][2][4][2], const Unit& u, int wr, int wc, int fr, int fq) const {
        const int row0 = u.pm * BM + wr * 64 + fr; const int col0 = u.pn * BM + wc * 32 + 8 * fq;
#pragma unroll
        for (int ai = 0; ai < 2; ++ai)
#pragma unroll
            for (int m = 0; m < 4; ++m) { bf16_t* rp = O + (size_t)(row0 + ai * HALF + m * 16) * ldc + col0;
#pragma unroll
                for (int bj = 0; bj < 2; ++bj) *(u32x4*)(rp + bj * HALF) = pack8(acc[ai][bj][m][0] * scale, acc[ai][bj][m][1] * scale); }
    }
};
struct EpiVt {
    static constexpr bool PERM = false, AFTER_DRAIN = false;
    bf16_t* Vt;
    __device__ __forceinline__ void operator()(const f32x4 (&acc)[2][2][4][2], const Unit& u, int wr, int wc, int fr, int fq) const {
        constexpr int T_ = 8208, TP_ = 8320, M_ = 4 * 8208;
        const int feat0 = u.pm * BM + wr * 64 + fr; const int pos = 8 * (fq & 1) + 4 * (fq >> 1);
#pragma unroll
        for (int bj = 0; bj < 2; ++bj)
#pragma unroll
            for (int n = 0; n < 2; ++n) {
                const int tok0 = u.pn * BM + bj * HALF + wc * 32 + n * 16;
                if (tok0 < M_) {
                    const int b = tok0 / T_, t0 = tok0 - b * T_;
                    bf16_t* vp = Vt + ((size_t)b * 512 + feat0) * TP_ + t0 + pos;
#pragma unroll
                    for (int ai = 0; ai < 2; ++ai)
#pragma unroll
                        for (int m = 0; m < 4; ++m) { const f32x4 x = acc[ai][bj][m][n]; u32x2 w; w.x = cvt_pk_bf16(x[0], x[1]); w.y = cvt_pk_bf16(x[2], x[3]);
                            *(u32x2*)(vp + (size_t)(ai * HALF + m * 16) * TP_) = w; }
                }
            }
    }
};
template <bool ACCUM> struct EpiGate {
    static constexpr bool PERM = true, AFTER_DRAIN = false;
    bf16_t* O; const bf16_t* G;
    __device__ __forceinline__ void operator()(const f32x4 (&acc)[2][2][4][2], const Unit& u, int wr, int wc, int fr, int fq) const {
        const int row0 = u.pm * BM + wr * 64 + fr; const int col0 = u.pn * BM + wc * 32 + 8 * fq;
#pragma unroll
        for (int ai = 0; ai < 2; ++ai)
#pragma unroll
            for (int m = 0; m < 4; ++m) { const size_t row = (size_t)(row0 + ai * HALF + m * 16);
#pragma unroll
                for (int bj = 0; bj < 2; ++bj) {
                    const u32x4 g = *(const u32x4*)(G + row * 2048 + col0 + bj * HALF);
                    f32x4 a = acc[ai][bj][m][0], b = acc[ai][bj][m][1];
                    a[0] *= bf_lo(g.x); a[1] *= bf_hi(g.x); a[2] *= bf_lo(g.y); a[3] *= bf_hi(g.y);
                    b[0] *= bf_lo(g.z); b[1] *= bf_hi(g.z); b[2] *= bf_lo(g.w); b[3] *= bf_hi(g.w);
                    bf16_t* op = O + row * 1024 + col0 + bj * HALF;
                    if (ACCUM) { const u32x4 p = *(const u32x4*)op;
                        a[0] += bf_lo(p.x); a[1] += bf_hi(p.x); a[2] += bf_lo(p.y); a[3] += bf_hi(p.y);
                        b[0] += bf_lo(p.z); b[1] += bf_hi(p.z); b[2] += bf_lo(p.w); b[3] += bf_hi(p.w); }
                    *(u32x4*)op = pack8(a, b);
                }
            }
    }
};

template <class Epi, class Sched, bool ALIGN_EPI = false, bool SP2 = false>
__device__ __forceinline__ void gemm_phase(PG8_LAS unsigned char* lds, const Gemm g, const Sched& S, const Epi& E) {
    int tid_ = threadIdx.x; asm volatile("" : "+v"(tid_));
    const int tid = tid_, wid = __builtin_amdgcn_readfirstlane(tid >> 6), lane = tid & 63, wr = wid >> 2, wc = wid & 3, fr = lane & 15, fq = lane >> 4;
    int K_ = g.K; asm volatile("" : "+s"(K_));
    const int K = K_, nt = K / BK;
    unsigned voffA[2], voffB[2];
#pragma unroll
    for (int i = 0; i < 2; ++i) { int R, C; stage_rc(tid * 16 + i * 8192, R, C); const int Rb = Epi::PERM ? ((R & ~31) + perm32(R & 31)) : R;
        voffA[i] = (unsigned)(R * K + C) * 2u; voffB[i] = (unsigned)(Rb * K + C) * 2u; }
    const size_t kstep = (size_t)(BK * 2);
    const size_t hstep = (size_t)HALF * K * 2;
    const size_t tstep = 2 * hstep;
    const unsigned ldsw = (unsigned)wid * 1024u;
    const int aoff = lds_byte(wr * 64 + fr, fq * 8), boff = lds_byte(wc * 32 + fr, fq * 8);
#define PG8_SA(b, h) (((b) * 2 + (h)) * HTB)
#define PG8_SB(b, h) ((4 + (b) * 2 + (h)) * HTB)
#define PG8_STAGE(bufoff, gbase, voff) do { _Pragma("unroll") for (int _i = 0; _i < 2; ++_i) \
        __builtin_amdgcn_global_load_lds((const unsigned*)((const char*)(gbase) + (voff)[_i]), (PG8_LAS unsigned*)(lds + (bufoff) + ldsw + _i * 8192), 16, 0, 0); } while (0)
#define PG8_LDA(dst, b, h) do { _Pragma("unroll") for (int m = 0; m < 4; ++m) _Pragma("unroll") for (int k = 0; k < 2; ++k) dst[m][k] = *(const PG8_LAS bf16x8*)(lds + PG8_SA(b, h) + aoff + m * 2048 + k * 1024); } while (0)
#define PG8_LDB(dst, b, h) do { _Pragma("unroll") for (int n = 0; n < 2; ++n) _Pragma("unroll") for (int k = 0; k < 2; ++k) dst[n][k] = *(const PG8_LAS bf16x8*)(lds + PG8_SB(b, h) + boff + n * 2048 + k * 1024); } while (0)
#define PG8_MMA(ai, bj, At, Bt) do { __builtin_amdgcn_s_setprio(1); _Pragma("unroll") for (int m = 0; m < 4; ++m) _Pragma("unroll") for (int n = 0; n < 2; ++n) _Pragma("unroll") for (int k = 0; k < 2; ++k) \
        acc[ai][bj][m][n] = __builtin_amdgcn_mfma_f32_16x16x32_bf16(Bt[n][k], At[m][k], acc[ai][bj][m][n], 0, 0, 0); __builtin_amdgcn_s_setprio(0); } while (0)
#define PG8_WAIT_V(n) asm volatile("s_waitcnt vmcnt(" #n ")" ::: "memory")
#define PG8_WAIT_L(n) asm volatile("s_waitcnt lgkmcnt(" #n ")" ::: "memory")
#define PG8_BAR __builtin_amdgcn_s_barrier()
#define PG8_SCHED __builtin_amdgcn_sched_barrier(0)
    Unit cur, nxt; int ui = 0;
    if (!S.next(0, cur)) return;
    f32x4 acc[2][2][4][2];
#pragma unroll
    for (int a = 0; a < 2; ++a)
#pragma unroll
        for (int b = 0; b < 2; ++b)
#pragma unroll
            for (int m = 0; m < 4; ++m)
#pragma unroll
                for (int n = 0; n < 2; ++n) acc[a][b][m][n] = (f32x4){0.f, 0.f, 0.f, 0.f};
    bf16x8 At[4][2], B0[2][2], B1[2][2];
    const char* cA = (const char*)g.A + (size_t)cur.pm * tstep; const char* cB = (const char*)g.Bt + (size_t)cur.pn * tstep;
    S.a_ready(cur);
    if constexpr (SP2) {
        PG8_STAGE(PG8_SB(0, 0), cB, voffB); PG8_STAGE(PG8_SB(0, 1), cB + hstep, voffB); PG8_STAGE(PG8_SA(0, 0), cA, voffA); PG8_STAGE(PG8_SA(0, 1), cA + hstep, voffA);
        if (wr == 1) PG8_BAR;
        PG8_WAIT_V(2); PG8_BAR;
        PG8_STAGE(PG8_SB(1, 0), cB + kstep, voffB); PG8_STAGE(PG8_SA(1, 0), cA + kstep, voffA); PG8_STAGE(PG8_SB(1, 1), cB + hstep + kstep, voffB);
        PG8_WAIT_V(6); PG8_BAR;
    } else {
        PG8_STAGE(PG8_SB(0, 0), cB, voffB); PG8_STAGE(PG8_SA(0, 0), cA, voffA); PG8_STAGE(PG8_SB(0, 1), cB + hstep, voffB); PG8_STAGE(PG8_SA(0, 1), cA + hstep, voffA);
        if (wr == 1) PG8_BAR;
        PG8_WAIT_V(4); PG8_BAR;
        PG8_STAGE(PG8_SB(1, 0), cB + kstep, voffB); PG8_STAGE(PG8_SA(1, 0), cA + kstep, voffA); PG8_STAGE(PG8_SB(1, 1), cB + hstep + kstep, voffB);
        PG8_WAIT_V(6); PG8_BAR;
    }
    for (;;) {
        const bool has_next = S.next(ui + 1, nxt);
        const char* nA = has_next ? (const char*)g.A + (size_t)nxt.pm * tstep : cA; const char* nB = has_next ? (const char*)g.Bt + (size_t)nxt.pn * tstep : cB;
        for (int t = 0; t < nt; t += 2) {
            const bool last = (t == nt - 2);
            const char* a1 = cA + (size_t)(t + 1) * kstep;
            const char* a2 = last ? nA : cA + (size_t)(t + 2) * kstep; const char* b2 = last ? nB : cB + (size_t)(t + 2) * kstep;
            const char* a3 = a2 + kstep; const char* b3 = b2 + kstep;
            if (last && has_next) S.a_ready(nxt);
            if constexpr (SP2) {
            PG8_LDB(B0, 0, 0); PG8_LDB(B1, 0, 1); PG8_SCHED; PG8_LDA(At, 0, 0); PG8_STAGE(PG8_SA(1, 1), a1 + hstep, voffA);
            PG8_WAIT_V(8); PG8_WAIT_L(0); PG8_BAR; PG8_MMA(0, 0, At, B0); PG8_MMA(0, 1, At, B1); PG8_BAR; PG8_SCHED;
            PG8_LDA(At, 0, 1); PG8_STAGE(PG8_SB(0, 0), b2, voffB); PG8_STAGE(PG8_SB(0, 1), b2 + hstep, voffB); PG8_STAGE(PG8_SA(0, 0), a2, voffA);
            PG8_WAIT_V(8); PG8_WAIT_L(0); PG8_BAR; PG8_MMA(1, 0, At, B0); PG8_MMA(1, 1, At, B1); PG8_BAR; PG8_SCHED;
            PG8_LDB(B0, 1, 0); PG8_LDB(B1, 1, 1); PG8_SCHED; PG8_LDA(At, 1, 0); PG8_STAGE(PG8_SA(0, 1), a2 + hstep, voffA);
            PG8_WAIT_V(8); PG8_WAIT_L(0); PG8_BAR; PG8_MMA(0, 0, At, B0); PG8_MMA(0, 1, At, B1); PG8_BAR; PG8_SCHED;
            PG8_LDA(At, 1, 1); PG8_STAGE(PG8_SB(1, 0), b3, voffB); PG8_STAGE(PG8_SB(1, 1), b3 + hstep, voffB); PG8_STAGE(PG8_SA(1, 0), a3, voffA);
            PG8_WAIT_V(8); PG8_WAIT_L(0); PG8_BAR; PG8_MMA(1, 0, At, B0); PG8_MMA(1, 1, At, B1); PG8_BAR; PG8_SCHED;
            } else {
            PG8_LDB(B0, 0, 0); PG8_SCHED; PG8_LDA(At, 0, 0); PG8_STAGE(PG8_SA(1, 1), a1 + hstep, voffA);
            PG8_WAIT_L(8); PG8_BAR; PG8_WAIT_L(0); PG8_MMA(0, 0, At, B0); PG8_BAR; PG8_SCHED;
            PG8_LDB(B1, 0, 1); PG8_STAGE(PG8_SB(0, 0), b2, voffB);
            PG8_BAR; PG8_WAIT_L(0); PG8_MMA(0, 1, At, B1); PG8_BAR;
            PG8_LDA(At, 0, 1); PG8_STAGE(PG8_SA(0, 0), a2, voffA);
            PG8_BAR; PG8_WAIT_L(0); PG8_MMA(1, 0, At, B0); PG8_BAR; PG8_SCHED;
            PG8_STAGE(PG8_SB(0, 1), b2 + hstep, voffB);
            PG8_WAIT_V(6); PG8_BAR; PG8_MMA(1, 1, At, B1); PG8_BAR;
            PG8_LDB(B0, 1, 0); PG8_SCHED; PG8_LDA(At, 1, 0); PG8_STAGE(PG8_SA(0, 1), a2 + hstep, voffA);
            PG8_WAIT_L(8); PG8_BAR; PG8_WAIT_L(0); PG8_MMA(0, 0, At, B0); PG8_BAR; PG8_SCHED;
            PG8_LDB(B1, 1, 1); PG8_STAGE(PG8_SB(1, 0), b3, voffB);
            PG8_BAR; PG8_WAIT_L(0); PG8_MMA(0, 1, At, B1); PG8_BAR;
            PG8_LDA(At, 1, 1); PG8_STAGE(PG8_SA(1, 0), a3, voffA);
            PG8_BAR; PG8_WAIT_L(0); PG8_MMA(1, 0, At, B0); PG8_BAR; PG8_SCHED;
            PG8_STAGE(PG8_SB(1, 1), b3 + hstep, voffB);
            PG8_WAIT_V(6); PG8_BAR; PG8_MMA(1, 1, At, B1); PG8_BAR;
            }
        }
        if constexpr (ALIGN_EPI) { if (wr == 0) PG8_BAR; }
        if constexpr (!Epi::AFTER_DRAIN) { E(acc, cur, wr, wc, fr, fq); S.done(cur); }
        if (!has_next) break;
#pragma unroll
        for (int a = 0; a < 2; ++a)
#pragma unroll
            for (int b = 0; b < 2; ++b)
#pragma unroll
                for (int m = 0; m < 4; ++m)
#pragma unroll
                    for (int n = 0; n < 2; ++n) acc[a][b][m][n] = (f32x4){0.f, 0.f, 0.f, 0.f};
        cur = nxt; cA = nA; cB = nB; ++ui;
        if constexpr (ALIGN_EPI) { if (wr == 1) PG8_BAR; }
    }
    PG8_WAIT_V(0);
    if constexpr (!ALIGN_EPI) { if (wr == 0) PG8_BAR; }
    PG8_BAR;
    if constexpr (Epi::AFTER_DRAIN) { E.fused(acc, cur, wr, wc, fr, fq, lds, wid, lane); S.done(cur); }
#undef PG8_SA
#undef PG8_SB
#undef PG8_STAGE
#undef PG8_LDA
#undef PG8_LDB
#undef PG8_MMA
#undef PG8_WAIT_V
#undef PG8_WAIT_L
#undef PG8_BAR
#undef PG8_SCHED
}
}

#include <hip/hip_cooperative_groups.h>
#include <type_traits>
namespace cg = cooperative_groups;

constexpr int D_MODEL = 1024, BATCH = 4, SEQ = 8192, DEPTH = 2, N_META = 16, T = SEQ + N_META  , M = BATCH * T  , MPAD = 33024  , MMAIN = 32768  ;
constexpr int D_CONV = 512, D_FF = 2816, D_IN = 4000, D_INP = 4096, NHEAD = 8, TP = 8320;
constexpr float ALPHA = 1.4142135623730951f;
constexpr float LN_EPS = 1e-5f, RMS_EPS = 1e-6f;
constexpr float QSCALE = 0.10206207261596575f * 1.4426950408889634f;
constexpr int NWAVES = 8;

constexpr size_t OFF_CTL = 0;
constexpr size_t OFF_ROPE = 65536;
constexpr size_t OFF_HF = 2097152;
constexpr size_t SZ_HF = (size_t)MPAD * 1024 * 4;
constexpr size_t OFF_W = OFF_HF + SZ_HF;
constexpr size_t SZ_W = 17825792;
constexpr size_t OFF_S = OFF_W + SZ_W;
constexpr size_t SZ_HB = (size_t)MPAD * 1024 * 2;
constexpr size_t S_HB = OFF_S;
constexpr size_t S_GATES = OFF_S + SZ_HB;
constexpr size_t S_ACT = S_GATES;
constexpr size_t S_BCH = S_GATES + (size_t)MPAD * 2048 * 2;
constexpr size_t S_LAT = S_BCH + (size_t)MPAD * 1536 * 2;
constexpr size_t S_END4 = S_LAT + (size_t)MPAD * 512 * 4;
constexpr size_t S_YCONV = S_HB;
constexpr size_t S_CQN = S_YCONV + (size_t)MPAD * 512 * 2;
constexpr size_t S_CKVN = S_CQN + (size_t)MPAD * 256 * 2;
static_assert(S_CKVN + (size_t)MPAD * 256 * 2 <= S_GATES, "row-prep outputs fit in hb's region");
constexpr size_t S_Q = S_BCH;
constexpr size_t S_KN = S_Q + (size_t)MPAD * 768 * 2;
constexpr size_t S_VT = S_KN + (size_t)MPAD * 512 * 2;
constexpr size_t S_YMLA = S_VT + (size_t)BATCH * NHEAD * 64 * TP * 2;
static_assert(S_YMLA + (size_t)MPAD * 512 * 2 <= S_END4, "attention tensors fit in bch|lat's region");
constexpr size_t S_MERGED = S_Q;
static_assert(S_MERGED + (size_t)MPAD * 1024 * 2 <= S_VT + 0 * S_YMLA && S_ACT + (size_t)MPAD * 2816 * 2 <= S_END4, "overlays");
constexpr size_t S_KR = S_END4;
constexpr size_t WS_NEED = S_KR + (size_t)MPAD * 32 * 2;
static_assert(WS_NEED <= 536870912, "fits the guaranteed workspace");
constexpr size_t W_UP = 0, W_DOWN = (size_t)5632 * 1024 * 2;
constexpr size_t W_IN = 0, W_UQ = (size_t)4096 * 1024 * 2, W_UKV = W_UQ + 768 * 256 * 2, W_BC = W_UKV + 1024 * 256 * 2, W_BM = W_BC + 1024 * 512 * 2, W_O = W_BM + 1024 * 512 * 2;
static_assert(W_O + 1024 * 1024 * 2 <= SZ_W && W_DOWN + (size_t)1024 * 2816 * 2 <= SZ_W, "weight region");
constexpr int RING_BYTES = 131072, LDS_MISC = RING_BYTES, LDS_BYTES = RING_BYTES + 256;

#define LAS __attribute__((address_space(3)))
#define GAS __attribute__((address_space(1)))
typedef unsigned short bf16;
typedef unsigned v4u __attribute__((ext_vector_type(4)));
typedef unsigned v2u __attribute__((ext_vector_type(2)));
typedef float f32x4 __attribute__((ext_vector_type(4)));
typedef float f32x2 __attribute__((ext_vector_type(2)));
typedef float f32x16 __attribute__((ext_vector_type(16)));
typedef short bf16x8 __attribute__((ext_vector_type(8)));
#define LDS_WAIT() asm volatile("s_waitcnt lgkmcnt(0)" ::: "memory")

__device__ __forceinline__ unsigned pk2(float lo, float hi) { return pg8::cvt_pk_bf16(lo, hi); }
__device__ __forceinline__ float wave_sum(float v) {
#pragma unroll
    for (int o = 1; o < 64; o <<= 1) v += __shfl_xor(v, o);
    return v;
}

__device__ __forceinline__ float inv_freq_of(int k) {
    switch (k) { case 0: return 1.000000000e+00f; case 1: return 5.623413324e-01f; case 2: return 3.162277639e-01f; case 3: return 1.778279394e-01f; case 4: return 1.000000015e-01f; case 5: return 5.623412877e-02f;
        case 6: return 3.162277862e-02f; case 7: return 1.778279431e-02f; case 8: return 9.999999776e-03f; case 9: return 5.623413250e-03f; case 10: return 3.162277862e-03f; case 11: return 1.778279431e-03f;
        case 12: return 1.000000047e-03f; case 13: return 5.623413017e-04f; case 14: return 3.162277862e-04f; default: return 1.778279402e-04f; }
}
__device__ __forceinline__ void transpose_item(const float* W, int N, int k0, int scol0, bf16* dst, int ldk, int drow0, LAS float* scr, int lane) {
    if (scol0 >= 0) {
#pragma unroll 8
        for (int i = 0; i < 32; ++i) { const int kk = 2 * i + (lane >> 5); scr[kk * 33 + (lane & 31)] = W[(size_t)(k0 + kk) * N + scol0 + (lane & 31)]; }
    } else {
#pragma unroll 8
        for (int i = 0; i < 32; ++i) { const int kk = 2 * i + (lane >> 5); scr[kk * 33 + (lane & 31)] = 0.f; }
    }
    LDS_WAIT(); asm volatile("" ::: "memory");
    const int c = lane & 7;
#pragma unroll
    for (int j = 0; j < 4; ++j) { const int n = (lane >> 3) + 8 * j; const LAS float* s = scr + (8 * c) * 33 + n;
        v4u o; o.x = pk2(s[0 * 33], s[1 * 33]); o.y = pk2(s[2 * 33], s[3 * 33]); o.z = pk2(s[4 * 33], s[5 * 33]); o.w = pk2(s[6 * 33], s[7 * 33]);
        *(v4u*)(dst + (size_t)(drow0 + n) * ldk + k0 + 8 * c) = o; }
    LDS_WAIT(); asm volatile("" ::: "memory");
}
__device__ __forceinline__ void convert_ffn(const float* w_up, const float* w_down, unsigned char* wreg, LAS float* scr, int gw, int ngw, int lane) {
    constexpr int I_UP = 16 * 176, I_DN = 44 * 32;
    for (int it = gw; it < I_UP + I_DN; it += ngw) {
        if (it < I_UP) { const int kb = it / 176, g = it % 176, tile = g >> 3, sub = g & 7;
            const int scol = sub < 4 ? tile * 128 + sub * 32 : D_FF + tile * 128 + (sub - 4) * 32;
            transpose_item(w_up, 2 * D_FF, kb * 64, scol, (bf16*)(wreg + W_UP), 1024, g * 32, scr, lane); }
        else { const int r = it - I_UP, kb = r / 32, g = r % 32; transpose_item(w_down, 1024, kb * 64, g * 32, (bf16*)(wreg + W_DOWN), D_FF, g * 32, scr, lane); }
    }
}
__device__ __forceinline__ void convert_mixer(const float* w_in, const float* w_uq, const float* w_ukv, const float* w_bc, const float* w_bm, const float* w_o, unsigned char* wreg, LAS float* scr, int gw, int ngw, int lane) {
    constexpr int I_IN = 16 * 128, I_UQ = 4 * 24, I_UKV = 4 * 32, I_BR = 8 * 32, I_O = 16 * 32;
    for (int it = gw; it < I_IN + I_UQ + I_UKV + 2 * I_BR + I_O; it += ngw) {
        int r = it;
        if (r < I_IN) { const int kb = r / 128, g = r % 128, n = g * 32; const int scol = n < 1952 ? n : (n < 2048 ? -1 : (n < 3072 ? 1952 + (n - 2048) : 2976 + (n - 3072)));
            transpose_item(w_in, D_IN, kb * 64, scol, (bf16*)(wreg + W_IN), 1024, n, scr, lane); continue; } r -= I_IN;
        if (r < I_UQ) { const int kb = r / 24, g = r % 24; transpose_item(w_uq, 768, kb * 64, g * 32, (bf16*)(wreg + W_UQ), 256, g * 32, scr, lane); continue; } r -= I_UQ;
        if (r < I_UKV) { const int kb = r / 32, g = r % 32, gg = g & 15; const int scol = (gg >> 1) * 128 + (g >> 4) * 64 + (gg & 1) * 32;
            transpose_item(w_ukv, 1024, kb < 2 ? kb * 64 : 0, kb < 2 ? scol : -1, (bf16*)(wreg + W_UKV) + (kb < 2 ? 0 : kb * 64), 256, g * 32, scr, lane); continue; } r -= I_UKV;
        if (r < I_BR) { const int kb = r / 32, g = r % 32; transpose_item(w_bc, 1024, kb * 64, g * 32, (bf16*)(wreg + W_BC), 512, g * 32, scr, lane); continue; } r -= I_BR;
        if (r < I_BR) { const int kb = r / 32, g = r % 32; transpose_item(w_bm, 1024, kb * 64, g * 32, (bf16*)(wreg + W_BM), 512, g * 32, scr, lane); continue; } r -= I_BR;
        { const int kb = r / 32, g = r % 32; transpose_item(w_o, 1024, kb * 64, g * 32, (bf16*)(wreg + W_O), 1024, g * 32, scr, lane); }
    }
}

__device__ __forceinline__ void ln_row(const float* xin, const float* g, const float* bt, float* of32, bf16* ob16, int lane) {
    const f32x4* xr = (const f32x4*)xin + lane;
    f32x4 v[4]; float s = 0.f;
#pragma unroll
    for (int j = 0; j < 4; ++j) { v[j] = xr[64 * j]; s += (v[j].x + v[j].y) + (v[j].z + v[j].w); }
    const float mean = wave_sum(s) * (1.f / 1024.f); float s2 = 0.f;
#pragma unroll
    for (int j = 0; j < 4; ++j) { v[j] = v[j] - mean; s2 += (v[j].x * v[j].x + v[j].y * v[j].y) + (v[j].z * v[j].z + v[j].w * v[j].w); }
    const float rstd = 1.f / sqrtf(wave_sum(s2) * (1.f / 1024.f) + LN_EPS);
#pragma unroll
    for (int j = 0; j < 4; ++j) { const f32x4 gg = ((const f32x4*)g)[lane + 64 * j], bb = ((const f32x4*)bt)[lane + 64 * j]; v[j] = v[j] * rstd * gg + bb; }
    if (of32) {
#pragma unroll
        for (int j = 0; j < 4; ++j) ((f32x4*)of32)[lane + 64 * j] = v[j]; }
    if (ob16) {
#pragma unroll
        for (int j = 0; j < 4; ++j) { v2u w; w.x = pk2(v[j].x, v[j].y); w.y = pk2(v[j].z, v[j].w); ((v2u*)ob16)[lane + 64 * j] = w; } }
}

struct TailResid { float* H; float alpha, coef;
    __device__ __forceinline__ void operator()(int token, int col, const f32x4 s) const { float* p = H + (size_t)token * 1024 + col; const f32x4 h = *(const f32x4*)p; *(f32x4*)p = h * alpha + s * coef; } };
template <bool ACCUM> struct TailGate { bf16* O; const bf16* G;
    __device__ __forceinline__ void operator()(int token, int col, f32x4 s) const {
        const v2u g = *(const v2u*)(G + (size_t)token * 2048 + col); bf16* op = O + (size_t)token * 1024 + col;
        s[0] *= pg8::bf_lo(g.x); s[1] *= pg8::bf_hi(g.x); s[2] *= pg8::bf_lo(g.y); s[3] *= pg8::bf_hi(g.y);
        if (ACCUM) { const v2u p = *(const v2u*)op; s[0] += pg8::bf_lo(p.x); s[1] += pg8::bf_hi(p.x); s[2] += pg8::bf_lo(p.y); s[3] += pg8::bf_hi(p.y); }
        v2u w; w.x = pk2(s[0], s[1]); w.y = pk2(s[2], s[3]); *(v2u*)op = w; } };
template <int NB, class F> __device__ __forceinline__ void tail_gemm_nb(const bf16* A, const bf16* Bt, int K, int blk, int nstrip, const int (&brow)[NB], LAS unsigned char* lds, const F& epi) {
    if (blk >= nstrip) return;
    int tid_ = threadIdx.x; asm volatile("" : "+v"(tid_));
    const int lane = tid_ & 63, wid = tid_ >> 6, fr = lane & 15, fq = lane >> 4, kw = K >> 3;
    const bf16* ap = A + (size_t)fr * K + wid * kw + fq * 8;
    f32x4 acc[NB][4];
#pragma unroll
    for (int j = 0; j < NB; ++j)
#pragma unroll
        for (int m = 0; m < 4; ++m) acc[j][m] = (f32x4){0.f, 0.f, 0.f, 0.f};
    for (int k = 0; k < kw; k += 32) {
        bf16x8 a[4];
#pragma unroll
        for (int m = 0; m < 4; ++m) a[m] = *(const bf16x8*)(ap + (size_t)m * 16 * K + k);
#pragma unroll
        for (int j = 0; j < NB; ++j) { const bf16x8 b = *(const bf16x8*)(Bt + (size_t)(brow[j] + fr) * K + wid * kw + fq * 8 + k);
#pragma unroll
            for (int m = 0; m < 4; ++m) acc[j][m] = __builtin_amdgcn_mfma_f32_16x16x32_bf16(b, a[m], acc[j][m], 0, 0, 0); }
    }
    LAS f32x4* red = (LAS f32x4*)lds;
#pragma unroll
    for (int j = 0; j < NB; ++j)
#pragma unroll
        for (int m = 0; m < 4; ++m) red[((wid * NB + j) * 4 + m) * 64 + lane] = acc[j][m];
    __syncthreads();
    if (wid < 4) { f32x4 s[NB];
#pragma unroll
        for (int j = 0; j < NB; ++j) { s[j] = red[(j * 4 + wid) * 64 + lane];
#pragma unroll
            for (int w = 1; w < 8; ++w) s[j] = s[j] + red[((w * NB + j) * 4 + wid) * 64 + lane]; }
        epi(wid * 16 + fr, fq * 4, s); }
    __syncthreads();
}
template <class F> struct TailOne { const F& f; int n0; __device__ __forceinline__ void operator()(int token, int c4, const f32x4 (&s)[1]) const { f(token, n0 + c4, s[0]); } };
template <class F> __device__ __forceinline__ void tail_gemm(const bf16* A, const bf16* Bt, int K, int blk, LAS unsigned char* lds, const F& epi) {
    const int brow[1] = {blk * 16}; const TailOne<F> e{epi, blk * 16};
    tail_gemm_nb<1>(A, Bt, K, blk, 64, brow, lds, e);
}
struct TailSwiGLU { bf16* O; int c0;
    __device__ __forceinline__ void operator()(int token, int c4, const f32x4 (&s)[2]) const { f32x4 v;
#pragma unroll
        for (int i = 0; i < 4; ++i) v[i] = s[0][i] * pg8::fast_sigmoid(s[0][i]) * s[1][i];
        v2u w; w.x = pk2(v[0], v[1]); w.y = pk2(v[2], v[3]); *(v2u*)(O + (size_t)token * D_FF + c0 + c4) = w; } };
struct TailInProj { bf16* bch_; float* lat_; bf16* gates_; const float* bgate; int c0;
    __device__ __forceinline__ void operator()(int token, int c4, const f32x4 (&s)[1]) const { const int c = c0 + c4; f32x4 v = s[0];
        if (c < 1536) { v2u w; w.x = pk2(v[0], v[1]); w.y = pk2(v[2], v[3]); *(v2u*)(bch_ + (size_t)token * 1536 + c) = w; }
        else if (c < 2048) { *(f32x4*)(lat_ + (size_t)token * 512 + (c - 1536)) = v; }
        else { const f32x4 bv = *(const f32x4*)(bgate + (c - 2048));
#pragma unroll
            for (int i = 0; i < 4; ++i) v[i] = pg8::fast_sigmoid(v[i] + bv[i]);
            v2u w; w.x = pk2(v[0], v[1]); w.y = pk2(v[2], v[3]); *(v2u*)(gates_ + (size_t)token * 2048 + (c - 2048)) = w; } } };

namespace att {
constexpr int KB = 12288, VB = 8192, OFF_V = 3 * KB, OFF_WS = 3 * KB + 3 * VB, OFF_Q = OFF_WS + 8 * 256;
__device__ __forceinline__ int crow(int r, int hi) { return (r & 3) + 8 * (r >> 2) + 4 * hi; }
__device__ __forceinline__ float max3f(float a, float b, float c) { return __builtin_fmaxf(__builtin_fmaxf(a, b), c); }
__device__ __forceinline__ void attn_unit(int b, int h, int qb, const bf16* Q, const bf16* Kn, const bf16* Kr, const bf16* Vt, const float* rope, bf16* Y, LAS unsigned char* lds) {
    int tid_ = threadIdx.x; asm volatile("" : "+v"(tid_));
    const int tid = tid_, lane = tid & 63, r32 = lane & 31, hi = lane >> 5; const int wid = __builtin_amdgcn_readfirstlane(tid >> 6);
    const int q0 = qb * 256, q0w = q0 + wid * 32;
    const size_t rowbase = (size_t)b * T;
    int NT = (q0 + 256) / 64; if (NT > (T + 63) / 64) NT = (T + 63) / 64;
    int ntw = 0; if (q0w < T) { ntw = (q0w + 31) / 64 + 1; if (ntw > NT) ntw = NT; }
    bf16x8 qr[6];
    { int tq = q0w + r32; if (tq > T - 1) tq = T - 1; const bf16* qp = Q + (rowbase + tq) * 768 + h * 96 + hi * 8;
#pragma unroll
      for (int d0 = 0; d0 < 6; ++d0) qr[d0] = *(const GAS bf16x8*)(qp + d0 * 16);
      const float* rt = rope + (size_t)tq * 32 + 8 * hi; const f32x4 c0 = *(const GAS f32x4*)rt, c1 = *(const GAS f32x4*)(rt + 4), s0 = *(const GAS f32x4*)(rt + 16), s1 = *(const GAS f32x4*)(rt + 20);
      v4u a = __builtin_bit_cast(v4u, qr[4]), bb = __builtin_bit_cast(v4u, qr[5]), oa, ob;
#define ROT2(AW, BW, CA, CB, SA, SB, OA, OB) do { const float x1l = pg8::bf_lo(AW), x1h = pg8::bf_hi(AW), x2l = pg8::bf_lo(BW), x2h = pg8::bf_hi(BW); \
        OA = pk2(x1l * (CA) - x2l * (SA), x1h * (CB) - x2h * (SB)); OB = pk2(x2l * (CA) + x1l * (SA), x2h * (CB) + x1h * (SB)); } while (0)
      ROT2(a.x, bb.x, c0[0], c0[1], s0[0], s0[1], oa.x, ob.x); ROT2(a.y, bb.y, c0[2], c0[3], s0[2], s0[3], oa.y, ob.y);
      ROT2(a.z, bb.z, c1[0], c1[1], s1[0], s1[1], oa.z, ob.z); ROT2(a.w, bb.w, c1[2], c1[3], s1[2], s1[3], oa.w, ob.w);
#undef ROT2
      qr[4] = __builtin_bit_cast(bf16x8, oa); qr[5] = __builtin_bit_cast(bf16x8, ob); }
    const bf16* kn_src = Kn + (rowbase + (tid >> 3)) * 512 + h * 64 + (tid & 7) * 8;
    const bf16* kr_src = Kr + (rowbase + ((tid & 255) >> 2)) * 32 + (tid & 3) * 8;
    const bf16* v_src = Vt + ((size_t)(b * 8 + h) * 64 + (tid >> 3)) * TP + (tid & 7) * 8;
    const int kn_dst = (tid & 7) * 1024 + (((tid >> 3) ^ (tid & 7)) << 4);
    const int kr_dst = (8 + (tid & 3)) * 1024 + ((((tid & 255) >> 2) ^ (tid & 3)) << 4);
    const int v_dst = OFF_V + (tid & 7) * 1024 + (((tid >> 3) ^ (tid & 7)) << 4);
    int kaddr[6], vaddr[4];
#pragma unroll
    for (int d0 = 0; d0 < 6; ++d0) kaddr[d0] = (int)(unsigned)(uintptr_t)lds + (2 * d0 + hi) * 1024 + ((r32 ^ ((2 * d0 + hi) & 7)) << 4);
#pragma unroll
    for (int ks = 0; ks < 4; ++ks) vaddr[ks] = (int)(unsigned)(uintptr_t)lds + OFF_V + (2 * ks + hi) * 1024 + ((r32 ^ (2 * ks + hi)) << 4);
    v4u kA, krA = (v4u){0u, 0u, 0u, 0u}, vA;
#define ATT_LOADK(kt, K_, KR_) do { K_ = *(const GAS v4u*)(kn_src + (size_t)(kt) * 64 * 512); if (wid < 4) KR_ = *(const GAS v4u*)(kr_src + (size_t)(kt) * 64 * 32); } while (0)
#define ATT_LOADV(kt, V_) do { V_ = *(const GAS v4u*)(v_src + (size_t)(kt) * 64); } while (0)
#define ATT_STOREK(slot, K_, KR_) do { *(LAS v4u*)(lds + (slot) * KB + kn_dst) = K_; if (wid < 4) *(LAS v4u*)(lds + (slot) * KB + kr_dst) = KR_; } while (0)
#define ATT_STOREV(slot, V_) do { *(LAS v4u*)(lds + (slot) * VB + v_dst) = V_; } while (0)
    LAS float* wsf = (LAS float*)(lds + OFF_WS + wid * 256);
    const bool skew = wid >= 4;
    bf16x8 pw[4];
    float mrow = 0.f, lsum = 0.f;
    f32x16 o0, o1, negm, p0, p1;
#pragma unroll
    for (int r = 0; r < 16; ++r) { o0[r] = 0.f; o1[r] = 0.f; negm[r] = 0.f; p0[r] = 0.f; p1[r] = 0.f; }
#define ATT_PV(VOFF) do { \
        _Pragma("unroll") for (int ks = 0; ks < 4; ++ks) { \
            const bf16x8 v0 = *(const LAS bf16x8*)(unsigned)(vaddr[ks] + (VOFF)), v1 = *(const LAS bf16x8*)(unsigned)(vaddr[ks] + (VOFF) + 512); \
            o0 = __builtin_amdgcn_mfma_f32_32x32x16_bf16(pw[ks], v0, o0, 0, 0, 0); \
            o1 = __builtin_amdgcn_mfma_f32_32x32x16_bf16(pw[ks], v1, o1, 0, 0, 0); } } while (0)
#define ATT_QK(KOFF) do { \
        _Pragma("unroll") for (int d0 = 0; d0 < 6; ++d0) { \
            const bf16x8 a0 = *(const LAS bf16x8*)(unsigned)(kaddr[d0] + (KOFF)), a1 = *(const LAS bf16x8*)(unsigned)(kaddr[d0] + (KOFF) + 512); \
            p0 = __builtin_amdgcn_mfma_f32_32x32x16_bf16(a0, qr[d0], d0 == 0 ? negm : p0, 0, 0, 0); \
            p1 = __builtin_amdgcn_mfma_f32_32x32x16_bf16(a1, qr[d0], d0 == 0 ? negm : p1, 0, 0, 0); } } while (0)
    auto softmax_tile = [&](const int kt) __attribute__((always_inline)) {
        if (64 * kt + 63 > q0w) {
            const int q = q0w + r32, kbase = 64 * kt + 4 * hi;
#pragma unroll
            for (int r = 0; r < 16; ++r) { const int key = kbase + (r & 3) + 8 * (r >> 2); if (key > q) p0[r] = -1e30f; if (key + 32 > q) p1[r] = -1e30f; }
        }
        float mxa = max3f(p0[0], p0[1], p1[0]), mxb = max3f(p0[2], p0[3], p1[1]); mxa = max3f(mxa, p1[2], p1[3]);
#pragma unroll
        for (int r = 4; r < 16; r += 4) { mxa = max3f(mxa, p0[r], p0[r + 1]); mxb = max3f(mxb, p0[r + 2], p0[r + 3]); mxa = max3f(mxa, p1[r], p1[r + 1]); mxb = max3f(mxb, p1[r + 2], p1[r + 3]); }
        float mx = fmaxf(mxa, mxb);
        mx = fmaxf(mx, __shfl_xor(mx, 32));
        if (kt == 0 || __any(mx > 8.0f)) {
            const float dl = (kt == 0) ? mx : fmaxf(mx, 0.f), alpha = __builtin_amdgcn_exp2f(-dl);
            mrow += dl; lsum *= alpha;
#pragma unroll
            for (int r = 0; r < 16; ++r) { p0[r] -= dl; p1[r] -= dl; negm[r] = -mrow; }
            if (hi == 0) wsf[r32] = alpha;
            LDS_WAIT();
#pragma unroll
            for (int i = 0; i < 4; ++i) { const f32x4 a = *(const LAS f32x4*)(wsf + 8 * i + 4 * hi);
#pragma unroll
                for (int j = 0; j < 4; ++j) { o0[4 * i + j] *= a[j]; o1[4 * i + j] *= a[j]; } }
        }
        float s = 0.f;
#pragma unroll
        for (int r = 0; r < 16; ++r) { p0[r] = __builtin_amdgcn_exp2f(p0[r]); p1[r] = __builtin_amdgcn_exp2f(p1[r]); s += p0[r] + p1[r]; }
        lsum += s;
#pragma unroll
        for (int ks = 0; ks < 4; ++ks) { v4u w;
            if (ks < 2) { w.x = pk2(p0[8 * ks + 0], p0[8 * ks + 1]); w.y = pk2(p0[8 * ks + 2], p0[8 * ks + 3]); w.z = pk2(p0[8 * ks + 4], p0[8 * ks + 5]); w.w = pk2(p0[8 * ks + 6], p0[8 * ks + 7]); }
            else { const int k2 = ks - 2; w.x = pk2(p1[8 * k2 + 0], p1[8 * k2 + 1]); w.y = pk2(p1[8 * k2 + 2], p1[8 * k2 + 3]); w.z = pk2(p1[8 * k2 + 4], p1[8 * k2 + 5]); w.w = pk2(p1[8 * k2 + 6], p1[8 * k2 + 7]); }
            pw[ks] = __builtin_bit_cast(bf16x8, w); }
    };
    ATT_LOADK(0, kA, krA); ATT_LOADV(0, vA); ATT_STOREK(0, kA, krA); ATT_STOREV(0, vA);
    if (NT > 1) { ATT_LOADK(1, kA, krA); ATT_STOREK(1, kA, krA); }
    __syncthreads();
    if (!skew && 0 < ntw) ATT_QK(0);
    int s0 = 0, s1 = 1, s2 = 2;
#define ATT_STEP(COMPUTE) do { \
        if (kt + 2 < NT) ATT_LOADK(kt + 2, kA, krA); if (kt + 1 < NT) ATT_LOADV(kt + 1, vA); \
        COMPUTE; \
        if (kt + 2 < NT) ATT_STOREK(s2, kA, krA); if (kt + 1 < NT) ATT_STOREV(s1, vA); \
        { const int t_ = s0; s0 = s1; s1 = s2; s2 = t_; } \
        asm volatile("s_waitcnt lgkmcnt(0)\n\ts_barrier" ::: "memory");   \
    } while (0)
    if (!skew) {
        for (int kt = 0; kt < NT; ++kt) ATT_STEP({ if (kt < ntw) { softmax_tile(kt); ATT_PV(s0 * VB); } if (kt + 1 < ntw) ATT_QK(s1 * KB); });
    } else {
        for (int kt = 0; kt < NT; ++kt) ATT_STEP({ if (kt >= 1 && kt - 1 < ntw) ATT_PV(s2 * VB); if (kt < ntw) { ATT_QK(s0 * KB); softmax_tile(kt); } });
    }
#undef ATT_STEP
    if (skew && NT - 1 < ntw) ATT_PV(((NT - 1) % 3) * VB);
#undef ATT_PV
#undef ATT_QK
    if (ntw > 0) {
        lsum += __shfl_xor(lsum, 32);
        if (hi == 0) wsf[32 + r32] = 1.0f / lsum;
        LDS_WAIT();
        bf16* yp = Y + (rowbase + q0w) * 512 + h * 64 + r32;
#pragma unroll
        for (int i = 0; i < 4; ++i) { const f32x4 a = *(const LAS f32x4*)(wsf + 32 + 8 * i + 4 * hi);
#pragma unroll
            for (int j = 0; j < 4; ++j) { const int r = 4 * i + j, q = crow(r, hi);
                if (q0w + q < T) { const unsigned w = pk2(o0[r] * a[j], o1[r] * a[j]); ((GAS bf16*)yp)[(size_t)q * 512] = (bf16)(w & 0xffffu); ((GAS bf16*)yp)[(size_t)q * 512 + 32] = (bf16)(w >> 16); } } }
        LDS_WAIT();
    }
#undef ATT_LOADK
#undef ATT_LOADV
#undef ATT_STOREK
#undef ATT_STOREV
}
}

#ifdef PROBE_SYS_SCOPE
#define XB_SCOPE ""
#else
#define XB_SCOPE "agent"
#endif
#define XB_TMO      128
#define XB_XCNT(j)  (256  + 64 * (j))
#define XB_XSUB(j)  (1280 + 64 * (j))
#define XB_XGEN(j)  (2304 + 64 * (j))
#define XB_TOP      3328
#define XB_TOPGEN   3392
#define XCD_BAR_WORDS 3456
#define XB_SPIN_CAP (1u << 18)

__device__ __forceinline__ unsigned xb_ld(unsigned* p)              { return __hip_atomic_load(p, __ATOMIC_RELAXED, __HIP_MEMORY_SCOPE_AGENT); }
__device__ __forceinline__ unsigned xb_add(unsigned* p, unsigned v) { return __hip_atomic_fetch_add(p, v, __ATOMIC_RELAXED, __HIP_MEMORY_SCOPE_AGENT); }
__device__ __forceinline__ unsigned xb_xcc_id() { return (unsigned)__builtin_amdgcn_s_getreg((3 << 11) | 20) & 0xFu; }
#define XB_SPIN(cond, bar) do { unsigned _sp = 0; while (cond) { __builtin_amdgcn_s_sleep(1); \
    if ((++_sp & 255u) == 0u) { if (xb_ld(&(bar)[XB_TMO])) break; if (_sp > XB_SPIN_CAP) { atomicAdd(&(bar)[XB_TMO], 1u); break; } } } } while (0)

struct XcdBarrier {
    unsigned* bar; unsigned x;
    volatile LAS unsigned* st;
};

__device__ __forceinline__ XcdBarrier xcd_barrier_post(unsigned* bar, volatile LAS unsigned* st) {
    XcdBarrier b; b.bar = bar; b.x = xb_xcc_id(); b.st = st;
    if (threadIdx.x == 0) (void)xb_add(&bar[XB_XCNT(b.x)], 1u);
    return b;
}
__device__ __forceinline__ void xcd_barrier_complete(unsigned* bar, unsigned x, unsigned& nloc, unsigned& nx) {
    const unsigned G = gridDim.x * gridDim.y * gridDim.z;
    unsigned sum, cnt, mine, sp = 0u;
    for (;;) {
        sum = 0u; cnt = 0u; mine = 0u;
#pragma unroll
        for (unsigned j = 0; j < 16; ++j) { const unsigned c = xb_ld(&bar[XB_XCNT(j)]); sum += c; cnt += (c > 0u) ? 1u : 0u; mine = (j == x) ? c : mine; }
        if (sum == G) break;
        __builtin_amdgcn_s_sleep(1);
        if ((++sp & 255u) == 0u) { if (xb_ld(&bar[XB_TMO])) break; if (sp > XB_SPIN_CAP) { atomicAdd(&bar[XB_TMO], 1u); break; } }
    }
    nloc = mine > 0u ? mine : 1u; nx = cnt > 0u ? cnt : 1u;
}

__device__ __forceinline__ void xcd_barrier(const XcdBarrier& b) {
    asm volatile("s_waitcnt vmcnt(0)" ::: "memory");
    __syncthreads();
    if (threadIdx.x == 0) {
        unsigned* bar = b.bar;
        __builtin_amdgcn_s_waitcnt(0);
        unsigned nloc = b.st[0], nx = b.st[1];
        if (nloc == 0u) { xcd_barrier_complete(bar, b.x, nloc, nx); b.st[0] = nloc; b.st[1] = nx; }
        const unsigned old = xb_add(&bar[XB_XSUB(b.x)], 1u);
        const unsigned gen = old / nloc;
        if (old + 1u == (gen + 1u) * nloc) {
            __builtin_amdgcn_fence(__ATOMIC_RELEASE, XB_SCOPE);
            asm volatile("s_waitcnt vmcnt(0)" ::: "memory");
            const unsigned og = xb_add(&bar[XB_TOP], 1u);
            const unsigned tg = og / nx;
            if (og + 1u == (tg + 1u) * nx) xb_add(&bar[XB_TOPGEN], 1u);
            else XB_SPIN(xb_ld(&bar[XB_TOPGEN]) == tg, bar);
            __builtin_amdgcn_fence(__ATOMIC_ACQUIRE, XB_SCOPE);
            xb_add(&bar[XB_XGEN(b.x)], 1u);
            asm volatile("s_waitcnt vmcnt(0)" ::: "memory");
        } else {
            XB_SPIN(xb_ld(&bar[XB_XGEN(b.x)]) == gen, bar);
            __builtin_amdgcn_fence(__ATOMIC_ACQUIRE, XB_SCOPE);
            asm volatile("s_waitcnt vmcnt(0)" ::: "memory");
        }
    }
    __syncthreads();
}

struct Args { const float* in[18]; float* out; unsigned char* ws; };
static_assert(sizeof(Args) == 160, "Args layout");

__global__ void __launch_bounds__(NWAVES * 64, 2) mega_fwd(Args args) {
    extern __shared__ __attribute__((aligned(16))) unsigned char lds_raw[];
    cg::grid_group grid = cg::this_grid();
    LAS unsigned char* lds = (LAS unsigned char*)lds_raw;
    int tid = threadIdx.x, lane = tid & 63; const int wave = __builtin_amdgcn_readfirstlane(tid >> 6);
#define GRID_SYNC() do { XcdBarrier xb_; xb_.bar = ctl + 4096; xb_.x = xb_xcc_id(); xb_.st = (volatile LAS unsigned*)(lds + LDS_MISC) + 8; xcd_barrier(xb_); REBASE(); } while (0)
#define OPQ() do { asm volatile("" : "+v"(tid)); lane = tid & 63; } while (0)
    const int G = gridDim.x, blk = blockIdx.x;
    const int gw = blk * NWAVES + wave, ngw = G * NWAVES;
    const unsigned char* ka = (const unsigned char*)__builtin_amdgcn_kernarg_segment_ptr();
    GAS unsigned char* ws = (GAS unsigned char*)args.ws;
#define REBASE() do { asm volatile("" : "+s"(ka)); asm volatile("" : "+s"(ws)); } while (0)
#define INP(i) ((const float*)(const GAS float*)(*(const float* const*)(ka + 8 * (i))))
#define X_IN INP(0)
#define meta INP(1)
#define ffn1_up INP(2)
#define ffn1_down INP(3)
#define w_in INP(4)
#define b_gate INP(5)
#define conv_w INP(6)
#define q_norm_g INP(7)
#define w_uq INP(8)
#define kv_norm_g INP(9)
#define w_ukv INP(10)
#define w_br_conv INP(11)
#define w_br_mla INP(12)
#define w_o INP(13)
#define ffn2_up INP(14)
#define ffn2_down INP(15)
#define ln_g INP(16)
#define ln_b INP(17)
#define OUTP ((float*)(GAS float*)(*(float* const*)(ka + 144)))
#define ctl ((unsigned*)(ws + OFF_CTL))
#define rope ((float*)(ws + OFF_ROPE))
#define hf ((float*)(ws + OFF_HF))
#define wreg ((unsigned char*)(ws + OFF_W))
#define hb ((bf16*)(ws + S_HB))
#define act ((bf16*)(ws + S_ACT))
#define gates ((bf16*)(ws + S_GATES))
#define bch ((bf16*)(ws + S_BCH))
#define lat ((float*)(ws + S_LAT))
#define yconv ((bf16*)(ws + S_YCONV))
#define cqn ((bf16*)(ws + S_CQN))
#define ckvn ((bf16*)(ws + S_CKVN))
#define krb ((bf16*)(ws + S_KR))
#define Qb ((bf16*)(ws + S_Q))
#define Knb ((bf16*)(ws + S_KN))
#define Vtb ((bf16*)(ws + S_VT))
#define ymla ((bf16*)(ws + S_YMLA))
#define merged ((bf16*)(ws + S_MERGED))
    LAS float* scr = (LAS float*)(lds + wave * 16384);
    LAS unsigned char* ring = lds;
    if (threadIdx.x < 64) ((LAS unsigned*)(lds + LDS_MISC))[threadIdx.x] = 0u;
    __syncthreads();
    (void)xcd_barrier_post(ctl + 4096, (volatile LAS unsigned*)(lds + LDS_MISC) + 8);
    grid.sync();

#ifdef PROBE_DUMP_BIAS
    OPQ();
    for (int row = gw; row < BATCH * SEQ; row += ngw) { float* o = OUTP + (size_t)row * 1024; for (int c = lane; c < 1024; c += 64) o[c] = b_gate[c] + 2.0f * b_gate[1024 + c] + 4.0f * b_gate[2048 + c] + 8.0f * b_gate[3072 + c]; }
    return;
#endif
    OPQ();
    for (int row = gw; row < MPAD; row += ngw) {
        f32x4 v[4];
        if (row < M) { const int b = row / T, t = row - b * T; const f32x4* src = (const f32x4*)(t < N_META ? meta + (size_t)t * 1024 : X_IN + ((size_t)b * SEQ + (t - N_META)) * 1024) + lane;
#pragma unroll
            for (int j = 0; j < 4; ++j) v[j] = src[64 * j]; }
        else {
#pragma unroll
            for (int j = 0; j < 4; ++j) v[j] = (f32x4){0.f, 0.f, 0.f, 0.f}; }
#pragma unroll
        for (int j = 0; j < 4; ++j) { ((f32x4*)(hf + (size_t)row * 1024))[lane + 64 * j] = v[j]; v2u w; w.x = pk2(v[j].x, v[j].y); w.y = pk2(v[j].z, v[j].w); ((v2u*)(hb + (size_t)row * 1024))[lane + 64 * j] = w; }
    }
    for (int i = blk * 512 + tid; i < T * 16; i += G * 512) { const int t = i >> 4, k = i & 15;
        const float inv_freq = inv_freq_of(k); const float ang = (float)t * inv_freq;
        const double rev = (double)ang * 0.15915494309189535; const float fr = (float)(rev - floor(rev));
        rope[t * 32 + k] = __builtin_amdgcn_cosf(fr); rope[t * 32 + 16 + k] = __builtin_amdgcn_sinf(fr); }
    convert_ffn(ffn1_up, ffn1_down, wreg, scr, gw, ngw, lane);
    GRID_SYNC();

    for (int step = 0; step < 3 * DEPTH; ++step) {
        const int l = step / 3, sub = step % 3;
#ifdef PROBE_STEPS
        if (step == PROBE_STEPS) {
            OPQ();
            for (int row = gw; row < M; row += ngw) { const int b = row / T, t = row - b * T; if (t >= N_META) {
#pragma unroll
                for (int j = 0; j < 4; ++j) ((f32x4*)(OUTP + ((size_t)b * SEQ + (t - N_META)) * 1024))[lane + 64 * j] = ((const f32x4*)(hf + (size_t)row * 1024))[lane + 64 * j]; } }
            return;
        }
#endif
        if (sub != 1) {
            { const int c0 = blk * 16, tl = c0 >> 7, j0 = c0 & 127; const int brow[2] = {256 * tl + j0, 256 * tl + 128 + j0};
              tail_gemm_nb<2>(hb + (size_t)MMAIN * 1024, (const bf16*)(wreg + W_UP), 1024, blk, D_FF / 16, brow, lds, TailSwiGLU{act + (size_t)MMAIN * D_FF, c0}); }
            { pg8::Gemm g{hb, (const bf16*)(wreg + W_UP), MMAIN, 2 * D_FF, 1024}; pg8::StaticOrder S; S.init(MMAIN, 2 * D_FF, G, blk);
              pg8::EpiSwiGLU E{act, D_FF};
              pg8::gemm_phase<pg8::EpiSwiGLU, pg8::StaticOrder, true, true>(ring, g, S, E); }
            GRID_SYNC();
            tail_gemm(act + (size_t)MMAIN * D_FF, (const bf16*)(wreg + W_DOWN), D_FF, blk, lds, TailResid{hf + (size_t)MMAIN * 1024, ALPHA, 0.5f});
            { pg8::Gemm g{act, (const bf16*)(wreg + W_DOWN), MMAIN, 1024, D_FF}; pg8::StaticOrder S; S.init(MMAIN, 1024, G, blk);
              pg8::EpiResid E{hf, ALPHA, 0.5f};
              pg8::gemm_phase<pg8::EpiResid, pg8::StaticOrder, true, true>(ring, g, S, E); }
            GRID_SYNC();
            OPQ();
            const int li = (sub == 0) ? 0 : 2; const float* lg = ln_g + ((size_t)l * 3 + li) * 1024; const float* lb = ln_b + ((size_t)l * 3 + li) * 1024;
            const bool final_ln = (step == 3 * DEPTH - 1);
            for (int row = gw; row < MPAD; row += ngw) {
                if (!final_ln) ln_row(hf + (size_t)row * 1024, lg, lb, hf + (size_t)row * 1024, hb + (size_t)row * 1024, lane);
                else if (row < M) { const int b = row / T, t = row - b * T; if (t >= N_META) ln_row(hf + (size_t)row * 1024, lg, lb, OUTP + ((size_t)b * SEQ + (t - N_META)) * 1024, nullptr, lane); }
            }
            if (sub == 0) convert_mixer(w_in + (size_t)l * 1024 * D_IN, w_uq + (size_t)l * 256 * 768, w_ukv + (size_t)l * 128 * 1024, w_br_conv + (size_t)l * 512 * 1024, w_br_mla + (size_t)l * 512 * 1024, w_o + (size_t)l * 1024 * 1024, wreg, scr, gw, ngw, lane);
            else if (!final_ln) convert_ffn(ffn1_up + (size_t)(l + 1) * 1024 * 2 * D_FF, ffn1_down + (size_t)(l + 1) * D_FF * 1024, wreg, scr, gw, ngw, lane);
            if (!final_ln) GRID_SYNC();
        } else {
#ifdef PROBE_DUMP_BIAS1
            OPQ();
            for (int row = gw; row < BATCH * SEQ; row += ngw) { float* o = OUTP + (size_t)row * 1024; for (int c = lane; c < 1024; c += 64) o[c] = b_gate[c] + 2.0f * b_gate[1024 + c] + 4.0f * b_gate[2048 + c] + 8.0f * b_gate[3072 + c]; }
            return;
#endif
            { const int brow[1] = {blk * 16};
              tail_gemm_nb<1>(hb + (size_t)MMAIN * 1024, (const bf16*)(wreg + W_IN), 1024, blk, D_INP / 16, brow, lds,
                              TailInProj{bch + (size_t)MMAIN * 1536, lat + (size_t)MMAIN * 512, gates + (size_t)MMAIN * 2048, b_gate + (size_t)l * 2048, blk * 16}); }
            { pg8::Gemm g{hb, (const bf16*)(wreg + W_IN), MMAIN, D_INP, 1024}; pg8::StaticOrder S; S.init(MMAIN, D_INP, G, blk);
              pg8::EpiInProj E{bch, lat, gates, b_gate + (size_t)l * 2048};
              pg8::gemm_phase<pg8::EpiInProj, pg8::StaticOrder, true, true>(ring, g, S, E); }
            GRID_SYNC();
#ifdef PROBE_DUMP_GATES0
            OPQ();
            for (int row = gw; row < M; row += ngw) { const int b = row / T, t = row - b * T; if (t >= N_META) { float* o = OUTP + ((size_t)b * SEQ + (t - N_META)) * 1024;
                for (int c = lane; c < 1024; c += 64) o[c] = pg8::bf_lo(gates[(size_t)row * 2048 + c]) + 2.0f * pg8::bf_lo(gates[(size_t)row * 2048 + 1024 + c]); } }
            return;
#endif
            OPQ();
            { const float* cw = conv_w + (size_t)l * 3 * 512; const float* qg = q_norm_g + (size_t)l * 256; const float* kg = kv_norm_g + (size_t)l * 128;
              for (int row = gw; row < MPAD; row += ngw) {
                int rr = row < M ? row : M - 1; const int b = rr / T, t = rr - b * T;
                f32x4 ua[2] = {(f32x4){0.f, 0.f, 0.f, 0.f}, (f32x4){0.f, 0.f, 0.f, 0.f}};
#pragma unroll
                for (int k = 0; k < 3; ++k) { const int dt = 2 - k;
                    if (t - dt >= 0 && row < M) { const bf16* rp = bch + (size_t)(row - dt) * 1536 + 8 * lane; const v4u c = *(const v4u*)(rp + 512), hh = *(const v4u*)(rp + 1024);
                        const f32x4 w0 = *(const f32x4*)(cw + k * 512 + 8 * lane), w1 = *(const f32x4*)(cw + k * 512 + 8 * lane + 4);
                        ua[0][0] += w0[0] * pg8::bf_lo(c.x) * pg8::bf_lo(hh.x); ua[0][1] += w0[1] * pg8::bf_hi(c.x) * pg8::bf_hi(hh.x);
                        ua[0][2] += w0[2] * pg8::bf_lo(c.y) * pg8::bf_lo(hh.y); ua[0][3] += w0[3] * pg8::bf_hi(c.y) * pg8::bf_hi(hh.y);
                        ua[1][0] += w1[0] * pg8::bf_lo(c.z) * pg8::bf_lo(hh.z); ua[1][1] += w1[1] * pg8::bf_hi(c.z) * pg8::bf_hi(hh.z);
                        ua[1][2] += w1[2] * pg8::bf_lo(c.w) * pg8::bf_lo(hh.w); ua[1][3] += w1[3] * pg8::bf_hi(c.w) * pg8::bf_hi(hh.w); } }
                { const v4u bb = *(const v4u*)(bch + (size_t)row * 1536 + 8 * lane);
                  v4u o; o.x = pk2(ua[0][0] * pg8::bf_lo(bb.x), ua[0][1] * pg8::bf_hi(bb.x)); o.y = pk2(ua[0][2] * pg8::bf_lo(bb.y), ua[0][3] * pg8::bf_hi(bb.y));
                  o.z = pk2(ua[1][0] * pg8::bf_lo(bb.z), ua[1][1] * pg8::bf_hi(bb.z)); o.w = pk2(ua[1][2] * pg8::bf_lo(bb.w), ua[1][3] * pg8::bf_hi(bb.w));
                  *(v4u*)(yconv + (size_t)row * 512 + 8 * lane) = o; }
                const float* lr = lat + (size_t)row * 512;
                { const f32x4 v = *(const f32x4*)(lr + 4 * lane); const float ss = wave_sum((v.x * v.x + v.y * v.y) + (v.z * v.z + v.w * v.w));
                  const float rs = 1.f / sqrtf(ss * (1.f / 256.f) + RMS_EPS); const f32x4 gg = *(const f32x4*)(qg + 4 * lane);
                  v2u w; w.x = pk2(v.x * rs * gg.x, v.y * rs * gg.y); w.y = pk2(v.z * rs * gg.z, v.w * rs * gg.w); *(v2u*)(cqn + (size_t)row * 256 + 4 * lane) = w; }
                { const f32x2 v = *(const f32x2*)(lr + 256 + 2 * lane); const float ss = wave_sum(v.x * v.x + v.y * v.y);
                  const float rs = 1.f / sqrtf(ss * (1.f / 128.f) + RMS_EPS); const f32x2 gg = *(const f32x2*)(kg + 2 * lane);
                  *(unsigned*)(ckvn + (size_t)row * 256 + 2 * lane) = pk2(v.x * rs * gg.x, v.y * rs * gg.y); *(unsigned*)(ckvn + (size_t)row * 256 + 128 + 2 * lane) = 0u; }
                if (lane < 16) { const float x1 = lr[384 + lane], x2 = lr[400 + lane], cs = rope[t * 32 + lane], sn = rope[t * 32 + 16 + lane];
                  const unsigned w = pk2(x1 * cs - x2 * sn, x2 * cs + x1 * sn); krb[(size_t)row * 32 + lane] = (bf16)(w & 0xffffu); krb[(size_t)row * 32 + 16 + lane] = (bf16)(w >> 16); }
              } }
            GRID_SYNC();
#ifdef PROBE_DUMP_GATES
            OPQ();
            for (int row = gw; row < M; row += ngw) { const int b = row / T, t = row - b * T; if (t >= N_META) { float* o = OUTP + ((size_t)b * SEQ + (t - N_META)) * 1024;
                for (int c = lane; c < 1024; c += 64) o[c] = pg8::bf_lo(gates[(size_t)row * 2048 + c]) + 2.0f * pg8::bf_lo(gates[(size_t)row * 2048 + 1024 + c]); } }
            return;
#endif
#ifdef PROBE_DUMP_ROWPREP
            OPQ();
            for (int row = gw; row < M; row += ngw) { const int b = row / T, t = row - b * T; if (t >= N_META) { float* o = OUTP + ((size_t)b * SEQ + (t - N_META)) * 1024;
                for (int c = lane; c < 1024; c += 64) { float v = 0.f;
                    if (c < 512) v = pg8::bf_lo(yconv[(size_t)row * 512 + c]); else if (c < 768) v = pg8::bf_lo(cqn[(size_t)row * 256 + c - 512]); else if (c < 896) v = pg8::bf_lo(ckvn[(size_t)row * 256 + c - 768]); else if (c < 928) v = pg8::bf_lo(krb[(size_t)row * 32 + c - 896]);
                    else if (c < 960) v = lat[(size_t)row * 512 + 384 + c - 928];
                    o[c] = v; } } }
            return;
#endif
            OPQ();
            for (int i = blk * 512 + tid; i < BATCH * NHEAD * 64 * (TP - T); i += G * 512) { const int r = i / (TP - T), c = i % (TP - T); Vtb[(size_t)r * TP + T + c] = 0; }
            { pg8::Gemm g{cqn, (const bf16*)(wreg + W_UQ), MPAD, 768, 256}; pg8::StaticOrder S; S.init(MPAD, 768, G, blk);
              pg8::EpiPlain E{Qb, 768, QSCALE};
              pg8::gemm_phase<pg8::EpiPlain, pg8::StaticOrder, true, true>(ring, g, S, E); }
            { pg8::Gemm g{ckvn, (const bf16*)(wreg + W_UKV), MPAD, 512, 256}; pg8::StaticOrder S; S.init(MPAD, 512, G, blk);
              pg8::EpiPlain E{Knb, 512, 1.0f};
              pg8::gemm_phase<pg8::EpiPlain, pg8::StaticOrder, true, true>(ring, g, S, E); }
            { pg8::Gemm g{(const bf16*)(wreg + W_UKV) + 512 * 256, ckvn, 512, MPAD, 256}; pg8::StaticOrder S; S.init(512, MPAD, G, blk);
              pg8::EpiVt E{Vtb};
              pg8::gemm_phase<pg8::EpiVt, pg8::StaticOrder, true, true>(ring, g, S, E); }
            GRID_SYNC();
            OPQ();
#ifdef PROBE_NOATTN
            for (size_t i = (size_t)blk * 512 + tid; i < (size_t)MPAD * 512 / 8; i += (size_t)G * 512) ((v4u*)ymla)[i] = (v4u){0u, 0u, 0u, 0u};
            if (false)
#endif
#ifdef PROBE_ATTN_TWICE
            for (int rep = 0; rep < 2; ++rep)
            { const int grp = blk & 7; unsigned* qctr = ctl + 64 * (rep * 16 + l * 8 + grp);
#else
            { const int grp = blk & 7; unsigned* qctr = ctl + 64 * (l * 8 + grp);
#endif
              volatile LAS unsigned* bc = (volatile LAS unsigned*)(lds + LDS_MISC);
              for (;;) {
                  if (tid == 0) bc[0] = atomicAdd(qctr, 1u);
                  __syncthreads();
                  const unsigned u = bc[0];
                  __syncthreads();
                  if (u >= 132u) break;
                  const int qb = 32 - (int)(u >> 2), bh = grp * 4 + (int)(u & 3u);
                  att::attn_unit(bh >> 3, bh & 7, qb, Qb, Knb, krb, Vtb, rope, ymla, lds);
              } }
            GRID_SYNC();
            tail_gemm(yconv + (size_t)MMAIN * 512, (const bf16*)(wreg + W_BC), 512, blk, lds, TailGate<false>{merged + (size_t)MMAIN * 1024, gates + (size_t)MMAIN * 2048});
            tail_gemm(ymla + (size_t)MMAIN * 512, (const bf16*)(wreg + W_BM), 512, blk, lds, TailGate<true>{merged + (size_t)MMAIN * 1024, gates + (size_t)MMAIN * 2048 + 1024});
            { pg8::Gemm g{yconv, (const bf16*)(wreg + W_BC), MMAIN, 1024, 512}; pg8::StaticOrder S; S.init(MMAIN, 1024, G, blk);
              pg8::EpiGate<false> E{merged, gates};
              pg8::gemm_phase<pg8::EpiGate<false>, pg8::StaticOrder, true, true>(ring, g, S, E); }
#ifdef PROBE_SYNC_BETWEEN
            GRID_SYNC();
#endif
#ifndef PROBE_SKIP_BR2
            { pg8::Gemm g{ymla, (const bf16*)(wreg + W_BM), MMAIN, 1024, 512}; pg8::StaticOrder S; S.init(MMAIN, 1024, G, blk);
              pg8::EpiGate<true> E{merged, gates + 1024};
              pg8::gemm_phase<pg8::EpiGate<true>, pg8::StaticOrder, true, true>(ring, g, S, E); }
#endif
            GRID_SYNC();
#ifdef PROBE_DUMP_MERGED
            OPQ();
            for (int row = gw; row < M; row += ngw) { const int b = row / T, t = row - b * T; if (t >= N_META) { float* o = OUTP + ((size_t)b * SEQ + (t - N_META)) * 1024;
                for (int c = lane; c < 1024; c += 64) o[c] = pg8::bf_lo(merged[(size_t)row * 1024 + c]); } }
            return;
#endif
            tail_gemm(merged + (size_t)MMAIN * 1024, (const bf16*)(wreg + W_O), 1024, blk, lds, TailResid{hf + (size_t)MMAIN * 1024, ALPHA, 1.0f});
            { pg8::Gemm g{merged, (const bf16*)(wreg + W_O), MMAIN, 1024, 1024}; pg8::StaticOrder S; S.init(MMAIN, 1024, G, blk);
              pg8::EpiResid E{hf, ALPHA, 1.0f};
              pg8::gemm_phase<pg8::EpiResid, pg8::StaticOrder, true, true>(ring, g, S, E); }
            GRID_SYNC();
            OPQ();
            { const float* lg = ln_g + ((size_t)l * 3 + 1) * 1024; const float* lb = ln_b + ((size_t)l * 3 + 1) * 1024;
              for (int row = gw; row < MPAD; row += ngw) ln_row(hf + (size_t)row * 1024, lg, lb, hf + (size_t)row * 1024, hb + (size_t)row * 1024, lane);
              convert_ffn(ffn2_up + (size_t)l * 1024 * 2 * D_FF, ffn2_down + (size_t)l * D_FF * 1024, wreg, scr, gw, ngw, lane); }
            GRID_SYNC();
        }
    }
}

extern "C" void kernel_launch(void* const* d_in, const int* in_sizes, int n_in, void* d_out, int out_size, void* d_ws, size_t ws_size, hipStream_t stream) {
    static int grid = 0;
    if (grid == 0) {
        if (n_in != 18 || ws_size < WS_NEED) { fprintf(stderr, "kernel_launch: expected 18 inputs and >= %zu bytes of workspace; got %d, %zu\n", (size_t)WS_NEED, n_in, ws_size); grid = -1; return; }
        int dev = 0, cus = 0, per_cu = 0;
        hipGetDevice(&dev); hipDeviceGetAttribute(&cus, hipDeviceAttributeMultiprocessorCount, dev);
        if (hipFuncSetAttribute((const void*)mega_fwd, hipFuncAttributeMaxDynamicSharedMemorySize, LDS_BYTES) != hipSuccess) { fprintf(stderr, "kernel_launch: hipFuncSetAttribute failed\n"); grid = -1; return; }
        hipOccupancyMaxActiveBlocksPerMultiprocessor(&per_cu, (const void*)mega_fwd, NWAVES * 64, LDS_BYTES);
        (void)hipGetLastError();
        if (per_cu < 1) per_cu = 1;
        grid = cus;
    }
    if (grid < 0) return;
    (void)hipMemsetAsync((char*)d_ws + OFF_CTL, 0, 65536, stream);
    Args a{};
    for (int i = 0; i < 18; ++i) a.in[i] = (const float*)d_in[i];
    a.out = (float*)d_out; a.ws = (unsigned char*)d_ws;
    void* params[] = {&a};
    hipError_t e = hipLaunchCooperativeKernel((const void*)mega_fwd, dim3(grid), dim3(NWAVES * 64), params, LDS_BYTES, stream);
    if (e != hipSuccess) fprintf(stderr, "cooperative launch failed: %s (grid %d)\n", hipGetErrorString(e), grid);
}
```

```cpp
#include <hip/hip_runtime.h>
#include <cstdio>
#include <cstdint>
namespace pg8 {
#define PG8_LAS __attribute__((address_space(3)))
typedef unsigned short bf16_t;
typedef short bf16x8 __attribute__((ext_vector_type(8)));
typedef float f32x4 __attribute__((ext_vector_type(4)));
typedef unsigned u32x4 __attribute__((ext_vector_type(4)));
constexpr int BM = 256, BK = 64, HALF = 128, HTB = HALF * BK * 2  , STAGE_BYTES = 8 * HTB, NXCD = 8, WGM = 8;

__host__ __device__ __forceinline__ int lds_byte(int r, int c) { const int st = (r >> 4) * 2 + (c >> 5), rr = r & 15, cc = c & 31, ob = rr * 64 + cc * 2; return st * 1024 + (ob ^ (((ob >> 9) & 1) << 5)); }
__host__ __device__ __forceinline__ void stage_rc(int b, int& R, int& C) { const int st = b / 1024, sb = b % 1024, swz = sb ^ (((sb >> 9) & 1) << 5); R = (st >> 1) * 16 + swz / 64; C = (st & 1) * 32 + (swz % 64) / 2; }
__host__ __device__ __forceinline__ int perm32(int rho) { const int n = rho >> 4, i = rho & 15; return 8 * (i >> 2) + 4 * n + (i & 3); }

struct Unit { int pm, pn; };
struct Gemm { const bf16_t* A; const bf16_t* Bt; int M, N, K; };

struct StaticOrder {
    int nM, nN, nwg, G, c;
    __host__ __device__ void init(int M, int N, int G_, int c_) { nM = M / BM; nN = N / BM; nwg = nM * nN; G = G_; c = c_; }
    __host__ __device__ bool next(int i, Unit& u) const {
        const long L = (long)i * G + c; if (L >= nwg) return false;
        int wgid = (int)L; { const int q = nwg / NXCD, r = nwg % NXCD, xcd = wgid % NXCD, off = wgid / NXCD; wgid = (xcd < r ? xcd * (q + 1) : r * (q + 1) + (xcd - r) * q) + off; }
        const int nig = WGM * nN, gid = wgid / nig, fm = gid * WGM, gsz = (nM - fm) < WGM ? (nM - fm) : WGM;
        u.pm = fm + ((wgid % nig) % gsz); u.pn = (wgid % nig) / gsz; return true;
    }
    __device__ __forceinline__ void a_ready(const Unit&) const {}
    __device__ __forceinline__ void done(const Unit&) const {}
};

struct SignalOrder : StaticOrder {
    unsigned* tot_main; unsigned* tot_tail;
    __device__ __forceinline__ void done(const Unit& u) const {
        asm volatile("s_waitcnt vmcnt(0)" ::: "memory");
        if ((threadIdx.x & 63) == 0) __hip_atomic_fetch_add(u.pm < 128 ? tot_main : tot_tail, 1u, __ATOMIC_RELAXED, __HIP_MEMORY_SCOPE_AGENT);
    }
};
typedef float f32x2 __attribute__((ext_vector_type(2)));
typedef __bf16 bf16x2_cv __attribute__((ext_vector_type(2)));
__device__ __forceinline__ unsigned cvt_pk_bf16(float lo, float hi) { f32x2 v = {lo, hi}; bf16x2_cv b = __builtin_convertvector(v, bf16x2_cv); return __builtin_bit_cast(unsigned, b); }
__device__ __forceinline__ float fast_sigmoid(float x) { return __builtin_amdgcn_rcpf(1.0f + __builtin_amdgcn_exp2f(-1.4426950408889634f * x)); }
__device__ __forceinline__ u32x4 pack8(const f32x4 a, const f32x4 b) { u32x4 w; w.x = cvt_pk_bf16(a[0], a[1]); w.y = cvt_pk_bf16(a[2], a[3]); w.z = cvt_pk_bf16(b[0], b[1]); w.w = cvt_pk_bf16(b[2], b[3]); return w; }
typedef unsigned u32x2 __attribute__((ext_vector_type(2)));
__device__ __forceinline__ float bf_lo(unsigned w) { return __uint_as_float(w << 16); }
__device__ __forceinline__ float bf_hi(unsigned w) { return __uint_as_float(w & 0xffff0000u); }

struct EpiSwiGLU {
    static constexpr bool PERM = true, AFTER_DRAIN = false;
    bf16_t* O; int ldc;
    __device__ __forceinline__ void operator()(const f32x4 (&acc)[2][2][4][2], const Unit& u, int wr, int wc, int fr, int fq) const {
        const int row0 = u.pm * BM + wr * 64 + fr; const int col0 = u.pn * 128 + wc * 32 + 8 * fq;
#pragma unroll
        for (int ai = 0; ai < 2; ++ai)
#pragma unroll
            for (int m = 0; m < 4; ++m) {
                f32x4 v[2];
#pragma unroll
                for (int n = 0; n < 2; ++n) { const f32x4 g = acc[ai][0][m][n], up = acc[ai][1][m][n];
#pragma unroll
                    for (int j = 0; j < 4; ++j) v[n][j] = g[j] * fast_sigmoid(g[j]) * up[j]; }
                *(u32x4*)(O + (size_t)(row0 + ai * HALF + m * 16) * ldc + col0) = pack8(v[0], v[1]);
            }
    }
};
__device__ __forceinline__ void st_wt(float* p, const f32x4 v) { asm volatile("global_store_dwordx4 %0, %1, off sc0 sc1" :: "v"(p), "v"(v) : "memory"); }
struct EpiResid {
    static constexpr bool PERM = true, AFTER_DRAIN = false, WT = false;
    float* H; float alpha, coef;
    __device__ __forceinline__ void operator()(const f32x4 (&acc)[2][2][4][2], const Unit& u, int wr, int wc, int fr, int fq) const {
        const int row0 = u.pm * BM + wr * 64 + fr; const int col0 = u.pn * BM + wc * 32 + 8 * fq;
#pragma unroll
        for (int ai = 0; ai < 2; ++ai)
#pragma unroll
            for (int m = 0; m < 4; ++m) {
                float* rp = H + (size_t)(row0 + ai * HALF + m * 16) * 1024 + col0;
#pragma unroll
                for (int bj = 0; bj < 2; ++bj) {
                    f32x4 a = *(const f32x4*)(rp + bj * HALF), b = *(const f32x4*)(rp + bj * HALF + 4);
                    a = a * alpha + acc[ai][bj][m][0] * coef; b = b * alpha + acc[ai][bj][m][1] * coef;
                    if (WT) { st_wt(rp + bj * HALF, a); st_wt(rp + bj * HALF + 4, b); } else { *(f32x4*)(rp + bj * HALF) = a; *(f32x4*)(rp + bj * HALF + 4) = b; }
                }
            }
    }
};
struct EpiInProj {
    static constexpr bool PERM = true, AFTER_DRAIN = false;
    bf16_t* bch; float* lat; bf16_t* gates; const float* bgate;
    __device__ __forceinline__ void operator()(const f32x4 (&acc)[2][2][4][2], const Unit& u, int wr, int wc, int fr, int fq) const {
        const int row0 = u.pm * BM + wr * 64 + fr; const int cw = wc * 32 + 8 * fq; const int pn = u.pn;
        if (pn < 6) {
#pragma unroll
            for (int ai = 0; ai < 2; ++ai)
#pragma unroll
                for (int m = 0; m < 4; ++m) { bf16_t* rp = bch + (size_t)(row0 + ai * HALF + m * 16) * 1536 + pn * BM + cw;
#pragma unroll
                    for (int bj = 0; bj < 2; ++bj) *(u32x4*)(rp + bj * HALF) = pack8(acc[ai][bj][m][0], acc[ai][bj][m][1]); }
        } else if (pn < 8) {
#pragma unroll
            for (int ai = 0; ai < 2; ++ai)
#pragma unroll
                for (int m = 0; m < 4; ++m) { float* rp = lat + (size_t)(row0 + ai * HALF + m * 16) * 512 + (pn - 6) * BM + cw;
#pragma unroll
                    for (int bj = 0; bj < 2; ++bj) { *(f32x4*)(rp + bj * HALF) = acc[ai][bj][m][0]; *(f32x4*)(rp + bj * HALF + 4) = acc[ai][bj][m][1]; } }
        } else {
            const int gc = (pn - 8) * BM + cw;
            f32x4 bv[2][2];
#pragma unroll
            for (int bj = 0; bj < 2; ++bj)
#pragma unroll
                for (int n = 0; n < 2; ++n) bv[bj][n] = *(const f32x4*)(bgate + gc + bj * HALF + 4 * n);
#pragma unroll
            for (int ai = 0; ai < 2; ++ai)
#pragma unroll
                for (int m = 0; m < 4; ++m) { bf16_t* rp = gates + (size_t)(row0 + ai * HALF + m * 16) * 2048 + gc;
#pragma unroll
                    for (int bj = 0; bj < 2; ++bj) { f32x4 v[2];
#pragma unroll
                        for (int n = 0; n < 2; ++n) {
#ifdef PROBE_NO_BIAS
                            const f32x4 x = acc[ai][bj][m][n];
#else
                            const f32x4 x = acc[ai][bj][m][n] + bv[bj][n];
#endif
#pragma unroll
                            for (int j = 0; j < 4; ++j) {
#ifdef PROBE_PLAIN_GATES
                                v[n][j] = acc[ai][bj][m][n][j];
#elif defined(PROBE_BV_GATES)
                                v[n][j] = bv[bj][n][j] * 16.0f;
#else
                                v[n][j] = fast_sigmoid(x[j]);
#endif
                            } }
                        *(u32x4*)(rp + bj * HALF) = pack8(v[0], v[1]); } }
        }
    }
};
struct EpiPlain {
    static constexpr bool PERM = true, AFTER_DRAIN = false;
    bf16_t* O; int ldc; float scale;
    __device__ __forceinline__ void operator()(const f32x4 (&acc)[2][2][4][2], const Unit& u, int wr, int wc, int fr, int fq) const {
        const int row0 = u.pm * BM + wr * 64 + fr; const int col0 = u.pn * BM + wc * 32 + 8 * fq;
#pragma unroll
        for (int ai = 0; ai < 2; ++ai)
#pragma unroll
            for (int m = 0; m < 4; ++m) { bf16_t* rp = O + (size_t)(row0 + ai * HALF + m * 16) * ldc + col0;
#pragma unroll
                for (int bj = 0; bj < 2; ++bj) *(u32x4*)(rp + bj * HALF) = pack8(acc[ai][bj][m][0] * scale, acc[ai][bj][m][1] * scale); }
    }
};
struct EpiVt {
    static constexpr bool PERM = false, AFTER_DRAIN = false;
    bf16_t* Vt;
    __device__ __forceinline__ void operator()(const f32x4 (&acc)[2][2][4][2], const Unit& u, int wr, int wc, int fr, int fq) const {
        constexpr int T_ = 8208, TP_ = 8320, M_ = 4 * 8208;
        const int feat0 = u.pm * BM + wr * 64 + fr; const int pos = 8 * (fq & 1) + 4 * (fq >> 1);
#pragma unroll
        for (int bj = 0; bj < 2; ++bj)
#pragma unroll
            for (int n = 0; n < 2; ++n) {
                const int tok0 = u.pn * BM + bj * HALF + wc * 32 + n * 16;
                if (tok0 < M_) {
                    const int b = tok0 / T_, t0 = tok0 - b * T_;
                    bf16_t* vp = Vt + ((size_t)b * 512 + feat0) * TP_ + t0 + pos;
#pragma unroll
                    for (int ai = 0; ai < 2; ++ai)
#pragma unroll
                        for (int m = 0; m < 4; ++m) { const f32x4 x = acc[ai][bj][m][n]; u32x2 w; w.x = cvt_pk_bf16(x[0], x[1]); w.y = cvt_pk_bf16(x[2], x[3]);
                            *(u32x2*)(vp + (size_t)(ai * HALF + m * 16) * TP_) = w; }
                }
            }
    }
};
template <bool ACCUM> struct EpiGate {
    static constexpr bool PERM = true, AFTER_DRAIN = false;
    bf16_t* O; const bf16_t* G;
    __device__ __forceinline__ void operator()(const f32x4 (&acc)[2][2][4][2], const Unit& u, int wr, int wc, int fr, int fq) const {
        const int row0 = u.pm * BM + wr * 64 + fr; const int col0 = u.pn * BM + wc * 32 + 8 * fq;
#pragma unroll
        for (int ai = 0; ai < 2; ++ai)
#pragma unroll
            for (int m = 0; m < 4; ++m) { const size_t row = (size_t)(row0 + ai * HALF + m * 16);
#pragma unroll
                for (int bj = 0; bj < 2; ++bj) {
                    const u32x4 g = *(const u32x4*)(G + row * 2048 + col0 + bj * HALF);
                    f32x4 a = acc[ai][bj][m][0], b = acc[ai][bj][m][1];
                    a[0] *= bf_lo(g.x); a[1] *= bf_hi(g.x); a[2] *= bf_lo(g.y); a[3] *= bf_hi(g.y);
                    b[0] *= bf_lo(g.z); b[1] *= bf_hi(g.z); b[2] *= bf_lo(g.w); b[3] *= bf_hi(g.w);
                    bf16_t* op = O + row * 1024 + col0 + bj * HALF;
                    if (ACCUM) { const u32x4 p = *(const u32x4*)op;
                        a[0] += bf_lo(p.x); a[1] += bf_hi(p.x); a[2] += bf_lo(p.y); a[3] += bf_hi(p.y);
                        b[0] += bf_lo(p.z); b[1] += bf_hi(p.z); b[2] += bf_lo(p.w); b[3] += bf_hi(p.w); }
                    *(u32x4*)op = pack8(a, b);
                }
            }
    }
};

template <class Epi, class Sched, bool ALIGN_EPI = false, bool SP2 = false>
__device__ __forceinline__ void gemm_phase(PG8_LAS unsigned char* lds, const Gemm g, const Sched& S, const Epi& E) {
    int tid_ = threadIdx.x; asm volatile("" : "+v"(tid_));
    const int tid = tid_, wid = __builtin_amdgcn_readfirstlane(tid >> 6), lane = tid & 63, wr = wid >> 2, wc = wid & 3, fr = lane & 15, fq = lane >> 4;
    int K_ = g.K; asm volatile("" : "+s"(K_));
    const int K = K_, nt = K / BK;
    unsigned voffA[2], voffB[2];
#pragma unroll
    for (int i = 0; i < 2; ++i) { int R, C; stage_rc(tid * 16 + i * 8192, R, C); const int Rb = Epi::PERM ? ((R & ~31) + perm32(R & 31)) : R;
        voffA[i] = (unsigned)(R * K + C) * 2u; voffB[i] = (unsigned)(Rb * K + C) * 2u; }
    const size_t kstep = (size_t)(BK * 2);
    const size_t hstep = (size_t)HALF * K * 2;
    const size_t tstep = 2 * hstep;
    const unsigned ldsw = (unsigned)wid * 1024u;
    const int aoff = lds_byte(wr * 64 + fr, fq * 8), boff = lds_byte(wc * 32 + fr, fq * 8);
#define PG8_SA(b, h) (((b) * 2 + (h)) * HTB)
#define PG8_SB(b, h) ((4 + (b) * 2 + (h)) * HTB)
#define PG8_STAGE(bufoff, gbase, voff) do { _Pragma("unroll") for (int _i = 0; _i < 2; ++_i) \
        __builtin_amdgcn_global_load_lds((const unsigned*)((const char*)(gbase) + (voff)[_i]), (PG8_LAS unsigned*)(lds + (bufoff) + ldsw + _i * 8192), 16, 0, 0); } while (0)
#define PG8_LDA(dst, b, h) do { _Pragma("unroll") for (int m = 0; m < 4; ++m) _Pragma("unroll") for (int k = 0; k < 2; ++k) dst[m][k] = *(const PG8_LAS bf16x8*)(lds + PG8_SA(b, h) + aoff + m * 2048 + k * 1024); } while (0)
#define PG8_LDB(dst, b, h) do { _Pragma("unroll") for (int n = 0; n < 2; ++n) _Pragma("unroll") for (int k = 0; k < 2; ++k) dst[n][k] = *(const PG8_LAS bf16x8*)(lds + PG8_SB(b, h) + boff + n * 2048 + k * 1024); } while (0)
#define PG8_MMA(ai, bj, At, Bt) do { __builtin_amdgcn_s_setprio(1); _Pragma("unroll") for (int m = 0; m < 4; ++m) _Pragma("unroll") for (int n = 0; n < 2; ++n) _Pragma("unroll") for (int k = 0; k < 2; ++k) \
        acc[ai][bj][m][n] = __builtin_amdgcn_mfma_f32_16x16x32_bf16(Bt[n][k], At[m][k], acc[ai][bj][m][n], 0, 0, 0); __builtin_amdgcn_s_setprio(0); } while (0)
#define PG8_WAIT_V(n) asm volatile("s_waitcnt vmcnt(" #n ")" ::: "memory")
#define PG8_WAIT_L(n) asm volatile("s_waitcnt lgkmcnt(" #n ")" ::: "memory")
#define PG8_BAR __builtin_amdgcn_s_barrier()
#define PG8_SCHED __builtin_amdgcn_sched_barrier(0)
    Unit cur, nxt; int ui = 0;
    if (!S.next(0, cur)) return;
    f32x4 acc[2][2][4][2];
#pragma unroll
    for (int a = 0; a < 2; ++a)
#pragma unroll
        for (int b = 0; b < 2; ++b)
#pragma unroll
            for (int m = 0; m < 4; ++m)
#pragma unroll
                for (int n = 0; n < 2; ++n) acc[a][b][m][n] = (f32x4){0.f, 0.f, 0.f, 0.f};
    bf16x8 At[4][2], B0[2][2], B1[2][2];
    const char* cA = (const char*)g.A + (size_t)cur.pm * tstep; const char* cB = (const char*)g.Bt + (size_t)cur.pn * tstep;
    S.a_ready(cur);
    if constexpr (SP2) {
        PG8_STAGE(PG8_SB(0, 0), cB, voffB); PG8_STAGE(PG8_SB(0, 1), cB + hstep, voffB); PG8_STAGE(PG8_SA(0, 0), cA, voffA); PG8_STAGE(PG8_SA(0, 1), cA + hstep, voffA);
        if (wr == 1) PG8_BAR;
        PG8_WAIT_V(2); PG8_BAR;
        PG8_STAGE(PG8_SB(1, 0), cB + kstep, voffB); PG8_STAGE(PG8_SA(1, 0), cA + kstep, voffA); PG8_STAGE(PG8_SB(1, 1), cB + hstep + kstep, voffB);
        PG8_WAIT_V(6); PG8_BAR;
    } else {
        PG8_STAGE(PG8_SB(0, 0), cB, voffB); PG8_STAGE(PG8_SA(0, 0), cA, voffA); PG8_STAGE(PG8_SB(0, 1), cB + hstep, voffB); PG8_STAGE(PG8_SA(0, 1), cA + hstep, voffA);
        if (wr == 1) PG8_BAR;
        PG8_WAIT_V(4); PG8_BAR;
        PG8_STAGE(PG8_SB(1, 0), cB + kstep, voffB); PG8_STAGE(PG8_SA(1, 0), cA + kstep, voffA); PG8_STAGE(PG8_SB(1, 1), cB + hstep + kstep, voffB);
        PG8_WAIT_V(6); PG8_BAR;
    }
    for (;;) {
        const bool has_next = S.next(ui + 1, nxt);
        const char* nA = has_next ? (const char*)g.A + (size_t)nxt.pm * tstep : cA; const char* nB = has_next ? (const char*)g.Bt + (size_t)nxt.pn * tstep : cB;
        for (int t = 0; t < nt; t += 2) {
            const bool last = (t == nt - 2);
            const char* a1 = cA + (size_t)(t + 1) * kstep;
            const char* a2 = last ? nA : cA + (size_t)(t + 2) * kstep; const char* b2 = last ? nB : cB + (size_t)(t + 2) * kstep;
            const char* a3 = a2 + kstep; const char* b3 = b2 + kstep;
            if (last && has_next) S.a_ready(nxt);
            if constexpr (SP2) {
            PG8_LDB(B0, 0, 0); PG8_LDB(B1, 0, 1); PG8_SCHED; PG8_LDA(At, 0, 0); PG8_STAGE(PG8_SA(1, 1), a1 + hstep, voffA);
            PG8_WAIT_V(8); PG8_WAIT_L(0); PG8_BAR; PG8_MMA(0, 0, At, B0); PG8_MMA(0, 1, At, B1); PG8_BAR; PG8_SCHED;
            PG8_LDA(At, 0, 1); PG8_STAGE(PG8_SB(0, 0), b2, voffB); PG8_STAGE(PG8_SB(0, 1), b2 + hstep, voffB); PG8_STAGE(PG8_SA(0, 0), a2, voffA);
            PG8_WAIT_V(8); PG8_WAIT_L(0); PG8_BAR; PG8_MMA(1, 0, At, B0); PG8_MMA(1, 1, At, B1); PG8_BAR; PG8_SCHED;
            PG8_LDB(B0, 1, 0); PG8_LDB(B1, 1, 1); PG8_SCHED; PG8_LDA(At, 1, 0); PG8_STAGE(PG8_SA(0, 1), a2 + hstep, voffA);
            PG8_WAIT_V(8); PG8_WAIT_L(0); PG8_BAR; PG8_MMA(0, 0, At, B0); PG8_MMA(0, 1, At, B1); PG8_BAR; PG8_SCHED;
            PG8_LDA(At, 1, 1); PG8_STAGE(PG8_SB(1, 0), b3, voffB); PG8_STAGE(PG8_SB(1, 1), b3 + hstep, voffB); PG8_STAGE(PG8_SA(1, 0), a3, voffA);
            PG8_WAIT_V(8); PG8_WAIT_L(0); PG8_BAR; PG8_MMA(1, 0, At, B0); PG8_MMA(1, 1, At, B1); PG8_BAR; PG8_SCHED;
            } else {
            PG8_LDB(B0, 0, 0); PG8_SCHED; PG8_LDA(At, 0, 0); PG8_STAGE(PG8_SA(1, 1), a1 + hstep, voffA);
            PG8_WAIT_L(8); PG8_BAR; PG8_WAIT_L(0); PG8_MMA(0, 0, At, B0); PG8_BAR; PG8_SCHED;
            PG8_LDB(B1, 0, 1); PG8_STAGE(PG8_SB(0, 0), b2, voffB);
            PG8_BAR; PG8_WAIT_L(0); PG8_MMA(0, 1, At, B1); PG8_BAR;
            PG8_LDA(At, 0, 1); PG8_STAGE(PG8_SA(0, 0), a2, voffA);
            PG8_BAR; PG8_WAIT_L(0); PG8_MMA(1, 0, At, B0); PG8_BAR; PG8_SCHED;
            PG8_STAGE(PG8_SB(0, 1), b2 + hstep, voffB);
            PG8_WAIT_V(6); PG8_BAR; PG8_MMA(1, 1, At, B1); PG8_BAR;
            PG8_LDB(B0, 1, 0); PG8_SCHED; PG8_LDA(At, 1, 0); PG8_STAGE(PG8_SA(0, 1), a2 + hstep, voffA);
            PG8_WAIT_L(8); PG8_BAR; PG8_WAIT_L(0); PG8_MMA(0, 0, At, B0); PG8_BAR; PG8_SCHED;
            PG8_LDB(B1, 1, 1); PG8_STAGE(PG8_SB(1, 0), b3, voffB);
            PG8_BAR; PG8_WAIT_L(0); PG8_MMA(0, 1, At, B1); PG8_BAR;
            PG8_LDA(At, 1, 1); PG8_STAGE(PG8_SA(1, 0), a3, voffA);
            PG8_BAR; PG8_WAIT_L(0); PG8_MMA(1, 0, At, B0); PG8_BAR; PG8_SCHED;
            PG8_STAGE(PG8_SB(1, 1), b3 + hstep, voffB);
            PG8_WAIT_V(6); PG8_BAR; PG8_MMA(1, 1, At, B1); PG8_BAR;
            }
        }
        if constexpr (ALIGN_EPI) { if (wr == 0) PG8_BAR; }
        if constexpr (!Epi::AFTER_DRAIN) { E(acc, cur, wr, wc, fr, fq); S.done(cur); }
        if (!has_next) break;
#pragma unroll
        for (int a = 0; a < 2; ++a)
#pragma unroll
            for (int b = 0; b < 2; ++b)
#pragma unroll
                for (int m = 0; m < 4; ++m)
#pragma unroll
                    for (int n = 0; n < 2; ++n) acc[a][b][m][n] = (f32x4){0.f, 0.f, 0.f, 0.f};
        cur = nxt; cA = nA; cB = nB; ++ui;
        if constexpr (ALIGN_EPI) { if (wr == 1) PG8_BAR; }
    }
    PG8_WAIT_V(0);
    if constexpr (!ALIGN_EPI) { if (wr == 0) PG8_BAR; }
    PG8_BAR;
    if constexpr (Epi::AFTER_DRAIN) { E.fused(acc, cur, wr, wc, fr, fq, lds, wid, lane); S.done(cur); }
#undef PG8_SA
#undef PG8_SB
#undef PG8_STAGE
#undef PG8_LDA
#undef PG8_LDB
#undef PG8_MMA
#undef PG8_WAIT_V
#undef PG8_WAIT_L
#undef PG8_BAR
#undef PG8_SCHED
}
}

#include <hip/hip_cooperative_groups.h>
#include <type_traits>
namespace cg = cooperative_groups;

constexpr int D_MODEL = 1024, BATCH = 4, SEQ = 8192, DEPTH = 2, N_META = 16, T = SEQ + N_META  , M = BATCH * T  , MPAD = 33024  , MMAIN = 32768  ;
constexpr int D_CONV = 512, D_FF = 2816, D_IN = 4000, D_INP = 4096, NHEAD = 8, TP = 8320;
constexpr float ALPHA = 1.4142135623730951f;
constexpr float LN_EPS = 1e-5f, RMS_EPS = 1e-6f;
constexpr float QSCALE = 0.10206207261596575f * 1.4426950408889634f;
constexpr int NWAVES = 8;

constexpr size_t OFF_CTL = 0;
constexpr size_t OFF_ROPE = 65536;
constexpr size_t OFF_HF = 2097152;
constexpr size_t SZ_HF = (size_t)MPAD * 1024 * 4;
constexpr size_t OFF_W = OFF_HF + SZ_HF;
constexpr size_t SZ_W = 17825792;
constexpr size_t OFF_S = OFF_W + SZ_W;
constexpr size_t SZ_HB = (size_t)MPAD * 1024 * 2;
constexpr size_t S_HB = OFF_S;
constexpr size_t S_GATES = OFF_S + SZ_HB;
constexpr size_t S_ACT = S_GATES;
constexpr size_t S_BCH = S_GATES + (size_t)MPAD * 2048 * 2;
constexpr size_t S_LAT = S_BCH + (size_t)MPAD * 1536 * 2;
constexpr size_t S_END4 = S_LAT + (size_t)MPAD * 512 * 4;
constexpr size_t S_YCONV = S_HB;
constexpr size_t S_CQN = S_YCONV + (size_t)MPAD * 512 * 2;
constexpr size_t S_CKVN = S_CQN + (size_t)MPAD * 256 * 2;
static_assert(S_CKVN + (size_t)MPAD * 256 * 2 <= S_GATES, "row-prep outputs fit in hb's region");
constexpr size_t S_Q = S_BCH;
constexpr size_t S_KN = S_Q + (size_t)MPAD * 768 * 2;
constexpr size_t S_VT = S_KN + (size_t)MPAD * 512 * 2;
constexpr size_t S_YMLA = S_VT + (size_t)BATCH * NHEAD * 64 * TP * 2;
static_assert(S_YMLA + (size_t)MPAD * 512 * 2 <= S_END4, "attention tensors fit in bch|lat's region");
constexpr size_t S_MERGED = S_Q;
static_assert(S_MERGED + (size_t)MPAD * 1024 * 2 <= S_VT + 0 * S_YMLA && S_ACT + (size_t)MPAD * 2816 * 2 <= S_END4, "overlays");
constexpr size_t S_KR = S_END4;
constexpr size_t WS_NEED = S_KR + (size_t)MPAD * 32 * 2;
static_assert(WS_NEED <= 536870912, "fits the guaranteed workspace");
constexpr size_t W_UP = 0, W_DOWN = (size_t)5632 * 1024 * 2;
constexpr size_t W_IN = 0, W_UQ = (size_t)4096 * 1024 * 2, W_UKV = W_UQ + 768 * 256 * 2, W_BC = W_UKV + 1024 * 256 * 2, W_BM = W_BC + 1024 * 512 * 2, W_O = W_BM + 1024 * 512 * 2;
static_assert(W_O + 1024 * 1024 * 2 <= SZ_W && W_DOWN + (size_t)1024 * 2816 * 2 <= SZ_W, "weight region");
constexpr int RING_BYTES = 131072, LDS_MISC = RING_BYTES, LDS_BYTES = RING_BYTES + 256;

#define LAS __attribute__((address_space(3)))
#define GAS __attribute__((address_space(1)))
typedef unsigned short bf16;
typedef unsigned v4u __attribute__((ext_vector_type(4)));
typedef unsigned v2u __attribute__((ext_vector_type(2)));
typedef float f32x4 __attribute__((ext_vector_type(4)));
typedef float f32x2 __attribute__((ext_vector_type(2)));
typedef float f32x16 __attribute__((ext_vector_type(16)));
typedef short bf16x8 __attribute__((ext_vector_type(8)));
#define LDS_WAIT() asm volatile("s_waitcnt lgkmcnt(0)" ::: "memory")

__device__ __forceinline__ unsigned pk2(float lo, float hi) { return pg8::cvt_pk_bf16(lo, hi); }
__device__ __forceinline__ float wave_sum(float v) {
#pragma unroll
    for (int o = 1; o < 64; o <<= 1) v += __shfl_xor(v, o);
    return v;
}

__device__ __forceinline__ float inv_freq_of(int k) {
    switch (k) { case 0: return 1.000000000e+00f; case 1: return 5.623413324e-01f; case 2: return 3.162277639e-01f; case 3: return 1.778279394e-01f; case 4: return 1.000000015e-01f; case 5: return 5.623412877e-02f;
        case 6: return 3.162277862e-02f; case 7: return 1.778279431e-02f; case 8: return 9.999999776e-03f; case 9: return 5.623413250e-03f; case 10: return 3.162277862e-03f; case 11: return 1.778279431e-03f;
        case 12: return 1.000000047e-03f; case 13: return 5.623413017e-04f; case 14: return 3.162277862e-04f; default: return 1.778279402e-04f; }
}
__device__ __forceinline__ void transpose_item(const float* W, int N, int k0, int scol0, bf16* dst, int ldk, int drow0, LAS float* scr, int lane) {
    if (scol0 >= 0) {
        float wv[32];
#pragma unroll
        for (int i = 0; i < 32; ++i) wv[i] = W[(size_t)(k0 + 2 * i + (lane >> 5)) * N + scol0 + (lane & 31)];
#pragma unroll
        for (int i = 0; i < 32; ++i) scr[(2 * i + (lane >> 5)) * 33 + (lane & 31)] = wv[i];
    } else {
#pragma unroll 8
        for (int i = 0; i < 32; ++i) { const int kk = 2 * i + (lane >> 5); scr[kk * 33 + (lane & 31)] = 0.f; }
    }
    LDS_WAIT(); asm volatile("" ::: "memory");
    const int c = lane & 7;
#pragma unroll
    for (int j = 0; j < 4; ++j) { const int n = (lane >> 3) + 8 * j; const LAS float* s = scr + (8 * c) * 33 + n;
        v4u o; o.x = pk2(s[0 * 33], s[1 * 33]); o.y = pk2(s[2 * 33], s[3 * 33]); o.z = pk2(s[4 * 33], s[5 * 33]); o.w = pk2(s[6 * 33], s[7 * 33]);
        *(v4u*)(dst + (size_t)(drow0 + n) * ldk + k0 + 8 * c) = o; }
    LDS_WAIT(); asm volatile("" ::: "memory");
}
__device__ __forceinline__ void convert_ffn(const float* w_up, const float* w_down, unsigned char* wreg, LAS float* scr, int gw, int ngw, int lane) {
    constexpr int I_UP = 16 * 176, I_DN = 44 * 32;
    for (int it = gw; it < I_UP + I_DN; it += ngw) {
        if (it < I_UP) { const int kb = it / 176, g = it % 176, tile = g >> 3, sub = g & 7;
            const int scol = sub < 4 ? tile * 128 + sub * 32 : D_FF + tile * 128 + (sub - 4) * 32;
            transpose_item(w_up, 2 * D_FF, kb * 64, scol, (bf16*)(wreg + W_UP), 1024, g * 32, scr, lane); }
        else { const int r = it - I_UP, kb = r / 32, g = r % 32; transpose_item(w_down, 1024, kb * 64, g * 32, (bf16*)(wreg + W_DOWN), D_FF, g * 32, scr, lane); }
    }
}
__device__ __forceinline__ void convert_mixer(const float* w_in, const float* w_uq, const float* w_ukv, const float* w_bc, const float* w_bm, const float* w_o, unsigned char* wreg, LAS float* scr, int gw, int ngw, int lane) {
    constexpr int I_IN = 16 * 128, I_UQ = 4 * 24, I_UKV = 4 * 32, I_BR = 8 * 32, I_O = 16 * 32;
    for (int it = gw; it < I_IN + I_UQ + I_UKV + 2 * I_BR + I_O; it += ngw) {
        int r = it;
        if (r < I_IN) { const int kb = r / 128, g = r % 128, n = g * 32; const int scol = n < 1952 ? n : (n < 2048 ? -1 : (n < 3072 ? 1952 + (n - 2048) : 2976 + (n - 3072)));
            transpose_item(w_in, D_IN, kb * 64, scol, (bf16*)(wreg + W_IN), 1024, n, scr, lane); continue; } r -= I_IN;
        if (r < I_UQ) { const int kb = r / 24, g = r % 24; transpose_item(w_uq, 768, kb * 64, g * 32, (bf16*)(wreg + W_UQ), 256, g * 32, scr, lane); continue; } r -= I_UQ;
        if (r < I_UKV) { const int kb = r / 32, g = r % 32, gg = g & 15; const int scol = (gg >> 1) * 128 + (g >> 4) * 64 + (gg & 1) * 32;
            transpose_item(w_ukv, 1024, kb < 2 ? kb * 64 : 0, kb < 2 ? scol : -1, (bf16*)(wreg + W_UKV) + (kb < 2 ? 0 : kb * 64), 256, g * 32, scr, lane); continue; } r -= I_UKV;
        if (r < I_BR) { const int kb = r / 32, g = r % 32; transpose_item(w_bc, 1024, kb * 64, g * 32, (bf16*)(wreg + W_BC), 512, g * 32, scr, lane); continue; } r -= I_BR;
        if (r < I_BR) { const int kb = r / 32, g = r % 32; transpose_item(w_bm, 1024, kb * 64, g * 32, (bf16*)(wreg + W_BM), 512, g * 32, scr, lane); continue; } r -= I_BR;
        { const int kb = r / 32, g = r % 32; transpose_item(w_o, 1024, kb * 64, g * 32, (bf16*)(wreg + W_O), 1024, g * 32, scr, lane); }
    }
}

struct LnRow { f32x4 v[4]; };
__device__ __forceinline__ LnRow ln_load(const float* xin, int lane) { LnRow r; const f32x4* xr = (const f32x4*)xin + lane;
#pragma unroll
    for (int j = 0; j < 4; ++j) r.v[j] = xr[64 * j];
    return r; }
__device__ __forceinline__ void ln_finish(LnRow r, const float* g, const float* bt, float* of32, bf16* ob16, int lane) {
    f32x4 (&v)[4] = r.v; float s = 0.f;
#pragma unroll
    for (int j = 0; j < 4; ++j) s += (v[j].x + v[j].y) + (v[j].z + v[j].w);
    const float mean = wave_sum(s) * (1.f / 1024.f); float s2 = 0.f;
#pragma unroll
    for (int j = 0; j < 4; ++j) { v[j] = v[j] - mean; s2 += (v[j].x * v[j].x + v[j].y * v[j].y) + (v[j].z * v[j].z + v[j].w * v[j].w); }
    const float rstd = 1.f / sqrtf(wave_sum(s2) * (1.f / 1024.f) + LN_EPS);
#pragma unroll
    for (int j = 0; j < 4; ++j) { const f32x4 gg = ((const f32x4*)g)[lane + 64 * j], bb = ((const f32x4*)bt)[lane + 64 * j]; v[j] = v[j] * rstd * gg + bb; }
    if (of32) {
#pragma unroll
        for (int j = 0; j < 4; ++j) ((f32x4*)of32)[lane + 64 * j] = v[j]; }
    if (ob16) {
#pragma unroll
        for (int j = 0; j < 4; ++j) { v2u w; w.x = pk2(v[j].x, v[j].y); w.y = pk2(v[j].z, v[j].w); ((v2u*)ob16)[lane + 64 * j] = w; } }
}
__device__ __forceinline__ void ln_row(const float* xin, const float* g, const float* bt, float* of32, bf16* ob16, int lane) { ln_finish(ln_load(xin, lane), g, bt, of32, ob16, lane); }

struct TailResid { float* H; float alpha, coef;
    __device__ __forceinline__ void operator()(int token, int col, const f32x4 s) const { float* p = H + (size_t)token * 1024 + col; const f32x4 h = *(const f32x4*)p; *(f32x4*)p = h * alpha + s * coef; } };
template <bool ACCUM> struct TailGate { bf16* O; const bf16* G;
    __device__ __forceinline__ void operator()(int token, int col, f32x4 s) const {
        const v2u g = *(const v2u*)(G + (size_t)token * 2048 + col); bf16* op = O + (size_t)token * 1024 + col;
        s[0] *= pg8::bf_lo(g.x); s[1] *= pg8::bf_hi(g.x); s[2] *= pg8::bf_lo(g.y); s[3] *= pg8::bf_hi(g.y);
        if (ACCUM) { const v2u p = *(const v2u*)op; s[0] += pg8::bf_lo(p.x); s[1] += pg8::bf_hi(p.x); s[2] += pg8::bf_lo(p.y); s[3] += pg8::bf_hi(p.y); }
        v2u w; w.x = pk2(s[0], s[1]); w.y = pk2(s[2], s[3]); *(v2u*)op = w; } };
template <int NB, class F> __device__ __forceinline__ void tail_gemm_nb(const bf16* A, const bf16* Bt, int K, int blk, int nstrip, const int (&brow)[NB], LAS unsigned char* lds, const F& epi) {
    if (blk >= nstrip) return;
    int tid_ = threadIdx.x; asm volatile("" : "+v"(tid_));
    const int lane = tid_ & 63, wid = tid_ >> 6, fr = lane & 15, fq = lane >> 4, kw = K >> 3;
    const bf16* ap = A + (size_t)fr * K + wid * kw + fq * 8;
    f32x4 acc[NB][4];
#pragma unroll
    for (int j = 0; j < NB; ++j)
#pragma unroll
        for (int m = 0; m < 4; ++m) acc[j][m] = (f32x4){0.f, 0.f, 0.f, 0.f};
    for (int k = 0; k < kw; k += 32) {
        bf16x8 a[4];
#pragma unroll
        for (int m = 0; m < 4; ++m) a[m] = *(const bf16x8*)(ap + (size_t)m * 16 * K + k);
#pragma unroll
        for (int j = 0; j < NB; ++j) { const bf16x8 b = *(const bf16x8*)(Bt + (size_t)(brow[j] + fr) * K + wid * kw + fq * 8 + k);
#pragma unroll
            for (int m = 0; m < 4; ++m) acc[j][m] = __builtin_amdgcn_mfma_f32_16x16x32_bf16(b, a[m], acc[j][m], 0, 0, 0); }
    }
    LAS f32x4* red = (LAS f32x4*)lds;
#pragma unroll
    for (int j = 0; j < NB; ++j)
#pragma unroll
        for (int m = 0; m < 4; ++m) red[((wid * NB + j) * 4 + m) * 64 + lane] = acc[j][m];
    __syncthreads();
    if (wid < 4) { f32x4 s[NB];
#pragma unroll
        for (int j = 0; j < NB; ++j) { s[j] = red[(j * 4 + wid) * 64 + lane];
#pragma unroll
            for (int w = 1; w < 8; ++w) s[j] = s[j] + red[((w * NB + j) * 4 + wid) * 64 + lane]; }
        epi(wid * 16 + fr, fq * 4, s); }
    __syncthreads();
}
template <class F> struct TailOne { const F& f; int n0; __device__ __forceinline__ void operator()(int token, int c4, const f32x4 (&s)[1]) const { f(token, n0 + c4, s[0]); } };
template <class F> __device__ __forceinline__ void tail_gemm(const bf16* A, const bf16* Bt, int K, int blk, LAS unsigned char* lds, const F& epi) {
    const int brow[1] = {blk * 16}; const TailOne<F> e{epi, blk * 16};
    tail_gemm_nb<1>(A, Bt, K, blk, 64, brow, lds, e);
}
struct TailSwiGLU { bf16* O; int c0;
    __device__ __forceinline__ void operator()(int token, int c4, const f32x4 (&s)[2]) const { f32x4 v;
#pragma unroll
        for (int i = 0; i < 4; ++i) v[i] = s[0][i] * pg8::fast_sigmoid(s[0][i]) * s[1][i];
        v2u w; w.x = pk2(v[0], v[1]); w.y = pk2(v[2], v[3]); *(v2u*)(O + (size_t)token * D_FF + c0 + c4) = w; } };
struct TailInProj { bf16* bch_; float* lat_; bf16* gates_; const float* bgate; int c0;
    __device__ __forceinline__ void operator()(int token, int c4, const f32x4 (&s)[1]) const { const int c = c0 + c4; f32x4 v = s[0];
        if (c < 1536) { v2u w; w.x = pk2(v[0], v[1]); w.y = pk2(v[2], v[3]); *(v2u*)(bch_ + (size_t)token * 1536 + c) = w; }
        else if (c < 2048) { *(f32x4*)(lat_ + (size_t)token * 512 + (c - 1536)) = v; }
        else { const f32x4 bv = *(const f32x4*)(bgate + (c - 2048));
#pragma unroll
            for (int i = 0; i < 4; ++i) v[i] = pg8::fast_sigmoid(v[i] + bv[i]);
            v2u w; w.x = pk2(v[0], v[1]); w.y = pk2(v[2], v[3]); *(v2u*)(gates_ + (size_t)token * 2048 + (c - 2048)) = w; } } };

namespace att {
constexpr int KB = 12288, VB = 8192, OFF_V = 3 * KB, OFF_WS = 3 * KB + 3 * VB, OFF_Q = OFF_WS + 8 * 256;
__device__ __forceinline__ int crow(int r, int hi) { return (r & 3) + 8 * (r >> 2) + 4 * hi; }
__device__ __forceinline__ float max3f(float a, float b, float c) { return __builtin_fmaxf(__builtin_fmaxf(a, b), c); }
__device__ __forceinline__ void attn_unit(int b, int h, int qb, const bf16* Q, const bf16* Kn, const bf16* Kr, const bf16* Vt, const float* rope, bf16* Y, LAS unsigned char* lds) {
    int tid_ = threadIdx.x; asm volatile("" : "+v"(tid_));
    const int tid = tid_, lane = tid & 63, r32 = lane & 31, hi = lane >> 5; const int wid = __builtin_amdgcn_readfirstlane(tid >> 6);
    const int q0 = qb * 256, q0w = q0 + wid * 32;
    const size_t rowbase = (size_t)b * T;
    int NT = (q0 + 256) / 64; if (NT > (T + 63) / 64) NT = (T + 63) / 64;
    int ntw = 0; if (q0w < T) { ntw = (q0w + 31) / 64 + 1; if (ntw > NT) ntw = NT; }
    bf16x8 qr[6];
    { int tq = q0w + r32; if (tq > T - 1) tq = T - 1; const bf16* qp = Q + (rowbase + tq) * 768 + h * 96 + hi * 8;
#pragma unroll
      for (int d0 = 0; d0 < 6; ++d0) qr[d0] = *(const GAS bf16x8*)(qp + d0 * 16);
      const float* rt = rope + (size_t)tq * 32 + 8 * hi; const f32x4 c0 = *(const GAS f32x4*)rt, c1 = *(const GAS f32x4*)(rt + 4), s0 = *(const GAS f32x4*)(rt + 16), s1 = *(const GAS f32x4*)(rt + 20);
      v4u a = __builtin_bit_cast(v4u, qr[4]), bb = __builtin_bit_cast(v4u, qr[5]), oa, ob;
#define ROT2(AW, BW, CA, CB, SA, SB, OA, OB) do { const float x1l = pg8::bf_lo(AW), x1h = pg8::bf_hi(AW), x2l = pg8::bf_lo(BW), x2h = pg8::bf_hi(BW); \
        OA = pk2(x1l * (CA) - x2l * (SA), x1h * (CB) - x2h * (SB)); OB = pk2(x2l * (CA) + x1l * (SA), x2h * (CB) + x1h * (SB)); } while (0)
      ROT2(a.x, bb.x, c0[0], c0[1], s0[0], s0[1], oa.x, ob.x); ROT2(a.y, bb.y, c0[2], c0[3], s0[2], s0[3], oa.y, ob.y);
      ROT2(a.z, bb.z, c1[0], c1[1], s1[0], s1[1], oa.z, ob.z); ROT2(a.w, bb.w, c1[2], c1[3], s1[2], s1[3], oa.w, ob.w);
#undef ROT2
      qr[4] = __builtin_bit_cast(bf16x8, oa); qr[5] = __builtin_bit_cast(bf16x8, ob); }
    const bf16* kn_src = Kn + (rowbase + (tid >> 3)) * 512 + h * 64 + (tid & 7) * 8;
    const bf16* kr_src = Kr + (rowbase + ((tid & 255) >> 2)) * 32 + (tid & 3) * 8;
    const bf16* v_src = Vt + ((size_t)(b * 8 + h) * 64 + (tid >> 3)) * TP + (tid & 7) * 8;
    const int kn_dst = (tid & 7) * 1024 + (((tid >> 3) ^ (tid & 7)) << 4);
    const int kr_dst = (8 + (tid & 3)) * 1024 + ((((tid & 255) >> 2) ^ (tid & 3)) << 4);
    const int v_dst = OFF_V + (tid & 7) * 1024 + (((tid >> 3) ^ (tid & 7)) << 4);
    int kaddr[6], vaddr[4];
#pragma unroll
    for (int d0 = 0; d0 < 6; ++d0) kaddr[d0] = (int)(unsigned)(uintptr_t)lds + (2 * d0 + hi) * 1024 + ((r32 ^ ((2 * d0 + hi) & 7)) << 4);
#pragma unroll
    for (int ks = 0; ks < 4; ++ks) vaddr[ks] = (int)(unsigned)(uintptr_t)lds + OFF_V + (2 * ks + hi) * 1024 + ((r32 ^ (2 * ks + hi)) << 4);
    v4u kA, krA = (v4u){0u, 0u, 0u, 0u}, vA;
#define ATT_LOADK(kt, K_, KR_) do { K_ = *(const GAS v4u*)(kn_src + (size_t)(kt) * 64 * 512); if (wid < 4) KR_ = *(const GAS v4u*)(kr_src + (size_t)(kt) * 64 * 32); } while (0)
#define ATT_LOADV(kt, V_) do { V_ = *(const GAS v4u*)(v_src + (size_t)(kt) * 64); } while (0)
#define ATT_STOREK(slot, K_, KR_) do { *(LAS v4u*)(lds + (slot) * KB + kn_dst) = K_; if (wid < 4) *(LAS v4u*)(lds + (slot) * KB + kr_dst) = KR_; } while (0)
#define ATT_STOREV(slot, V_) do { *(LAS v4u*)(lds + (slot) * VB + v_dst) = V_; } while (0)
    LAS float* wsf = (LAS float*)(lds + OFF_WS + wid * 256);
    const bool skew = wid >= 4;
    bf16x8 pw[4];
    float mrow = 0.f, lsum = 0.f;
    f32x16 o0, o1, negm, p0, p1;
#pragma unroll
    for (int r = 0; r < 16; ++r) { o0[r] = 0.f; o1[r] = 0.f; negm[r] = 0.f; p0[r] = 0.f; p1[r] = 0.f; }
#define ATT_PV(VOFF) do { \
        _Pragma("unroll") for (int ks = 0; ks < 4; ++ks) { \
            const bf16x8 v0 = *(const LAS bf16x8*)(unsigned)(vaddr[ks] + (VOFF)), v1 = *(const LAS bf16x8*)(unsigned)(vaddr[ks] + (VOFF) + 512); \
            o0 = __builtin_amdgcn_mfma_f32_32x32x16_bf16(pw[ks], v0, o0, 0, 0, 0); \
            o1 = __builtin_amdgcn_mfma_f32_32x32x16_bf16(pw[ks], v1, o1, 0, 0, 0); } } while (0)
#define ATT_QK(KOFF) do { \
        _Pragma("unroll") for (int d0 = 0; d0 < 6; ++d0) { \
            const bf16x8 a0 = *(const LAS bf16x8*)(unsigned)(kaddr[d0] + (KOFF)), a1 = *(const LAS bf16x8*)(unsigned)(kaddr[d0] + (KOFF) + 512); \
            p0 = __builtin_amdgcn_mfma_f32_32x32x16_bf16(a0, qr[d0], d0 == 0 ? negm : p0, 0, 0, 0); \
            p1 = __builtin_amdgcn_mfma_f32_32x32x16_bf16(a1, qr[d0], d0 == 0 ? negm : p1, 0, 0, 0); } } while (0)
    auto softmax_tile = [&](const int kt) __attribute__((always_inline)) {
        if (64 * kt + 63 > q0w) {
            const int q = q0w + r32, kbase = 64 * kt + 4 * hi;
#pragma unroll
            for (int r = 0; r < 16; ++r) { const int key = kbase + (r & 3) + 8 * (r >> 2); if (key > q) p0[r] = -1e30f; if (key + 32 > q) p1[r] = -1e30f; }
        }
        float mxa = max3f(p0[0], p0[1], p1[0]), mxb = max3f(p0[2], p0[3], p1[1]); mxa = max3f(mxa, p1[2], p1[3]);
#pragma unroll
        for (int r = 4; r < 16; r += 4) { mxa = max3f(mxa, p0[r], p0[r + 1]); mxb = max3f(mxb, p0[r + 2], p0[r + 3]); mxa = max3f(mxa, p1[r], p1[r + 1]); mxb = max3f(mxb, p1[r + 2], p1[r + 3]); }
        float mx = fmaxf(mxa, mxb);
        mx = fmaxf(mx, __shfl_xor(mx, 32));
        if (kt == 0 || __any(mx > 8.0f)) {
            const float dl = (kt == 0) ? mx : fmaxf(mx, 0.f), alpha = __builtin_amdgcn_exp2f(-dl);
            mrow += dl; lsum *= alpha;
#pragma unroll
            for (int r = 0; r < 16; ++r) { p0[r] -= dl; p1[r] -= dl; negm[r] = -mrow; }
            if (hi == 0) wsf[r32] = alpha;
            LDS_WAIT();
#pragma unroll
            for (int i = 0; i < 4; ++i) { const f32x4 a = *(const LAS f32x4*)(wsf + 8 * i + 4 * hi);
#pragma unroll
                for (int j = 0; j < 4; ++j) { o0[4 * i + j] *= a[j]; o1[4 * i + j] *= a[j]; } }
        }
        float s = 0.f;
#pragma unroll
        for (int r = 0; r < 16; ++r) { p0[r] = __builtin_amdgcn_exp2f(p0[r]); p1[r] = __builtin_amdgcn_exp2f(p1[r]); s += p0[r] + p1[r]; }
        lsum += s;
#pragma unroll
        for (int ks = 0; ks < 4; ++ks) { v4u w;
            if (ks < 2) { w.x = pk2(p0[8 * ks + 0], p0[8 * ks + 1]); w.y = pk2(p0[8 * ks + 2], p0[8 * ks + 3]); w.z = pk2(p0[8 * ks + 4], p0[8 * ks + 5]); w.w = pk2(p0[8 * ks + 6], p0[8 * ks + 7]); }
            else { const int k2 = ks - 2; w.x = pk2(p1[8 * k2 + 0], p1[8 * k2 + 1]); w.y = pk2(p1[8 * k2 + 2], p1[8 * k2 + 3]); w.z = pk2(p1[8 * k2 + 4], p1[8 * k2 + 5]); w.w = pk2(p1[8 * k2 + 6], p1[8 * k2 + 7]); }
            pw[ks] = __builtin_bit_cast(bf16x8, w); }
    };
    ATT_LOADK(0, kA, krA); ATT_LOADV(0, vA); ATT_STOREK(0, kA, krA); ATT_STOREV(0, vA);
    if (NT > 1) { ATT_LOADK(1, kA, krA); ATT_STOREK(1, kA, krA); }
    __syncthreads();
    if (!skew && 0 < ntw) ATT_QK(0);
    int s0 = 0, s1 = 1, s2 = 2;
#define ATT_STEP(COMPUTE) do { \
        if (kt + 2 < NT) ATT_LOADK(kt + 2, kA, krA); if (kt + 1 < NT) ATT_LOADV(kt + 1, vA); \
        COMPUTE; \
        if (kt + 2 < NT) ATT_STOREK(s2, kA, krA); if (kt + 1 < NT) ATT_STOREV(s1, vA); \
        { const int t_ = s0; s0 = s1; s1 = s2; s2 = t_; } \
        asm volatile("s_waitcnt lgkmcnt(0)\n\ts_barrier" ::: "memory");   \
    } while (0)
    if (!skew) {
        for (int kt = 0; kt < NT; ++kt) ATT_STEP({ if (kt < ntw) { softmax_tile(kt); ATT_PV(s0 * VB); } if (kt + 1 < ntw) ATT_QK(s1 * KB); });
    } else {
        for (int kt = 0; kt < NT; ++kt) ATT_STEP({ if (kt >= 1 && kt - 1 < ntw) ATT_PV(s2 * VB); if (kt < ntw) { ATT_QK(s0 * KB); softmax_tile(kt); } });
    }
#undef ATT_STEP
    if (skew && NT - 1 < ntw) ATT_PV(((NT - 1) % 3) * VB);
#undef ATT_PV
#undef ATT_QK
    if (ntw > 0) {
        lsum += __shfl_xor(lsum, 32);
        if (hi == 0) wsf[32 + r32] = 1.0f / lsum;
        LDS_WAIT();
        bf16* yp = Y + (rowbase + q0w) * 512 + h * 64 + r32;
#pragma unroll
        for (int i = 0; i < 4; ++i) { const f32x4 a = *(const LAS f32x4*)(wsf + 32 + 8 * i + 4 * hi);
#pragma unroll
            for (int j = 0; j < 4; ++j) { const int r = 4 * i + j, q = crow(r, hi);
                if (q0w + q < T) { const unsigned w = pk2(o0[r] * a[j], o1[r] * a[j]); ((GAS bf16*)yp)[(size_t)q * 512] = (bf16)(w & 0xffffu); ((GAS bf16*)yp)[(size_t)q * 512 + 32] = (bf16)(w >> 16); } } }
        LDS_WAIT();
    }
#undef ATT_LOADK
#undef ATT_LOADV
#undef ATT_STOREK
#undef ATT_STOREV
}
}

#ifdef PROBE_SYS_SCOPE
#define XB_SCOPE ""
#else
#define XB_SCOPE "agent"
#endif
#define XB_TMO      128
#define XB_XCNT(j)  (256  + 64 * (j))
#define XB_XSUB(j)  (1280 + 64 * (j))
#define XB_XGEN(j)  (2304 + 64 * (j))
#define XB_TOP      3328
#define XB_TOPGEN   3392
#define XCD_BAR_WORDS 3456
#define XB_SPIN_CAP (1u << 18)

__device__ __forceinline__ unsigned xb_ld(unsigned* p)              { return __hip_atomic_load(p, __ATOMIC_RELAXED, __HIP_MEMORY_SCOPE_AGENT); }
__device__ __forceinline__ unsigned xb_add(unsigned* p, unsigned v) { return __hip_atomic_fetch_add(p, v, __ATOMIC_RELAXED, __HIP_MEMORY_SCOPE_AGENT); }
__device__ __forceinline__ unsigned xb_xcc_id() { return (unsigned)__builtin_amdgcn_s_getreg((3 << 11) | 20) & 0xFu; }
#define XB_SPIN(cond, bar) do { unsigned _sp = 0; while (cond) { __builtin_amdgcn_s_sleep(1); \
    if ((++_sp & 255u) == 0u) { if (xb_ld(&(bar)[XB_TMO])) break; if (_sp > XB_SPIN_CAP) { atomicAdd(&(bar)[XB_TMO], 1u); break; } } } } while (0)

struct XcdBarrier {
    unsigned* bar; unsigned x;
    volatile LAS unsigned* st;
};

__device__ __forceinline__ XcdBarrier xcd_barrier_post(unsigned* bar, volatile LAS unsigned* st) {
    XcdBarrier b; b.bar = bar; b.x = xb_xcc_id(); b.st = st;
    if (threadIdx.x == 0) (void)xb_add(&bar[XB_XCNT(b.x)], 1u);
    return b;
}
__device__ __forceinline__ void xcd_barrier_complete(unsigned* bar, unsigned x, unsigned& nloc, unsigned& nx) {
    const unsigned G = gridDim.x * gridDim.y * gridDim.z;
    unsigned sum, cnt, mine, sp = 0u;
    for (;;) {
        sum = 0u; cnt = 0u; mine = 0u;
#pragma unroll
        for (unsigned j = 0; j < 16; ++j) { const unsigned c = xb_ld(&bar[XB_XCNT(j)]); sum += c; cnt += (c > 0u) ? 1u : 0u; mine = (j == x) ? c : mine; }
        if (sum == G) break;
        __builtin_amdgcn_s_sleep(1);
        if ((++sp & 255u) == 0u) { if (xb_ld(&bar[XB_TMO])) break; if (sp > XB_SPIN_CAP) { atomicAdd(&bar[XB_TMO], 1u); break; } }
    }
    nloc = mine > 0u ? mine : 1u; nx = cnt > 0u ? cnt : 1u;
}

__device__ __forceinline__ void xcd_barrier(const XcdBarrier& b) {
    asm volatile("s_waitcnt vmcnt(0)" ::: "memory");
    __syncthreads();
    if (threadIdx.x == 0) {
        unsigned* bar = b.bar;
        __builtin_amdgcn_s_waitcnt(0);
        unsigned nloc = b.st[0], nx = b.st[1];
        if (nloc == 0u) { xcd_barrier_complete(bar, b.x, nloc, nx); b.st[0] = nloc; b.st[1] = nx; }
        const unsigned old = xb_add(&bar[XB_XSUB(b.x)], 1u);
        const unsigned gen = old / nloc;
        if (old + 1u == (gen + 1u) * nloc) {
            __builtin_amdgcn_fence(__ATOMIC_RELEASE, XB_SCOPE);
            asm volatile("s_waitcnt vmcnt(0)" ::: "memory");
            const unsigned og = xb_add(&bar[XB_TOP], 1u);
            const unsigned tg = og / nx;
            if (og + 1u == (tg + 1u) * nx) xb_add(&bar[XB_TOPGEN], 1u);
            else XB_SPIN(xb_ld(&bar[XB_TOPGEN]) == tg, bar);
            __builtin_amdgcn_fence(__ATOMIC_ACQUIRE, XB_SCOPE);
            xb_add(&bar[XB_XGEN(b.x)], 1u);
            asm volatile("s_waitcnt vmcnt(0)" ::: "memory");
        } else {
            XB_SPIN(xb_ld(&bar[XB_XGEN(b.x)]) == gen, bar);
            __builtin_amdgcn_fence(__ATOMIC_ACQUIRE, XB_SCOPE);
            asm volatile("s_waitcnt vmcnt(0)" ::: "memory");
        }
    }
    __syncthreads();
}

struct Args { const float* in[18]; float* out; unsigned char* ws; };
static_assert(sizeof(Args) == 160, "Args layout");

__global__ void __launch_bounds__(NWAVES * 64, 2) mega_fwd(Args args) {
    extern __shared__ __attribute__((aligned(16))) unsigned char lds_raw[];
    cg::grid_group grid = cg::this_grid();
    LAS unsigned char* lds = (LAS unsigned char*)lds_raw;
    int tid = threadIdx.x, lane = tid & 63; const int wave = __builtin_amdgcn_readfirstlane(tid >> 6);
#define GRID_SYNC() do { XcdBarrier xb_; xb_.bar = ctl + 4096; xb_.x = xb_xcc_id(); xb_.st = (volatile LAS unsigned*)(lds + LDS_MISC) + 8; xcd_barrier(xb_); REBASE(); } while (0)
#define OPQ() do { asm volatile("" : "+v"(tid)); lane = tid & 63; } while (0)
    const int G = gridDim.x, blk = blockIdx.x;
    const int gw = blk * NWAVES + wave, ngw = G * NWAVES;
    const unsigned char* ka = (const unsigned char*)__builtin_amdgcn_kernarg_segment_ptr();
    GAS unsigned char* ws = (GAS unsigned char*)args.ws;
#define REBASE() do { asm volatile("" : "+s"(ka)); asm volatile("" : "+s"(ws)); } while (0)
#define INP(i) ((const float*)(const GAS float*)(*(const float* const*)(ka + 8 * (i))))
#define X_IN INP(0)
#define meta INP(1)
#define ffn1_up INP(2)
#define ffn1_down INP(3)
#define w_in INP(4)
#define b_gate INP(5)
#define conv_w INP(6)
#define q_norm_g INP(7)
#define w_uq INP(8)
#define kv_norm_g INP(9)
#define w_ukv INP(10)
#define w_br_conv INP(11)
#define w_br_mla INP(12)
#define w_o INP(13)
#define ffn2_up INP(14)
#define ffn2_down INP(15)
#define ln_g INP(16)
#define ln_b INP(17)
#define OUTP ((float*)(GAS float*)(*(float* const*)(ka + 144)))
#define ctl ((unsigned*)(ws + OFF_CTL))
#define rope ((float*)(ws + OFF_ROPE))
#define hf ((float*)(ws + OFF_HF))
#define wreg ((unsigned char*)(ws + OFF_W))
#define hb ((bf16*)(ws + S_HB))
#define act ((bf16*)(ws + S_ACT))
#define gates ((bf16*)(ws + S_GATES))
#define bch ((bf16*)(ws + S_BCH))
#define lat ((float*)(ws + S_LAT))
#define yconv ((bf16*)(ws + S_YCONV))
#define cqn ((bf16*)(ws + S_CQN))
#define ckvn ((bf16*)(ws + S_CKVN))
#define krb ((bf16*)(ws + S_KR))
#define Qb ((bf16*)(ws + S_Q))
#define Knb ((bf16*)(ws + S_KN))
#define Vtb ((bf16*)(ws + S_VT))
#define ymla ((bf16*)(ws + S_YMLA))
#define merged ((bf16*)(ws + S_MERGED))
    LAS float* scr = (LAS float*)(lds + wave * 16384);
    LAS unsigned char* ring = lds;
    if (threadIdx.x < 64) ((LAS unsigned*)(lds + LDS_MISC))[threadIdx.x] = 0u;
    __syncthreads();
    (void)xcd_barrier_post(ctl + 4096, (volatile LAS unsigned*)(lds + LDS_MISC) + 8);
    grid.sync();

#ifdef PROBE_DUMP_BIAS
    OPQ();
    for (int row = gw; row < BATCH * SEQ; row += ngw) { float* o = OUTP + (size_t)row * 1024; for (int c = lane; c < 1024; c += 64) o[c] = b_gate[c] + 2.0f * b_gate[1024 + c] + 4.0f * b_gate[2048 + c] + 8.0f * b_gate[3072 + c]; }
    return;
#endif
    OPQ();
    { auto p0_load = [&](int row) __attribute__((always_inline)) { LnRow rr;
          if (row < M) { const int b = row / T, t = row - b * T; rr = ln_load(t < N_META ? meta + (size_t)t * 1024 : X_IN + ((size_t)b * SEQ + (t - N_META)) * 1024, lane); }
          else {
#pragma unroll
              for (int j = 0; j < 4; ++j) rr.v[j] = (f32x4){0.f, 0.f, 0.f, 0.f}; }
          return rr; };
      LnRow cur = p0_load(gw);
      for (int row = gw; row < MPAD; row += ngw) { const LnRow nxt = p0_load(row + ngw < MPAD ? row + ngw : row);
#pragma unroll
          for (int j = 0; j < 4; ++j) { const f32x4 v = cur.v[j]; ((f32x4*)(hf + (size_t)row * 1024))[lane + 64 * j] = v; v2u w; w.x = pk2(v.x, v.y); w.y = pk2(v.z, v.w); ((v2u*)(hb + (size_t)row * 1024))[lane + 64 * j] = w; }
          cur = nxt; } }
    for (int i = blk * 512 + tid; i < T * 16; i += G * 512) { const int t = i >> 4, k = i & 15;
        const float inv_freq = inv_freq_of(k); const float ang = (float)t * inv_freq;
        const double rev = (double)ang * 0.15915494309189535; const float fr = (float)(rev - floor(rev));
        rope[t * 32 + k] = __builtin_amdgcn_cosf(fr); rope[t * 32 + 16 + k] = __builtin_amdgcn_sinf(fr); }
    convert_ffn(ffn1_up, ffn1_down, wreg, scr, gw, ngw, lane);
    GRID_SYNC();

    for (int step = 0; step < 3 * DEPTH; ++step) {
        const int l = step / 3, sub = step % 3;
#ifdef PROBE_STEPS
        if (step == PROBE_STEPS) {
            OPQ();
            for (int row = gw; row < M; row += ngw) { const int b = row / T, t = row - b * T; if (t >= N_META) {
#pragma unroll
                for (int j = 0; j < 4; ++j) ((f32x4*)(OUTP + ((size_t)b * SEQ + (t - N_META)) * 1024))[lane + 64 * j] = ((const f32x4*)(hf + (size_t)row * 1024))[lane + 64 * j]; } }
            return;
        }
#endif
        if (sub != 1) {
            { const int c0 = blk * 16, tl = c0 >> 7, j0 = c0 & 127; const int brow[2] = {256 * tl + j0, 256 * tl + 128 + j0};
              tail_gemm_nb<2>(hb + (size_t)MMAIN * 1024, (const bf16*)(wreg + W_UP), 1024, blk, D_FF / 16, brow, lds, TailSwiGLU{act + (size_t)MMAIN * D_FF, c0}); }
            { pg8::Gemm g{hb, (const bf16*)(wreg + W_UP), MMAIN, 2 * D_FF, 1024}; pg8::StaticOrder S; S.init(MMAIN, 2 * D_FF, G, blk);
              pg8::EpiSwiGLU E{act, D_FF};
              pg8::gemm_phase<pg8::EpiSwiGLU, pg8::StaticOrder, true, true>(ring, g, S, E); }
            GRID_SYNC();
            tail_gemm(act + (size_t)MMAIN * D_FF, (const bf16*)(wreg + W_DOWN), D_FF, blk, lds, TailResid{hf + (size_t)MMAIN * 1024, ALPHA, 0.5f});
            { pg8::Gemm g{act, (const bf16*)(wreg + W_DOWN), MMAIN, 1024, D_FF}; pg8::StaticOrder S; S.init(MMAIN, 1024, G, blk);
              pg8::EpiResid E{hf, ALPHA, 0.5f};
              pg8::gemm_phase<pg8::EpiResid, pg8::StaticOrder, true, true>(ring, g, S, E); }
            GRID_SYNC();
            OPQ();
            const int li = (sub == 0) ? 0 : 2; const float* lg = ln_g + ((size_t)l * 3 + li) * 1024; const float* lb = ln_b + ((size_t)l * 3 + li) * 1024;
            const bool final_ln = (step == 3 * DEPTH - 1);
            if (!final_ln) {
                LnRow cur = ln_load(hf + (size_t)gw * 1024, lane);
                for (int row = gw; row < MPAD; row += ngw) { const int nx = row + ngw < MPAD ? row + ngw : row; const LnRow nxt = ln_load(hf + (size_t)nx * 1024, lane);
                    ln_finish(cur, lg, lb, hf + (size_t)row * 1024, hb + (size_t)row * 1024, lane); cur = nxt; }
            } else {
                LnRow cur = ln_load(hf + (size_t)gw * 1024, lane);
                for (int row = gw; row < M; row += ngw) { const int nx = row + ngw < M ? row + ngw : row; const LnRow nxt = ln_load(hf + (size_t)nx * 1024, lane);
                    const int b = row / T, t = row - b * T; if (t >= N_META) ln_finish(cur, lg, lb, OUTP + ((size_t)b * SEQ + (t - N_META)) * 1024, nullptr, lane); cur = nxt; }
            }
            if (sub == 0) convert_mixer(w_in + (size_t)l * 1024 * D_IN, w_uq + (size_t)l * 256 * 768, w_ukv + (size_t)l * 128 * 1024, w_br_conv + (size_t)l * 512 * 1024, w_br_mla + (size_t)l * 512 * 1024, w_o + (size_t)l * 1024 * 1024, wreg, scr, gw, ngw, lane);
            else if (!final_ln) convert_ffn(ffn1_up + (size_t)(l + 1) * 1024 * 2 * D_FF, ffn1_down + (size_t)(l + 1) * D_FF * 1024, wreg, scr, gw, ngw, lane);
            if (!final_ln) GRID_SYNC();
        } else {
#ifdef PROBE_DUMP_BIAS1
            OPQ();
            for (int row = gw; row < BATCH * SEQ; row += ngw) { float* o = OUTP + (size_t)row * 1024; for (int c = lane; c < 1024; c += 64) o[c] = b_gate[c] + 2.0f * b_gate[1024 + c] + 4.0f * b_gate[2048 + c] + 8.0f * b_gate[3072 + c]; }
            return;
#endif
            { const int brow[1] = {blk * 16};
              tail_gemm_nb<1>(hb + (size_t)MMAIN * 1024, (const bf16*)(wreg + W_IN), 1024, blk, D_INP / 16, brow, lds,
                              TailInProj{bch + (size_t)MMAIN * 1536, lat + (size_t)MMAIN * 512, gates + (size_t)MMAIN * 2048, b_gate + (size_t)l * 2048, blk * 16}); }
            { pg8::Gemm g{hb, (const bf16*)(wreg + W_IN), MMAIN, D_INP, 1024}; pg8::StaticOrder S; S.init(MMAIN, D_INP, G, blk);
              pg8::EpiInProj E{bch, lat, gates, b_gate + (size_t)l * 2048};
              pg8::gemm_phase<pg8::EpiInProj, pg8::StaticOrder, true, true>(ring, g, S, E); }
            GRID_SYNC();
#ifdef PROBE_DUMP_GATES0
            OPQ();
            for (int row = gw; row < M; row += ngw) { const int b = row / T, t = row - b * T; if (t >= N_META) { float* o = OUTP + ((size_t)b * SEQ + (t - N_META)) * 1024;
                for (int c = lane; c < 1024; c += 64) o[c] = pg8::bf_lo(gates[(size_t)row * 2048 + c]) + 2.0f * pg8::bf_lo(gates[(size_t)row * 2048 + 1024 + c]); } }
            return;
#endif
            OPQ();
            { const float* cw = conv_w + (size_t)l * 3 * 512; const float* qg = q_norm_g + (size_t)l * 256; const float* kg = kv_norm_g + (size_t)l * 128;
              struct RpRow { v4u c[3], h[3], bb; f32x4 q; f32x2 kv; float x1, x2; };
              auto rp_load = [&](int row) __attribute__((always_inline)) { RpRow d; const int rr = row < M ? row : M - 1; const int b = rr / T, t = rr - b * T;
#pragma unroll
                  for (int k = 0; k < 3; ++k) { const int dt = 2 - k;
                      if (t - dt >= 0 && row < M) { const bf16* rp = bch + (size_t)(row - dt) * 1536 + 8 * lane; d.c[k] = *(const v4u*)(rp + 512); d.h[k] = *(const v4u*)(rp + 1024); }
                      else { d.c[k] = (v4u){0u, 0u, 0u, 0u}; d.h[k] = (v4u){0u, 0u, 0u, 0u}; } }
                  d.bb = *(const v4u*)(bch + (size_t)row * 1536 + 8 * lane);
                  const float* lr = lat + (size_t)row * 512;
                  d.q = *(const f32x4*)(lr + 4 * lane); d.kv = *(const f32x2*)(lr + 256 + 2 * lane); d.x1 = lr[384 + (lane & 15)]; d.x2 = lr[400 + (lane & 15)];
                  return d; };
              RpRow cur = rp_load(gw);
              for (int row = gw; row < MPAD; row += ngw) {
                const RpRow nxt = rp_load(row + ngw < MPAD ? row + ngw : row);
                const int rr = row < M ? row : M - 1; const int t = rr % T;
                f32x4 ua[2] = {(f32x4){0.f, 0.f, 0.f, 0.f}, (f32x4){0.f, 0.f, 0.f, 0.f}};
#pragma unroll
                for (int k = 0; k < 3; ++k) { const v4u c = cur.c[k], hh = cur.h[k];
                        const f32x4 w0 = *(const f32x4*)(cw + k * 512 + 8 * lane), w1 = *(const f32x4*)(cw + k * 512 + 8 * lane + 4);
                        ua[0][0] += w0[0] * pg8::bf_lo(c.x) * pg8::bf_lo(hh.x); ua[0][1] += w0[1] * pg8::bf_hi(c.x) * pg8::bf_hi(hh.x);
                        ua[0][2] += w0[2] * pg8::bf_lo(c.y) * pg8::bf_lo(hh.y); ua[0][3] += w0[3] * pg8::bf_hi(c.y) * pg8::bf_hi(hh.y);
                        ua[1][0] += w1[0] * pg8::bf_lo(c.z) * pg8::bf_lo(hh.z); ua[1][1] += w1[1] * pg8::bf_hi(c.z) * pg8::bf_hi(hh.z);
                        ua[1][2] += w1[2] * pg8::bf_lo(c.w) * pg8::bf_lo(hh.w); ua[1][3] += w1[3] * pg8::bf_hi(c.w) * pg8::bf_hi(hh.w); }
                { const v4u bb = cur.bb;
                  v4u o; o.x = pk2(ua[0][0] * pg8::bf_lo(bb.x), ua[0][1] * pg8::bf_hi(bb.x)); o.y = pk2(ua[0][2] * pg8::bf_lo(bb.y), ua[0][3] * pg8::bf_hi(bb.y));
                  o.z = pk2(ua[1][0] * pg8::bf_lo(bb.z), ua[1][1] * pg8::bf_hi(bb.z)); o.w = pk2(ua[1][2] * pg8::bf_lo(bb.w), ua[1][3] * pg8::bf_hi(bb.w));
                  *(v4u*)(yconv + (size_t)row * 512 + 8 * lane) = o; }
                { const f32x4 v = cur.q; const float ss = wave_sum((v.x * v.x + v.y * v.y) + (v.z * v.z + v.w * v.w));
                  const float rs = 1.f / sqrtf(ss * (1.f / 256.f) + RMS_EPS); const f32x4 gg = *(const f32x4*)(qg + 4 * lane);
                  v2u w; w.x = pk2(v.x * rs * gg.x, v.y * rs * gg.y); w.y = pk2(v.z * rs * gg.z, v.w * rs * gg.w); *(v2u*)(cqn + (size_t)row * 256 + 4 * lane) = w; }
                { const f32x2 v = cur.kv; const float ss = wave_sum(v.x * v.x + v.y * v.y);
                  const float rs = 1.f / sqrtf(ss * (1.f / 128.f) + RMS_EPS); const f32x2 gg = *(const f32x2*)(kg + 2 * lane);
                  *(unsigned*)(ckvn + (size_t)row * 256 + 2 * lane) = pk2(v.x * rs * gg.x, v.y * rs * gg.y); *(unsigned*)(ckvn + (size_t)row * 256 + 128 + 2 * lane) = 0u; }
                if (lane < 16) { const float x1 = cur.x1, x2 = cur.x2, cs = rope[t * 32 + lane], sn = rope[t * 32 + 16 + lane];
                  const unsigned w = pk2(x1 * cs - x2 * sn, x2 * cs + x1 * sn); krb[(size_t)row * 32 + lane] = (bf16)(w & 0xffffu); krb[(size_t)row * 32 + 16 + lane] = (bf16)(w >> 16); }
                cur = nxt;
              } }
            GRID_SYNC();
#ifdef PROBE_DUMP_GATES
            OPQ();
            for (int row = gw; row < M; row += ngw) { const int b = row / T, t = row - b * T; if (t >= N_META) { float* o = OUTP + ((size_t)b * SEQ + (t - N_META)) * 1024;
                for (int c = lane; c < 1024; c += 64) o[c] = pg8::bf_lo(gates[(size_t)row * 2048 + c]) + 2.0f * pg8::bf_lo(gates[(size_t)row * 2048 + 1024 + c]); } }
            return;
#endif
#ifdef PROBE_DUMP_ROWPREP
            OPQ();
            for (int row = gw; row < M; row += ngw) { const int b = row / T, t = row - b * T; if (t >= N_META) { float* o = OUTP + ((size_t)b * SEQ + (t - N_META)) * 1024;
                for (int c = lane; c < 1024; c += 64) { float v = 0.f;
                    if (c < 512) v = pg8::bf_lo(yconv[(size_t)row * 512 + c]); else if (c < 768) v = pg8::bf_lo(cqn[(size_t)row * 256 + c - 512]); else if (c < 896) v = pg8::bf_lo(ckvn[(size_t)row * 256 + c - 768]); else if (c < 928) v = pg8::bf_lo(krb[(size_t)row * 32 + c - 896]);
                    else if (c < 960) v = lat[(size_t)row * 512 + 384 + c - 928];
                    o[c] = v; } } }
            return;
#endif
            OPQ();
            for (int i = blk * 512 + tid; i < BATCH * NHEAD * 64 * (TP - T); i += G * 512) { const int r = i / (TP - T), c = i % (TP - T); Vtb[(size_t)r * TP + T + c] = 0; }
            { pg8::Gemm g{cqn, (const bf16*)(wreg + W_UQ), MPAD, 768, 256}; pg8::StaticOrder S; S.init(MPAD, 768, G, blk);
              pg8::EpiPlain E{Qb, 768, QSCALE};
              pg8::gemm_phase<pg8::EpiPlain, pg8::StaticOrder, true, true>(ring, g, S, E); }
            { pg8::Gemm g{ckvn, (const bf16*)(wreg + W_UKV), MPAD, 512, 256}; pg8::StaticOrder S; S.init(MPAD, 512, G, blk);
              pg8::EpiPlain E{Knb, 512, 1.0f};
              pg8::gemm_phase<pg8::EpiPlain, pg8::StaticOrder, true, true>(ring, g, S, E); }
            { pg8::Gemm g{(const bf16*)(wreg + W_UKV) + 512 * 256, ckvn, 512, MPAD, 256}; pg8::StaticOrder S; S.init(512, MPAD, G, blk);
              pg8::EpiVt E{Vtb};
              pg8::gemm_phase<pg8::EpiVt, pg8::StaticOrder, true, true>(ring, g, S, E); }
            GRID_SYNC();
            OPQ();
#ifdef PROBE_NOATTN
            for (size_t i = (size_t)blk * 512 + tid; i < (size_t)MPAD * 512 / 8; i += (size_t)G * 512) ((v4u*)ymla)[i] = (v4u){0u, 0u, 0u, 0u};
            if (false)
#endif
#ifdef PROBE_ATTN_TWICE
            for (int rep = 0; rep < 2; ++rep)
            { const int grp = blk & 7; unsigned* qctr = ctl + 64 * (rep * 16 + l * 8 + grp);
#else
            { const int grp = blk & 7; unsigned* qctr = ctl + 64 * (l * 8 + grp);
#endif
              volatile LAS unsigned* bc = (volatile LAS unsigned*)(lds + LDS_MISC);
              for (;;) {
                  if (tid == 0) bc[0] = atomicAdd(qctr, 1u);
                  __syncthreads();
                  const unsigned u = bc[0];
                  __syncthreads();
                  if (u >= 132u) break;
                  const int qb = 32 - (int)(u >> 2), bh = grp * 4 + (int)(u & 3u);
                  att::attn_unit(bh >> 3, bh & 7, qb, Qb, Knb, krb, Vtb, rope, ymla, lds);
              } }
            GRID_SYNC();
            tail_gemm(yconv + (size_t)MMAIN * 512, (const bf16*)(wreg + W_BC), 512, blk, lds, TailGate<false>{merged + (size_t)MMAIN * 1024, gates + (size_t)MMAIN * 2048});
            tail_gemm(ymla + (size_t)MMAIN * 512, (const bf16*)(wreg + W_BM), 512, blk, lds, TailGate<true>{merged + (size_t)MMAIN * 1024, gates + (size_t)MMAIN * 2048 + 1024});
            { pg8::Gemm g{yconv, (const bf16*)(wreg + W_BC), MMAIN, 1024, 512}; pg8::StaticOrder S; S.init(MMAIN, 1024, G, blk);
              pg8::EpiGate<false> E{merged, gates};
              pg8::gemm_phase<pg8::EpiGate<false>, pg8::StaticOrder, true, true>(ring, g, S, E); }
#ifdef PROBE_SYNC_BETWEEN
            GRID_SYNC();
#endif
#ifndef PROBE_SKIP_BR2
            { pg8::Gemm g{ymla, (const bf16*)(wreg + W_BM), MMAIN, 1024, 512}; pg8::StaticOrder S; S.init(MMAIN, 1024, G, blk);
              pg8::EpiGate<true> E{merged, gates + 1024};
              pg8::gemm_phase<pg8::EpiGate<true>, pg8::StaticOrder, true, true>(ring, g, S, E); }
#endif
            GRID_SYNC();
#ifdef PROBE_DUMP_MERGED
            OPQ();
            for (int row = gw; row < M; row += ngw) { const int b = row / T, t = row - b * T; if (t >= N_META) { float* o = OUTP + ((size_t)b * SEQ + (t - N_META)) * 1024;
                for (int c = lane; c < 1024; c += 64) o[c] = pg8::bf_lo(merged[(size_t)row * 1024 + c]); } }
            return;
#endif
            tail_gemm(merged + (size_t)MMAIN * 1024, (const bf16*)(wreg + W_O), 1024, blk, lds, TailResid{hf + (size_t)MMAIN * 1024, ALPHA, 1.0f});
            { pg8::Gemm g{merged, (const bf16*)(wreg + W_O), MMAIN, 1024, 1024}; pg8::StaticOrder S; S.init(MMAIN, 1024, G, blk);
              pg8::EpiResid E{hf, ALPHA, 1.0f};
              pg8::gemm_phase<pg8::EpiResid, pg8::StaticOrder, true, true>(ring, g, S, E); }
            GRID_SYNC();
            OPQ();
            { const float* lg = ln_g + ((size_t)l * 3 + 1) * 1024; const float* lb = ln_b + ((size_t)l * 3 + 1) * 1024;
              LnRow cur = ln_load(hf + (size_t)gw * 1024, lane);
              for (int row = gw; row < MPAD; row += ngw) { const int nx = row + ngw < MPAD ? row + ngw : row; const LnRow nxt = ln_load(hf + (size_t)nx * 1024, lane);
                  ln_finish(cur, lg, lb, hf + (size_t)row * 1024, hb + (size_t)row * 1024, lane); cur = nxt; }
              convert_ffn(ffn2_up + (size_t)l * 1024 * 2 * D_FF, ffn2_down + (size_t)l * D_FF * 1024, wreg, scr, gw, ngw, lane); }
            GRID_SYNC();
        }
    }
}

extern "C" void kernel_launch(void* const* d_in, const int* in_sizes, int n_in, void* d_out, int out_size, void* d_ws, size_t ws_size, hipStream_t stream) {
    static int grid = 0;
    if (grid == 0) {
        if (n_in != 18 || ws_size < WS_NEED) { fprintf(stderr, "kernel_launch: expected 18 inputs and >= %zu bytes of workspace; got %d, %zu\n", (size_t)WS_NEED, n_in, ws_size); grid = -1; return; }
        int dev = 0, cus = 0, per_cu = 0;
        hipGetDevice(&dev); hipDeviceGetAttribute(&cus, hipDeviceAttributeMultiprocessorCount, dev);
        if (hipFuncSetAttribute((const void*)mega_fwd, hipFuncAttributeMaxDynamicSharedMemorySize, LDS_BYTES) != hipSuccess) { fprintf(stderr, "kernel_launch: hipFuncSetAttribute failed\n"); grid = -1; return; }
        hipOccupancyMaxActiveBlocksPerMultiprocessor(&per_cu, (const void*)mega_fwd, NWAVES * 64, LDS_BYTES);
        (void)hipGetLastError();
        if (per_cu < 1) per_cu = 1;
        grid = cus;
    }
    if (grid < 0) return;
    (void)hipMemsetAsync((char*)d_ws + OFF_CTL, 0, 65536, stream);
    Args a{};
    for (int i = 0; i < 18; ++i) a.in[i] = (const float*)d_in[i];
    a.out = (float*)d_out; a.ws = (unsigned char*)d_ws;
    void* params[] = {&a};
    hipError_t e = hipLaunchCooperativeKernel((const void*)mega_fwd, dim3(grid), dim3(NWAVES * 64), params, LDS_BYTES, stream);
    if (e != hipSuccess) fprintf(stderr, "cooperative launch failed: %s (grid %d)\n", hipGetErrorString(e), grid);
}
```

```cpp
#include <hip/hip_runtime.h>
#include <cstdio>
#include <cstdint>
namespace pg8 {
#define PG8_LAS __attribute__((address_space(3)))
typedef unsigned short bf16_t;
typedef short bf16x8 __attribute__((ext_vector_type(8)));
typedef float f32x4 __attribute__((ext_vector_type(4)));
typedef unsigned u32x4 __attribute__((ext_vector_type(4)));
constexpr int BM = 256, BK = 64, HALF = 128, HTB = HALF * BK * 2  , STAGE_BYTES = 8 * HTB, NXCD = 8, WGM = 8;

__host__ __device__ __forceinline__ int lds_byte(int r, int c) { const int st = (r >> 4) * 2 + (c >> 5), rr = r & 15, cc = c & 31, ob = rr * 64 + cc * 2; return st * 1024 + (ob ^ (((ob >> 9) & 1) << 5)); }
__host__ __device__ __forceinline__ void stage_rc(int b, int& R, int& C) { const int st = b / 1024, sb = b % 1024, swz = sb ^ (((sb >> 9) & 1) << 5); R = (st >> 1) * 16 + swz / 64; C = (st & 1) * 32 + (swz % 64) / 2; }
__host__ __device__ __forceinline__ int perm32(int rho) { const int n = rho >> 4, i = rho & 15; return 8 * (i >> 2) + 4 * n + (i & 3); }

struct Unit { int pm, pn; };
struct Gemm { const bf16_t* A; const bf16_t* Bt; int M, N, K; };

struct StaticOrder {
    int nM, nN, nwg, G, c;
    __host__ __device__ void init(int M, int N, int G_, int c_) { nM = M / BM; nN = N / BM; nwg = nM * nN; G = G_; c = c_; }
    __host__ __device__ bool next(int i, Unit& u) const {
        const long L = (long)i * G + c; if (L >= nwg) return false;
        int wgid = (int)L; { const int q = nwg / NXCD, r = nwg % NXCD, xcd = wgid % NXCD, off = wgid / NXCD; wgid = (xcd < r ? xcd * (q + 1) : r * (q + 1) + (xcd - r) * q) + off; }
        const int nig = WGM * nN, gid = wgid / nig, fm = gid * WGM, gsz = (nM - fm) < WGM ? (nM - fm) : WGM;
        u.pm = fm + ((wgid % nig) % gsz); u.pn = (wgid % nig) / gsz; return true;
    }
    __device__ __forceinline__ void a_ready(const Unit&) const {}
    __device__ __forceinline__ void done(const Unit&) const {}
};

struct SignalOrder : StaticOrder {
    unsigned* tot_main; unsigned* tot_tail;
    __device__ __forceinline__ void done(const Unit& u) const {
        asm volatile("s_waitcnt vmcnt(0)" ::: "memory");
        if ((threadIdx.x & 63) == 0) __hip_atomic_fetch_add(u.pm < 128 ? tot_main : tot_tail, 1u, __ATOMIC_RELAXED, __HIP_MEMORY_SCOPE_AGENT);
    }
};
typedef float f32x2 __attribute__((ext_vector_type(2)));
typedef __bf16 bf16x2_cv __attribute__((ext_vector_type(2)));
__device__ __forceinline__ unsigned cvt_pk_bf16(float lo, float hi) { f32x2 v = {lo, hi}; bf16x2_cv b = __builtin_convertvector(v, bf16x2_cv); return __builtin_bit_cast(unsigned, b); }
__device__ __forceinline__ float fast_sigmoid(float x) { return __builtin_amdgcn_rcpf(1.0f + __builtin_amdgcn_exp2f(-1.4426950408889634f * x)); }
__device__ __forceinline__ u32x4 pack8(const f32x4 a, const f32x4 b) { u32x4 w; w.x = cvt_pk_bf16(a[0], a[1]); w.y = cvt_pk_bf16(a[2], a[3]); w.z = cvt_pk_bf16(b[0], b[1]); w.w = cvt_pk_bf16(b[2], b[3]); return w; }
typedef unsigned u32x2 __attribute__((ext_vector_type(2)));
__device__ __forceinline__ float bf_lo(unsigned w) { return __uint_as_float(w << 16); }
__device__ __forceinline__ float bf_hi(unsigned w) { return __uint_as_float(w & 0xffff0000u); }

struct EpiSwiGLU {
    static constexpr bool PERM = true, AFTER_DRAIN = false;
    bf16_t* O; int ldc;
    __device__ __forceinline__ void operator()(const f32x4 (&acc)[2][2][4][2], const Unit& u, int wr, int wc, int fr, int fq) const {
        const int row0 = u.pm * BM + wr * 64 + fr; const int col0 = u.pn * 128 + wc * 32 + 8 * fq;
#pragma unroll
        for (int ai = 0; ai < 2; ++ai)
#pragma unroll
            for (int m = 0; m < 4; ++m) {
                f32x4 v[2];
#pragma unroll
                for (int n = 0; n < 2; ++n) { const f32x4 g = acc[ai][0][m][n], up = acc[ai][1][m][n];
#pragma unroll
                    for (int j = 0; j < 4; ++j) v[n][j] = g[j] * fast_sigmoid(g[j]) * up[j]; }
                *(u32x4*)(O + (size_t)(row0 + ai * HALF + m * 16) * ldc + col0) = pack8(v[0], v[1]);
            }
    }
};
__device__ __forceinline__ void st_wt(float* p, const f32x4 v) { asm volatile("global_store_dwordx4 %0, %1, off sc0 sc1" :: "v"(p), "v"(v) : "memory"); }
struct EpiResid {
    static constexpr bool PERM = true, AFTER_DRAIN = false;
    float* H; float alpha, coef;
    const float* stats; const float* g; const float* b;
    __device__ __forceinline__ void operator()(const f32x4 (&acc)[2][2][4][2], const Unit& u, int wr, int wc, int fr, int fq) const {
        const int row0 = u.pm * BM + wr * 64 + fr; const int col0 = u.pn * BM + wc * 32 + 8 * fq;
#pragma unroll
        for (int ai = 0; ai < 2; ++ai)
#pragma unroll
            for (int m = 0; m < 4; ++m) {
                const int row = row0 + ai * HALF + m * 16;
                float* rp = H + (size_t)row * 1024 + col0;
                const f32x2 st = *(const f32x2*)(stats + 2 * (size_t)row);
#pragma unroll
                for (int bj = 0; bj < 2; ++bj) {
                    f32x4 a = *(const f32x4*)(rp + bj * HALF), bb = *(const f32x4*)(rp + bj * HALF + 4);
                    { const f32x4 g0 = *(const f32x4*)(g + col0 + bj * HALF), g1 = *(const f32x4*)(g + col0 + bj * HALF + 4), b0 = *(const f32x4*)(b + col0 + bj * HALF), b1 = *(const f32x4*)(b + col0 + bj * HALF + 4);
                        a = (a - st.x) * st.y * g0 + b0; bb = (bb - st.x) * st.y * g1 + b1; }
                    a = a * alpha + acc[ai][bj][m][0] * coef; bb = bb * alpha + acc[ai][bj][m][1] * coef;
                    *(f32x4*)(rp + bj * HALF) = a; *(f32x4*)(rp + bj * HALF + 4) = bb;
                }
            }
    }
};
struct EpiInProj {
    static constexpr bool PERM = true, AFTER_DRAIN = false;
    bf16_t* bch; float* lat; bf16_t* gates; const float* bgate;
    __device__ __forceinline__ void operator()(const f32x4 (&acc)[2][2][4][2], const Unit& u, int wr, int wc, int fr, int fq) const {
        const int row0 = u.pm * BM + wr * 64 + fr; const int cw = wc * 32 + 8 * fq; const int pn = u.pn;
        if (pn < 6) {
#pragma unroll
            for (int ai = 0; ai < 2; ++ai)
#pragma unroll
                for (int m = 0; m < 4; ++m) { bf16_t* rp = bch + (size_t)(row0 + ai * HALF + m * 16) * 1536 + pn * BM + cw;
#pragma unroll
                    for (int bj = 0; bj < 2; ++bj) *(u32x4*)(rp + bj * HALF) = pack8(acc[ai][bj][m][0], acc[ai][bj][m][1]); }
        } else if (pn < 8) {
#pragma unroll
            for (int ai = 0; ai < 2; ++ai)
#pragma unroll
                for (int m = 0; m < 4; ++m) { float* rp = lat + (size_t)(row0 + ai * HALF + m * 16) * 512 + (pn - 6) * BM + cw;
#pragma unroll
                    for (int bj = 0; bj < 2; ++bj) { *(f32x4*)(rp + bj * HALF) = acc[ai][bj][m][0]; *(f32x4*)(rp + bj * HALF + 4) = acc[ai][bj][m][1]; } }
        } else {
            const int gc = (pn - 8) * BM + cw;
            f32x4 bv[2][2];
#pragma unroll
            for (int bj = 0; bj < 2; ++bj)
#pragma unroll
                for (int n = 0; n < 2; ++n) bv[bj][n] = *(const f32x4*)(bgate + gc + bj * HALF + 4 * n);
#pragma unroll
            for (int ai = 0; ai < 2; ++ai)
#pragma unroll
                for (int m = 0; m < 4; ++m) { bf16_t* rp = gates + (size_t)(row0 + ai * HALF + m * 16) * 2048 + gc;
#pragma unroll
                    for (int bj = 0; bj < 2; ++bj) { f32x4 v[2];
#pragma unroll
                        for (int n = 0; n < 2; ++n) {
#ifdef PROBE_NO_BIAS
                            const f32x4 x = acc[ai][bj][m][n];
#else
                            const f32x4 x = acc[ai][bj][m][n] + bv[bj][n];
#endif
#pragma unroll
                            for (int j = 0; j < 4; ++j) {
#ifdef PROBE_PLAIN_GATES
                                v[n][j] = acc[ai][bj][m][n][j];
#elif defined(PROBE_BV_GATES)
                                v[n][j] = bv[bj][n][j] * 16.0f;
#else
                                v[n][j] = fast_sigmoid(x[j]);
#endif
                            } }
                        *(u32x4*)(rp + bj * HALF) = pack8(v[0], v[1]); } }
        }
    }
};
struct EpiPlain {
    static constexpr bool PERM = true, AFTER_DRAIN = false;
    bf16_t* O; int ldc; float scale;
    __device__ __forceinline__ void operator()(const f32x4 (&acc)[2][2][4][2], const Unit& u, int wr, int wc, int fr, int fq) const {
        const int row0 = u.pm * BM + wr * 64 + fr; const int col0 = u.pn * BM + wc * 32 + 8 * fq;
#pragma unroll
        for (int ai = 0; ai < 2; ++ai)
#pragma unroll
            for (int m = 0; m < 4; ++m) { bf16_t* rp = O + (size_t)(row0 + ai * HALF + m * 16) * ldc + col0;
#pragma unroll
                for (int bj = 0; bj < 2; ++bj) *(u32x4*)(rp + bj * HALF) = pack8(acc[ai][bj][m][0] * scale, acc[ai][bj][m][1] * scale); }
    }
};
struct EpiVt {
    static constexpr bool PERM = false, AFTER_DRAIN = false;
    bf16_t* Vt;
    __device__ __forceinline__ void operator()(const f32x4 (&acc)[2][2][4][2], const Unit& u, int wr, int wc, int fr, int fq) const {
        constexpr int T_ = 8208, TP_ = 8320, M_ = 4 * 8208;
        const int feat0 = u.pm * BM + wr * 64 + fr; const int pos = 8 * (fq & 1) + 4 * (fq >> 1);
#pragma unroll
        for (int bj = 0; bj < 2; ++bj)
#pragma unroll
            for (int n = 0; n < 2; ++n) {
                const int tok0 = u.pn * BM + bj * HALF + wc * 32 + n * 16;
                if (tok0 < M_) {
                    const int b = tok0 / T_, t0 = tok0 - b * T_;
                    bf16_t* vp = Vt + ((size_t)b * 512 + feat0) * TP_ + t0 + pos;
#pragma unroll
                    for (int ai = 0; ai < 2; ++ai)
#pragma unroll
                        for (int m = 0; m < 4; ++m) { const f32x4 x = acc[ai][bj][m][n]; u32x2 w; w.x = cvt_pk_bf16(x[0], x[1]); w.y = cvt_pk_bf16(x[2], x[3]);
                            *(u32x2*)(vp + (size_t)(ai * HALF + m * 16) * TP_) = w; }
                }
            }
    }
};
template <bool ACCUM> struct EpiGate {
    static constexpr bool PERM = true, AFTER_DRAIN = false;
    bf16_t* O; const bf16_t* G;
    __device__ __forceinline__ void operator()(const f32x4 (&acc)[2][2][4][2], const Unit& u, int wr, int wc, int fr, int fq) const {
        const int row0 = u.pm * BM + wr * 64 + fr; const int col0 = u.pn * BM + wc * 32 + 8 * fq;
#pragma unroll
        for (int ai = 0; ai < 2; ++ai)
#pragma unroll
            for (int m = 0; m < 4; ++m) { const size_t row = (size_t)(row0 + ai * HALF + m * 16);
#pragma unroll
                for (int bj = 0; bj < 2; ++bj) {
                    const u32x4 g = *(const u32x4*)(G + row * 2048 + col0 + bj * HALF);
                    f32x4 a = acc[ai][bj][m][0], b = acc[ai][bj][m][1];
                    a[0] *= bf_lo(g.x); a[1] *= bf_hi(g.x); a[2] *= bf_lo(g.y); a[3] *= bf_hi(g.y);
                    b[0] *= bf_lo(g.z); b[1] *= bf_hi(g.z); b[2] *= bf_lo(g.w); b[3] *= bf_hi(g.w);
                    bf16_t* op = O + row * 1024 + col0 + bj * HALF;
                    if (ACCUM) { const u32x4 p = *(const u32x4*)op;
                        a[0] += bf_lo(p.x); a[1] += bf_hi(p.x); a[2] += bf_lo(p.y); a[3] += bf_hi(p.y);
                        b[0] += bf_lo(p.z); b[1] += bf_hi(p.z); b[2] += bf_lo(p.w); b[3] += bf_hi(p.w); }
                    *(u32x4*)op = pack8(a, b);
                }
            }
    }
};

template <class Epi, class Sched, bool ALIGN_EPI = false, bool SP2 = false>
__device__ __forceinline__ void gemm_phase(PG8_LAS unsigned char* lds, const Gemm g, const Sched& S, const Epi& E) {
    int tid_ = threadIdx.x; asm volatile("" : "+v"(tid_));
    const int tid = tid_, wid = __builtin_amdgcn_readfirstlane(tid >> 6), lane = tid & 63, wr = wid >> 2, wc = wid & 3, fr = lane & 15, fq = lane >> 4;
    int K_ = g.K; asm volatile("" : "+s"(K_));
    const int K = K_, nt = K / BK;
    unsigned voffA[2], voffB[2];
#pragma unroll
    for (int i = 0; i < 2; ++i) { int R, C; stage_rc(tid * 16 + i * 8192, R, C); const int Rb = Epi::PERM ? ((R & ~31) + perm32(R & 31)) : R;
        voffA[i] = (unsigned)(R * K + C) * 2u; voffB[i] = (unsigned)(Rb * K + C) * 2u; }
    const size_t kstep = (size_t)(BK * 2);
    const size_t hstep = (size_t)HALF * K * 2;
    const size_t tstep = 2 * hstep;
    const unsigned ldsw = (unsigned)wid * 1024u;
    const int aoff = lds_byte(wr * 64 + fr, fq * 8), boff = lds_byte(wc * 32 + fr, fq * 8);
#define PG8_SA(b, h) (((b) * 2 + (h)) * HTB)
#define PG8_SB(b, h) ((4 + (b) * 2 + (h)) * HTB)
#define PG8_STAGE(bufoff, gbase, voff) do { _Pragma("unroll") for (int _i = 0; _i < 2; ++_i) \
        __builtin_amdgcn_global_load_lds((const unsigned*)((const char*)(gbase) + (voff)[_i]), (PG8_LAS unsigned*)(lds + (bufoff) + ldsw + _i * 8192), 16, 0, 0); } while (0)
#define PG8_LDA(dst, b, h) do { _Pragma("unroll") for (int m = 0; m < 4; ++m) _Pragma("unroll") for (int k = 0; k < 2; ++k) dst[m][k] = *(const PG8_LAS bf16x8*)(lds + PG8_SA(b, h) + aoff + m * 2048 + k * 1024); } while (0)
#define PG8_LDB(dst, b, h) do { _Pragma("unroll") for (int n = 0; n < 2; ++n) _Pragma("unroll") for (int k = 0; k < 2; ++k) dst[n][k] = *(const PG8_LAS bf16x8*)(lds + PG8_SB(b, h) + boff + n * 2048 + k * 1024); } while (0)
#define PG8_MMA(ai, bj, At, Bt) do { __builtin_amdgcn_s_setprio(1); _Pragma("unroll") for (int m = 0; m < 4; ++m) _Pragma("unroll") for (int n = 0; n < 2; ++n) _Pragma("unroll") for (int k = 0; k < 2; ++k) \
        acc[ai][bj][m][n] = __builtin_amdgcn_mfma_f32_16x16x32_bf16(Bt[n][k], At[m][k], acc[ai][bj][m][n], 0, 0, 0); __builtin_amdgcn_s_setprio(0); } while (0)
#define PG8_WAIT_V(n) asm volatile("s_waitcnt vmcnt(" #n ")" ::: "memory")
#define PG8_WAIT_L(n) asm volatile("s_waitcnt lgkmcnt(" #n ")" ::: "memory")
#define PG8_BAR __builtin_amdgcn_s_barrier()
#define PG8_SCHED __builtin_amdgcn_sched_barrier(0)
    Unit cur, nxt; int ui = 0;
    if (!S.next(0, cur)) return;
    f32x4 acc[2][2][4][2];
#pragma unroll
    for (int a = 0; a < 2; ++a)
#pragma unroll
        for (int b = 0; b < 2; ++b)
#pragma unroll
            for (int m = 0; m < 4; ++m)
#pragma unroll
                for (int n = 0; n < 2; ++n) acc[a][b][m][n] = (f32x4){0.f, 0.f, 0.f, 0.f};
    bf16x8 At[4][2], B0[2][2], B1[2][2];
    const char* cA = (const char*)g.A + (size_t)cur.pm * tstep; const char* cB = (const char*)g.Bt + (size_t)cur.pn * tstep;
    S.a_ready(cur);
    if constexpr (SP2) {
        PG8_STAGE(PG8_SB(0, 0), cB, voffB); PG8_STAGE(PG8_SB(0, 1), cB + hstep, voffB); PG8_STAGE(PG8_SA(0, 0), cA, voffA); PG8_STAGE(PG8_SA(0, 1), cA + hstep, voffA);
        if (wr == 1) PG8_BAR;
        PG8_WAIT_V(2); PG8_BAR;
        PG8_STAGE(PG8_SB(1, 0), cB + kstep, voffB); PG8_STAGE(PG8_SA(1, 0), cA + kstep, voffA); PG8_STAGE(PG8_SB(1, 1), cB + hstep + kstep, voffB);
        PG8_WAIT_V(6); PG8_BAR;
    } else {
        PG8_STAGE(PG8_SB(0, 0), cB, voffB); PG8_STAGE(PG8_SA(0, 0), cA, voffA); PG8_STAGE(PG8_SB(0, 1), cB + hstep, voffB); PG8_STAGE(PG8_SA(0, 1), cA + hstep, voffA);
        if (wr == 1) PG8_BAR;
        PG8_WAIT_V(4); PG8_BAR;
        PG8_STAGE(PG8_SB(1, 0), cB + kstep, voffB); PG8_STAGE(PG8_SA(1, 0), cA + kstep, voffA); PG8_STAGE(PG8_SB(1, 1), cB + hstep + kstep, voffB);
        PG8_WAIT_V(6); PG8_BAR;
    }
    for (;;) {
        const bool has_next = S.next(ui + 1, nxt);
        const char* nA = has_next ? (const char*)g.A + (size_t)nxt.pm * tstep : cA; const char* nB = has_next ? (const char*)g.Bt + (size_t)nxt.pn * tstep : cB;
        for (int t = 0; t < nt; t += 2) {
            const bool last = (t == nt - 2);
            const char* a1 = cA + (size_t)(t + 1) * kstep;
            const char* a2 = last ? nA : cA + (size_t)(t + 2) * kstep; const char* b2 = last ? nB : cB + (size_t)(t + 2) * kstep;
            const char* a3 = a2 + kstep; const char* b3 = b2 + kstep;
            if (last && has_next) S.a_ready(nxt);
            if constexpr (SP2) {
            PG8_LDB(B0, 0, 0); PG8_LDB(B1, 0, 1); PG8_SCHED; PG8_LDA(At, 0, 0); PG8_STAGE(PG8_SA(1, 1), a1 + hstep, voffA);
            PG8_WAIT_V(8); PG8_WAIT_L(0); PG8_BAR; PG8_MMA(0, 0, At, B0); PG8_MMA(0, 1, At, B1); PG8_BAR; PG8_SCHED;
            PG8_LDA(At, 0, 1); PG8_STAGE(PG8_SB(0, 0), b2, voffB); PG8_STAGE(PG8_SB(0, 1), b2 + hstep, voffB); PG8_STAGE(PG8_SA(0, 0), a2, voffA);
            PG8_WAIT_V(8); PG8_WAIT_L(0); PG8_BAR; PG8_MMA(1, 0, At, B0); PG8_MMA(1, 1, At, B1); PG8_BAR; PG8_SCHED;
            PG8_LDB(B0, 1, 0); PG8_LDB(B1, 1, 1); PG8_SCHED; PG8_LDA(At, 1, 0); PG8_STAGE(PG8_SA(0, 1), a2 + hstep, voffA);
            PG8_WAIT_V(8); PG8_WAIT_L(0); PG8_BAR; PG8_MMA(0, 0, At, B0); PG8_MMA(0, 1, At, B1); PG8_BAR; PG8_SCHED;
            PG8_LDA(At, 1, 1); PG8_STAGE(PG8_SB(1, 0), b3, voffB); PG8_STAGE(PG8_SB(1, 1), b3 + hstep, voffB); PG8_STAGE(PG8_SA(1, 0), a3, voffA);
            PG8_WAIT_V(8); PG8_WAIT_L(0); PG8_BAR; PG8_MMA(1, 0, At, B0); PG8_MMA(1, 1, At, B1); PG8_BAR; PG8_SCHED;
            } else {
            PG8_LDB(B0, 0, 0); PG8_SCHED; PG8_LDA(At, 0, 0); PG8_STAGE(PG8_SA(1, 1), a1 + hstep, voffA);
            PG8_WAIT_L(8); PG8_BAR; PG8_WAIT_L(0); PG8_MMA(0, 0, At, B0); PG8_BAR; PG8_SCHED;
            PG8_LDB(B1, 0, 1); PG8_STAGE(PG8_SB(0, 0), b2, voffB);
            PG8_BAR; PG8_WAIT_L(0); PG8_MMA(0, 1, At, B1); PG8_BAR;
            PG8_LDA(At, 0, 1); PG8_STAGE(PG8_SA(0, 0), a2, voffA);
            PG8_BAR; PG8_WAIT_L(0); PG8_MMA(1, 0, At, B0); PG8_BAR; PG8_SCHED;
            PG8_STAGE(PG8_SB(0, 1), b2 + hstep, voffB);
            PG8_WAIT_V(6); PG8_BAR; PG8_MMA(1, 1, At, B1); PG8_BAR;
            PG8_LDB(B0, 1, 0); PG8_SCHED; PG8_LDA(At, 1, 0); PG8_STAGE(PG8_SA(0, 1), a2 + hstep, voffA);
            PG8_WAIT_L(8); PG8_BAR; PG8_WAIT_L(0); PG8_MMA(0, 0, At, B0); PG8_BAR; PG8_SCHED;
            PG8_LDB(B1, 1, 1); PG8_STAGE(PG8_SB(1, 0), b3, voffB);
            PG8_BAR; PG8_WAIT_L(0); PG8_MMA(0, 1, At, B1); PG8_BAR;
            PG8_LDA(At, 1, 1); PG8_STAGE(PG8_SA(1, 0), a3, voffA);
            PG8_BAR; PG8_WAIT_L(0); PG8_MMA(1, 0, At, B0); PG8_BAR; PG8_SCHED;
            PG8_STAGE(PG8_SB(1, 1), b3 + hstep, voffB);
            PG8_WAIT_V(6); PG8_BAR; PG8_MMA(1, 1, At, B1); PG8_BAR;
            }
        }
        if constexpr (ALIGN_EPI) { if (wr == 0) PG8_BAR; }
        if constexpr (!Epi::AFTER_DRAIN) { E(acc, cur, wr, wc, fr, fq); S.done(cur); }
        if (!has_next) break;
#pragma unroll
        for (int a = 0; a < 2; ++a)
#pragma unroll
            for (int b = 0; b < 2; ++b)
#pragma unroll
                for (int m = 0; m < 4; ++m)
#pragma unroll
                    for (int n = 0; n < 2; ++n) acc[a][b][m][n] = (f32x4){0.f, 0.f, 0.f, 0.f};
        cur = nxt; cA = nA; cB = nB; ++ui;
        if constexpr (ALIGN_EPI) { if (wr == 1) PG8_BAR; }
    }
    PG8_WAIT_V(0);
    if constexpr (!ALIGN_EPI) { if (wr == 0) PG8_BAR; }
    PG8_BAR;
    if constexpr (Epi::AFTER_DRAIN) { E.fused(acc, cur, wr, wc, fr, fq, lds, wid, lane); S.done(cur); }
#undef PG8_SA
#undef PG8_SB
#undef PG8_STAGE
#undef PG8_LDA
#undef PG8_LDB
#undef PG8_MMA
#undef PG8_WAIT_V
#undef PG8_WAIT_L
#undef PG8_BAR
#undef PG8_SCHED
}
}

#include <hip/hip_cooperative_groups.h>
#include <type_traits>
namespace cg = cooperative_groups;

constexpr int D_MODEL = 1024, BATCH = 4, SEQ = 8192, DEPTH = 2, N_META = 16, T = SEQ + N_META  , M = BATCH * T  , MPAD = 33024  , MMAIN = 32768  ;
constexpr int D_CONV = 512, D_FF = 2816, D_IN = 4000, D_INP = 4096, NHEAD = 8, TP = 8320;
constexpr float ALPHA = 1.4142135623730951f;
constexpr float LN_EPS = 1e-5f, RMS_EPS = 1e-6f;
constexpr float QSCALE = 0.10206207261596575f * 1.4426950408889634f;
constexpr int NWAVES = 8;

constexpr size_t OFF_CTL = 0;
constexpr size_t OFF_ROPE = 65536;
constexpr size_t OFF_STATS = 1179648;
constexpr size_t OFF_HF = 2097152;
constexpr size_t SZ_HF = (size_t)MPAD * 1024 * 4;
constexpr size_t OFF_W = OFF_HF + SZ_HF;
constexpr size_t SZ_W = 17825792;
constexpr size_t OFF_S = OFF_W + SZ_W;
constexpr size_t SZ_HB = (size_t)MPAD * 1024 * 2;
constexpr size_t S_HB = OFF_S;
constexpr size_t S_GATES = OFF_S + SZ_HB;
constexpr size_t S_ACT = S_GATES;
constexpr size_t S_BCH = S_GATES + (size_t)MPAD * 2048 * 2;
constexpr size_t S_LAT = S_BCH + (size_t)MPAD * 1536 * 2;
constexpr size_t S_END4 = S_LAT + (size_t)MPAD * 512 * 4;
constexpr size_t S_YCONV = S_HB;
constexpr size_t S_CQN = S_YCONV + (size_t)MPAD * 512 * 2;
constexpr size_t S_CKVN = S_CQN + (size_t)MPAD * 256 * 2;
static_assert(S_CKVN + (size_t)MPAD * 256 * 2 <= S_GATES, "row-prep outputs fit in hb's region");
constexpr size_t S_Q = S_BCH;
constexpr size_t S_KN = S_Q + (size_t)MPAD * 768 * 2;
constexpr size_t S_VT = S_KN + (size_t)MPAD * 512 * 2;
constexpr size_t S_YMLA = S_VT + (size_t)BATCH * NHEAD * 64 * TP * 2;
static_assert(S_YMLA + (size_t)MPAD * 512 * 2 <= S_END4, "attention tensors fit in bch|lat's region");
constexpr size_t S_MERGED = S_Q;
static_assert(S_MERGED + (size_t)MPAD * 1024 * 2 <= S_VT + 0 * S_YMLA && S_ACT + (size_t)MPAD * 2816 * 2 <= S_END4, "overlays");
constexpr size_t S_KR = S_END4;
constexpr size_t WS_NEED = S_KR + (size_t)MPAD * 32 * 2;
static_assert(WS_NEED <= 536870912, "fits the guaranteed workspace");
constexpr size_t W_UP = 0, W_DOWN = (size_t)5632 * 1024 * 2;
constexpr size_t W_IN = 0, W_UQ = (size_t)4096 * 1024 * 2, W_UKV = W_UQ + 768 * 256 * 2, W_BC = W_UKV + 1024 * 256 * 2, W_BM = W_BC + 1024 * 512 * 2, W_O = W_BM + 1024 * 512 * 2;
static_assert(W_O + 1024 * 1024 * 2 <= SZ_W && W_DOWN + (size_t)1024 * 2816 * 2 <= SZ_W, "weight region");
constexpr int RING_BYTES = 131072, LDS_MISC = RING_BYTES, LDS_BYTES = RING_BYTES + 256;

#define LAS __attribute__((address_space(3)))
#define GAS __attribute__((address_space(1)))
typedef unsigned short bf16;
typedef unsigned v4u __attribute__((ext_vector_type(4)));
typedef unsigned v2u __attribute__((ext_vector_type(2)));
typedef float f32x4 __attribute__((ext_vector_type(4)));
typedef float f32x2 __attribute__((ext_vector_type(2)));
typedef float f32x16 __attribute__((ext_vector_type(16)));
typedef short bf16x8 __attribute__((ext_vector_type(8)));
#define LDS_WAIT() asm volatile("s_waitcnt lgkmcnt(0)" ::: "memory")

__device__ __forceinline__ unsigned pk2(float lo, float hi) { return pg8::cvt_pk_bf16(lo, hi); }
__device__ __forceinline__ float wave_sum(float v) {
#pragma unroll
    for (int o = 1; o < 64; o <<= 1) v += __shfl_xor(v, o);
    return v;
}

__device__ __forceinline__ float inv_freq_of(int k) {
    switch (k) { case 0: return 1.000000000e+00f; case 1: return 5.623413324e-01f; case 2: return 3.162277639e-01f; case 3: return 1.778279394e-01f; case 4: return 1.000000015e-01f; case 5: return 5.623412877e-02f;
        case 6: return 3.162277862e-02f; case 7: return 1.778279431e-02f; case 8: return 9.999999776e-03f; case 9: return 5.623413250e-03f; case 10: return 3.162277862e-03f; case 11: return 1.778279431e-03f;
        case 12: return 1.000000047e-03f; case 13: return 5.623413017e-04f; case 14: return 3.162277862e-04f; default: return 1.778279402e-04f; }
}
__device__ __forceinline__ void transpose_item(const float* W, int N, int k0, int scol0, bf16* dst, int ldk, int drow0, LAS float* scr, int lane) {
    if (scol0 >= 0) {
        float wv[32];
#pragma unroll
        for (int i = 0; i < 32; ++i) wv[i] = W[(size_t)(k0 + 2 * i + (lane >> 5)) * N + scol0 + (lane & 31)];
#pragma unroll
        for (int i = 0; i < 32; ++i) scr[(2 * i + (lane >> 5)) * 33 + (lane & 31)] = wv[i];
    } else {
#pragma unroll 8
        for (int i = 0; i < 32; ++i) { const int kk = 2 * i + (lane >> 5); scr[kk * 33 + (lane & 31)] = 0.f; }
    }
    LDS_WAIT(); asm volatile("" ::: "memory");
    const int c = lane & 7;
#pragma unroll
    for (int j = 0; j < 4; ++j) { const int n = (lane >> 3) + 8 * j; const LAS float* s = scr + (8 * c) * 33 + n;
        v4u o; o.x = pk2(s[0 * 33], s[1 * 33]); o.y = pk2(s[2 * 33], s[3 * 33]); o.z = pk2(s[4 * 33], s[5 * 33]); o.w = pk2(s[6 * 33], s[7 * 33]);
        *(v4u*)(dst + (size_t)(drow0 + n) * ldk + k0 + 8 * c) = o; }
    LDS_WAIT(); asm volatile("" ::: "memory");
}
__device__ __forceinline__ void convert_ffn(const float* w_up, const float* w_down, unsigned char* wreg, LAS float* scr, int gw, int ngw, int lane) {
    constexpr int I_UP = 16 * 176, I_DN = 44 * 32;
    for (int it = gw; it < I_UP + I_DN; it += ngw) {
        if (it < I_UP) { const int kb = it / 176, g = it % 176, tile = g >> 3, sub = g & 7;
            const int scol = sub < 4 ? tile * 128 + sub * 32 : D_FF + tile * 128 + (sub - 4) * 32;
            transpose_item(w_up, 2 * D_FF, kb * 64, scol, (bf16*)(wreg + W_UP), 1024, g * 32, scr, lane); }
        else { const int r = it - I_UP, kb = r / 32, g = r % 32; transpose_item(w_down, 1024, kb * 64, g * 32, (bf16*)(wreg + W_DOWN), D_FF, g * 32, scr, lane); }
    }
}
__device__ __forceinline__ void convert_mixer(const float* w_in, const float* w_uq, const float* w_ukv, const float* w_bc, const float* w_bm, const float* w_o, unsigned char* wreg, LAS float* scr, int gw, int ngw, int lane) {
    constexpr int I_IN = 16 * 128, I_UQ = 4 * 24, I_UKV = 4 * 32, I_BR = 8 * 32, I_O = 16 * 32;
    for (int it = gw; it < I_IN + I_UQ + I_UKV + 2 * I_BR + I_O; it += ngw) {
        int r = it;
        if (r < I_IN) { const int kb = r / 128, g = r % 128, n = g * 32; const int scol = n < 1952 ? n : (n < 2048 ? -1 : (n < 3072 ? 1952 + (n - 2048) : 2976 + (n - 3072)));
            transpose_item(w_in, D_IN, kb * 64, scol, (bf16*)(wreg + W_IN), 1024, n, scr, lane); continue; } r -= I_IN;
        if (r < I_UQ) { const int kb = r / 24, g = r % 24; transpose_item(w_uq, 768, kb * 64, g * 32, (bf16*)(wreg + W_UQ), 256, g * 32, scr, lane); continue; } r -= I_UQ;
        if (r < I_UKV) { const int kb = r / 32, g = r % 32, gg = g & 15; const int scol = (gg >> 1) * 128 + (g >> 4) * 64 + (gg & 1) * 32;
            transpose_item(w_ukv, 1024, kb < 2 ? kb * 64 : 0, kb < 2 ? scol : -1, (bf16*)(wreg + W_UKV) + (kb < 2 ? 0 : kb * 64), 256, g * 32, scr, lane); continue; } r -= I_UKV;
        if (r < I_BR) { const int kb = r / 32, g = r % 32; transpose_item(w_bc, 1024, kb * 64, g * 32, (bf16*)(wreg + W_BC), 512, g * 32, scr, lane); continue; } r -= I_BR;
        if (r < I_BR) { const int kb = r / 32, g = r % 32; transpose_item(w_bm, 1024, kb * 64, g * 32, (bf16*)(wreg + W_BM), 512, g * 32, scr, lane); continue; } r -= I_BR;
        { const int kb = r / 32, g = r % 32; transpose_item(w_o, 1024, kb * 64, g * 32, (bf16*)(wreg + W_O), 1024, g * 32, scr, lane); }
    }
}

struct LnRow { f32x4 v[4]; };
__device__ __forceinline__ LnRow ln_load(const float* xin, int lane) { LnRow r; const f32x4* xr = (const f32x4*)xin + lane;
#pragma unroll
    for (int j = 0; j < 4; ++j) r.v[j] = xr[64 * j];
    return r; }
__device__ __forceinline__ void ln_finish(LnRow r, const float* g, const float* bt, float* of32, bf16* ob16, int lane, float* ostat = nullptr) {
    f32x4 (&v)[4] = r.v; float s = 0.f;
#pragma unroll
    for (int j = 0; j < 4; ++j) s += (v[j].x + v[j].y) + (v[j].z + v[j].w);
    const float mean = wave_sum(s) * (1.f / 1024.f); float s2 = 0.f;
#pragma unroll
    for (int j = 0; j < 4; ++j) { v[j] = v[j] - mean; s2 += (v[j].x * v[j].x + v[j].y * v[j].y) + (v[j].z * v[j].z + v[j].w * v[j].w); }
    const float rstd = 1.f / sqrtf(wave_sum(s2) * (1.f / 1024.f) + LN_EPS);
    if (ostat && lane == 0) { ostat[0] = mean; ostat[1] = rstd; }
#pragma unroll
    for (int j = 0; j < 4; ++j) { const f32x4 gg = ((const f32x4*)g)[lane + 64 * j], bb = ((const f32x4*)bt)[lane + 64 * j]; v[j] = v[j] * rstd * gg + bb; }
    if (of32) {
#pragma unroll
        for (int j = 0; j < 4; ++j) ((f32x4*)of32)[lane + 64 * j] = v[j]; }
    if (ob16) {
#pragma unroll
        for (int j = 0; j < 4; ++j) { v2u w; w.x = pk2(v[j].x, v[j].y); w.y = pk2(v[j].z, v[j].w); ((v2u*)ob16)[lane + 64 * j] = w; } }
}
__device__ __forceinline__ void ln_row(const float* xin, const float* g, const float* bt, float* of32, bf16* ob16, int lane) { ln_finish(ln_load(xin, lane), g, bt, of32, ob16, lane); }

struct TailResid { float* H; float alpha, coef; const float* stats; const float* g; const float* b;
    __device__ __forceinline__ void operator()(int token, int col, const f32x4 s) const { float* p = H + (size_t)token * 1024 + col; f32x4 h = *(const f32x4*)p;
        { const f32x2 st = *(const f32x2*)(stats + 2 * token); h = (h - st.x) * st.y * *(const f32x4*)(g + col) + *(const f32x4*)(b + col); }
        *(f32x4*)p = h * alpha + s * coef; } };
template <bool ACCUM> struct TailGate { bf16* O; const bf16* G;
    __device__ __forceinline__ void operator()(int token, int col, f32x4 s) const {
        const v2u g = *(const v2u*)(G + (size_t)token * 2048 + col); bf16* op = O + (size_t)token * 1024 + col;
        s[0] *= pg8::bf_lo(g.x); s[1] *= pg8::bf_hi(g.x); s[2] *= pg8::bf_lo(g.y); s[3] *= pg8::bf_hi(g.y);
        if (ACCUM) { const v2u p = *(const v2u*)op; s[0] += pg8::bf_lo(p.x); s[1] += pg8::bf_hi(p.x); s[2] += pg8::bf_lo(p.y); s[3] += pg8::bf_hi(p.y); }
        v2u w; w.x = pk2(s[0], s[1]); w.y = pk2(s[2], s[3]); *(v2u*)op = w; } };
template <int NB, class F> __device__ __forceinline__ void tail_gemm_nb(const bf16* A, const bf16* Bt, int K, int blk, int nstrip, const int (&brow)[NB], LAS unsigned char* lds, const F& epi) {
    if (blk >= nstrip) return;
    int tid_ = threadIdx.x; asm volatile("" : "+v"(tid_));
    const int lane = tid_ & 63, wid = tid_ >> 6, fr = lane & 15, fq = lane >> 4, kw = K >> 3;
    const bf16* ap = A + (size_t)fr * K + wid * kw + fq * 8;
    f32x4 acc[NB][4];
#pragma unroll
    for (int j = 0; j < NB; ++j)
#pragma unroll
        for (int m = 0; m < 4; ++m) acc[j][m] = (f32x4){0.f, 0.f, 0.f, 0.f};
    for (int k = 0; k < kw; k += 32) {
        bf16x8 a[4];
#pragma unroll
        for (int m = 0; m < 4; ++m) a[m] = *(const bf16x8*)(ap + (size_t)m * 16 * K + k);
#pragma unroll
        for (int j = 0; j < NB; ++j) { const bf16x8 b = *(const bf16x8*)(Bt + (size_t)(brow[j] + fr) * K + wid * kw + fq * 8 + k);
#pragma unroll
            for (int m = 0; m < 4; ++m) acc[j][m] = __builtin_amdgcn_mfma_f32_16x16x32_bf16(b, a[m], acc[j][m], 0, 0, 0); }
    }
    LAS f32x4* red = (LAS f32x4*)lds;
#pragma unroll
    for (int j = 0; j < NB; ++j)
#pragma unroll
        for (int m = 0; m < 4; ++m) red[((wid * NB + j) * 4 + m) * 64 + lane] = acc[j][m];
    __syncthreads();
    if (wid < 4) { f32x4 s[NB];
#pragma unroll
        for (int j = 0; j < NB; ++j) { s[j] = red[(j * 4 + wid) * 64 + lane];
#pragma unroll
            for (int w = 1; w < 8; ++w) s[j] = s[j] + red[((w * NB + j) * 4 + wid) * 64 + lane]; }
        epi(wid * 16 + fr, fq * 4, s); }
    __syncthreads();
}
template <class F> struct TailOne { const F& f; int n0; __device__ __forceinline__ void operator()(int token, int c4, const f32x4 (&s)[1]) const { f(token, n0 + c4, s[0]); } };
template <class F> __device__ __forceinline__ void tail_gemm(const bf16* A, const bf16* Bt, int K, int blk, LAS unsigned char* lds, const F& epi) {
    const int brow[1] = {blk * 16}; const TailOne<F> e{epi, blk * 16};
    tail_gemm_nb<1>(A, Bt, K, blk, 64, brow, lds, e);
}
struct TailSwiGLU { bf16* O; int c0;
    __device__ __forceinline__ void operator()(int token, int c4, const f32x4 (&s)[2]) const { f32x4 v;
#pragma unroll
        for (int i = 0; i < 4; ++i) v[i] = s[0][i] * pg8::fast_sigmoid(s[0][i]) * s[1][i];
        v2u w; w.x = pk2(v[0], v[1]); w.y = pk2(v[2], v[3]); *(v2u*)(O + (size_t)token * D_FF + c0 + c4) = w; } };
struct TailInProj { bf16* bch_; float* lat_; bf16* gates_; const float* bgate; int c0;
    __device__ __forceinline__ void operator()(int token, int c4, const f32x4 (&s)[1]) const { const int c = c0 + c4; f32x4 v = s[0];
        if (c < 1536) { v2u w; w.x = pk2(v[0], v[1]); w.y = pk2(v[2], v[3]); *(v2u*)(bch_ + (size_t)token * 1536 + c) = w; }
        else if (c < 2048) { *(f32x4*)(lat_ + (size_t)token * 512 + (c - 1536)) = v; }
        else { const f32x4 bv = *(const f32x4*)(bgate + (c - 2048));
#pragma unroll
            for (int i = 0; i < 4; ++i) v[i] = pg8::fast_sigmoid(v[i] + bv[i]);
            v2u w; w.x = pk2(v[0], v[1]); w.y = pk2(v[2], v[3]); *(v2u*)(gates_ + (size_t)token * 2048 + (c - 2048)) = w; } } };

namespace att {
constexpr int KB = 12288, VB = 8192, OFF_V = 3 * KB, OFF_WS = 3 * KB + 3 * VB, OFF_Q = OFF_WS + 8 * 256;
__device__ __forceinline__ int crow(int r, int hi) { return (r & 3) + 8 * (r >> 2) + 4 * hi; }
__device__ __forceinline__ float max3f(float a, float b, float c) { return __builtin_fmaxf(__builtin_fmaxf(a, b), c); }
__device__ __forceinline__ void attn_unit(int b, int h, int qb, const bf16* Q, const bf16* Kn, const bf16* Kr, const bf16* Vt, const float* rope, bf16* Y, LAS unsigned char* lds) {
    int tid_ = threadIdx.x; asm volatile("" : "+v"(tid_));
    const int tid = tid_, lane = tid & 63, r32 = lane & 31, hi = lane >> 5; const int wid = __builtin_amdgcn_readfirstlane(tid >> 6);
    const int q0 = qb * 256, q0w = q0 + wid * 32;
    const size_t rowbase = (size_t)b * T;
    int NT = (q0 + 256) / 64; if (NT > (T + 63) / 64) NT = (T + 63) / 64;
    int ntw = 0; if (q0w < T) { ntw = (q0w + 31) / 64 + 1; if (ntw > NT) ntw = NT; }
    bf16x8 qr[6];
    { int tq = q0w + r32; if (tq > T - 1) tq = T - 1; const bf16* qp = Q + (rowbase + tq) * 768 + h * 96 + hi * 8;
#pragma unroll
      for (int d0 = 0; d0 < 6; ++d0) qr[d0] = *(const GAS bf16x8*)(qp + d0 * 16);
      const float* rt = rope + (size_t)tq * 32 + 8 * hi; const f32x4 c0 = *(const GAS f32x4*)rt, c1 = *(const GAS f32x4*)(rt + 4), s0 = *(const GAS f32x4*)(rt + 16), s1 = *(const GAS f32x4*)(rt + 20);
      v4u a = __builtin_bit_cast(v4u, qr[4]), bb = __builtin_bit_cast(v4u, qr[5]), oa, ob;
#define ROT2(AW, BW, CA, CB, SA, SB, OA, OB) do { const float x1l = pg8::bf_lo(AW), x1h = pg8::bf_hi(AW), x2l = pg8::bf_lo(BW), x2h = pg8::bf_hi(BW); \
        OA = pk2(x1l * (CA) - x2l * (SA), x1h * (CB) - x2h * (SB)); OB = pk2(x2l * (CA) + x1l * (SA), x2h * (CB) + x1h * (SB)); } while (0)
      ROT2(a.x, bb.x, c0[0], c0[1], s0[0], s0[1], oa.x, ob.x); ROT2(a.y, bb.y, c0[2], c0[3], s0[2], s0[3], oa.y, ob.y);
      ROT2(a.z, bb.z, c1[0], c1[1], s1[0], s1[1], oa.z, ob.z); ROT2(a.w, bb.w, c1[2], c1[3], s1[2], s1[3], oa.w, ob.w);
#undef ROT2
      qr[4] = __builtin_bit_cast(bf16x8, oa); qr[5] = __builtin_bit_cast(bf16x8, ob); }
    const bf16* kn_src = Kn + (rowbase + (tid >> 3)) * 512 + h * 64 + (tid & 7) * 8;
    const bf16* kr_src = Kr + (rowbase + ((tid & 255) >> 2)) * 32 + (tid & 3) * 8;
    const bf16* v_src = Vt + ((size_t)(b * 8 + h) * 64 + (tid >> 3)) * TP + (tid & 7) * 8;
    const int kn_dst = (tid & 7) * 1024 + (((tid >> 3) ^ (tid & 7)) << 4);
    const int kr_dst = (8 + (tid & 3)) * 1024 + ((((tid & 255) >> 2) ^ (tid & 3)) << 4);
    const int v_dst = OFF_V + (tid & 7) * 1024 + (((tid >> 3) ^ (tid & 7)) << 4);
    int kaddr[6], vaddr[4];
#pragma unroll
    for (int d0 = 0; d0 < 6; ++d0) kaddr[d0] = (int)(unsigned)(uintptr_t)lds + (2 * d0 + hi) * 1024 + ((r32 ^ ((2 * d0 + hi) & 7)) << 4);
#pragma unroll
    for (int ks = 0; ks < 4; ++ks) vaddr[ks] = (int)(unsigned)(uintptr_t)lds + OFF_V + (2 * ks + hi) * 1024 + ((r32 ^ (2 * ks + hi)) << 4);
    v4u kA, krA = (v4u){0u, 0u, 0u, 0u}, vA;
#define ATT_LOADK(kt, K_, KR_) do { K_ = *(const GAS v4u*)(kn_src + (size_t)(kt) * 64 * 512); if (wid < 4) KR_ = *(const GAS v4u*)(kr_src + (size_t)(kt) * 64 * 32); } while (0)
#define ATT_LOADV(kt, V_) do { V_ = *(const GAS v4u*)(v_src + (size_t)(kt) * 64); } while (0)
#define ATT_STOREK(slot, K_, KR_) do { *(LAS v4u*)(lds + (slot) * KB + kn_dst) = K_; if (wid < 4) *(LAS v4u*)(lds + (slot) * KB + kr_dst) = KR_; } while (0)
#define ATT_STOREV(slot, V_) do { *(LAS v4u*)(lds + (slot) * VB + v_dst) = V_; } while (0)
    LAS float* wsf = (LAS float*)(lds + OFF_WS + wid * 256);
    const bool skew = wid >= 4;
    bf16x8 pw[4];
    float mrow = 0.f, lsum = 0.f;
    f32x16 o0, o1, negm, p0, p1;
#pragma unroll
    for (int r = 0; r < 16; ++r) { o0[r] = 0.f; o1[r] = 0.f; negm[r] = 0.f; p0[r] = 0.f; p1[r] = 0.f; }
#define ATT_PV(VOFF) do { \
        _Pragma("unroll") for (int ks = 0; ks < 4; ++ks) { \
            const bf16x8 v0 = *(const LAS bf16x8*)(unsigned)(vaddr[ks] + (VOFF)), v1 = *(const LAS bf16x8*)(unsigned)(vaddr[ks] + (VOFF) + 512); \
            o0 = __builtin_amdgcn_mfma_f32_32x32x16_bf16(pw[ks], v0, o0, 0, 0, 0); \
            o1 = __builtin_amdgcn_mfma_f32_32x32x16_bf16(pw[ks], v1, o1, 0, 0, 0); } } while (0)
#define ATT_QK(KOFF) do { \
        _Pragma("unroll") for (int d0 = 0; d0 < 6; ++d0) { \
            const bf16x8 a0 = *(const LAS bf16x8*)(unsigned)(kaddr[d0] + (KOFF)), a1 = *(const LAS bf16x8*)(unsigned)(kaddr[d0] + (KOFF) + 512); \
            p0 = __builtin_amdgcn_mfma_f32_32x32x16_bf16(a0, qr[d0], d0 == 0 ? negm : p0, 0, 0, 0); \
            p1 = __builtin_amdgcn_mfma_f32_32x32x16_bf16(a1, qr[d0], d0 == 0 ? negm : p1, 0, 0, 0); } } while (0)
    auto softmax_tile = [&](const int kt) __attribute__((always_inline)) {
        if (64 * kt + 63 > q0w) {
            const int q = q0w + r32, kbase = 64 * kt + 4 * hi;
#pragma unroll
            for (int r = 0; r < 16; ++r) { const int key = kbase + (r & 3) + 8 * (r >> 2); if (key > q) p0[r] = -1e30f; if (key + 32 > q) p1[r] = -1e30f; }
        }
        float mxa = max3f(p0[0], p0[1], p1[0]), mxb = max3f(p0[2], p0[3], p1[1]); mxa = max3f(mxa, p1[2], p1[3]);
#pragma unroll
        for (int r = 4; r < 16; r += 4) { mxa = max3f(mxa, p0[r], p0[r + 1]); mxb = max3f(mxb, p0[r + 2], p0[r + 3]); mxa = max3f(mxa, p1[r], p1[r + 1]); mxb = max3f(mxb, p1[r + 2], p1[r + 3]); }
        float mx = fmaxf(mxa, mxb);
        mx = fmaxf(mx, __shfl_xor(mx, 32));
        if (kt == 0 || __any(mx > 8.0f)) {
            const float dl = (kt == 0) ? mx : fmaxf(mx, 0.f), alpha = __builtin_amdgcn_exp2f(-dl);
            mrow += dl; lsum *= alpha;
#pragma unroll
            for (int r = 0; r < 16; ++r) { p0[r] -= dl; p1[r] -= dl; negm[r] = -mrow; }
            if (hi == 0) wsf[r32] = alpha;
            LDS_WAIT();
#pragma unroll
            for (int i = 0; i < 4; ++i) { const f32x4 a = *(const LAS f32x4*)(wsf + 8 * i + 4 * hi);
#pragma unroll
                for (int j = 0; j < 4; ++j) { o0[4 * i + j] *= a[j]; o1[4 * i + j] *= a[j]; } }
        }
        float s = 0.f;
#pragma unroll
        for (int r = 0; r < 16; ++r) { p0[r] = __builtin_amdgcn_exp2f(p0[r]); p1[r] = __builtin_amdgcn_exp2f(p1[r]); s += p0[r] + p1[r]; }
        lsum += s;
#pragma unroll
        for (int ks = 0; ks < 4; ++ks) { v4u w;
            if (ks < 2) { w.x = pk2(p0[8 * ks + 0], p0[8 * ks + 1]); w.y = pk2(p0[8 * ks + 2], p0[8 * ks + 3]); w.z = pk2(p0[8 * ks + 4], p0[8 * ks + 5]); w.w = pk2(p0[8 * ks + 6], p0[8 * ks + 7]); }
            else { const int k2 = ks - 2; w.x = pk2(p1[8 * k2 + 0], p1[8 * k2 + 1]); w.y = pk2(p1[8 * k2 + 2], p1[8 * k2 + 3]); w.z = pk2(p1[8 * k2 + 4], p1[8 * k2 + 5]); w.w = pk2(p1[8 * k2 + 6], p1[8 * k2 + 7]); }
            pw[ks] = __builtin_bit_cast(bf16x8, w); }
    };
    ATT_LOADK(0, kA, krA); ATT_LOADV(0, vA); ATT_STOREK(0, kA, krA); ATT_STOREV(0, vA);
    if (NT > 1) { ATT_LOADK(1, kA, krA); ATT_STOREK(1, kA, krA); }
    __syncthreads();
    if (!skew && 0 < ntw) ATT_QK(0);
    int s0 = 0, s1 = 1, s2 = 2;
#define ATT_STEP(COMPUTE) do { \
        if (kt + 2 < NT) ATT_LOADK(kt + 2, kA, krA); if (kt + 1 < NT) ATT_LOADV(kt + 1, vA); \
        COMPUTE; \
        if (kt + 2 < NT) ATT_STOREK(s2, kA, krA); if (kt + 1 < NT) ATT_STOREV(s1, vA); \
        { const int t_ = s0; s0 = s1; s1 = s2; s2 = t_; } \
        asm volatile("s_waitcnt lgkmcnt(0)\n\ts_barrier" ::: "memory");   \
    } while (0)
    if (!skew) {
        for (int kt = 0; kt < NT; ++kt) ATT_STEP({ if (kt < ntw) { softmax_tile(kt); ATT_PV(s0 * VB); } if (kt + 1 < ntw) ATT_QK(s1 * KB); });
    } else {
        for (int kt = 0; kt < NT; ++kt) ATT_STEP({ if (kt >= 1 && kt - 1 < ntw) ATT_PV(s2 * VB); if (kt < ntw) { ATT_QK(s0 * KB); softmax_tile(kt); } });
    }
#undef ATT_STEP
    if (skew && NT - 1 < ntw) ATT_PV(((NT - 1) % 3) * VB);
#undef ATT_PV
#undef ATT_QK
    if (ntw > 0) {
        lsum += __shfl_xor(lsum, 32);
        if (hi == 0) wsf[32 + r32] = 1.0f / lsum;
        LDS_WAIT();
        bf16* yp = Y + (rowbase + q0w) * 512 + h * 64 + r32;
#pragma unroll
        for (int i = 0; i < 4; ++i) { const f32x4 a = *(const LAS f32x4*)(wsf + 32 + 8 * i + 4 * hi);
#pragma unroll
            for (int j = 0; j < 4; ++j) { const int r = 4 * i + j, q = crow(r, hi);
                if (q0w + q < T) { const unsigned w = pk2(o0[r] * a[j], o1[r] * a[j]); ((GAS bf16*)yp)[(size_t)q * 512] = (bf16)(w & 0xffffu); ((GAS bf16*)yp)[(size_t)q * 512 + 32] = (bf16)(w >> 16); } } }
        LDS_WAIT();
    }
#undef ATT_LOADK
#undef ATT_LOADV
#undef ATT_STOREK
#undef ATT_STOREV
}
}

#ifdef PROBE_SYS_SCOPE
#define XB_SCOPE ""
#else
#define XB_SCOPE "agent"
#endif
#define XB_TMO      128
#define XB_XCNT(j)  (256  + 64 * (j))
#define XB_XSUB(j)  (1280 + 64 * (j))
#define XB_XGEN(j)  (2304 + 64 * (j))
#define XB_TOP      3328
#define XB_TOPGEN   3392
#define XCD_BAR_WORDS 3456
#define XB_SPIN_CAP (1u << 18)

__device__ __forceinline__ unsigned xb_ld(unsigned* p)              { return __hip_atomic_load(p, __ATOMIC_RELAXED, __HIP_MEMORY_SCOPE_AGENT); }
__device__ __forceinline__ unsigned xb_add(unsigned* p, unsigned v) { return __hip_atomic_fetch_add(p, v, __ATOMIC_RELAXED, __HIP_MEMORY_SCOPE_AGENT); }
__device__ __forceinline__ unsigned xb_xcc_id() { return (unsigned)__builtin_amdgcn_s_getreg((3 << 11) | 20) & 0xFu; }
#define XB_SPIN(cond, bar) do { unsigned _sp = 0; while (cond) { __builtin_amdgcn_s_sleep(1); \
    if ((++_sp & 255u) == 0u) { if (xb_ld(&(bar)[XB_TMO])) break; if (_sp > XB_SPIN_CAP) { atomicAdd(&(bar)[XB_TMO], 1u); break; } } } } while (0)

struct XcdBarrier {
    unsigned* bar; unsigned x;
    volatile LAS unsigned* st;
};

__device__ __forceinline__ XcdBarrier xcd_barrier_post(unsigned* bar, volatile LAS unsigned* st) {
    XcdBarrier b; b.bar = bar; b.x = xb_xcc_id(); b.st = st;
    if (threadIdx.x == 0) (void)xb_add(&bar[XB_XCNT(b.x)], 1u);
    return b;
}
__device__ __forceinline__ void xcd_barrier_complete(unsigned* bar, unsigned x, unsigned& nloc, unsigned& nx) {
    const unsigned G = gridDim.x * gridDim.y * gridDim.z;
    unsigned sum, cnt, mine, sp = 0u;
    for (;;) {
        sum = 0u; cnt = 0u; mine = 0u;
#pragma unroll
        for (unsigned j = 0; j < 16; ++j) { const unsigned c = xb_ld(&bar[XB_XCNT(j)]); sum += c; cnt += (c > 0u) ? 1u : 0u; mine = (j == x) ? c : mine; }
        if (sum == G) break;
        __builtin_amdgcn_s_sleep(1);
        if ((++sp & 255u) == 0u) { if (xb_ld(&bar[XB_TMO])) break; if (sp > XB_SPIN_CAP) { atomicAdd(&bar[XB_TMO], 1u); break; } }
    }
    nloc = mine > 0u ? mine : 1u; nx = cnt > 0u ? cnt : 1u;
}

__device__ __forceinline__ void xcd_barrier(const XcdBarrier& b) {
    asm volatile("s_waitcnt vmcnt(0)" ::: "memory");
    __syncthreads();
    if (threadIdx.x == 0) {
        unsigned* bar = b.bar;
        __builtin_amdgcn_s_waitcnt(0);
        unsigned nloc = b.st[0], nx = b.st[1];
        if (nloc == 0u) { xcd_barrier_complete(bar, b.x, nloc, nx); b.st[0] = nloc; b.st[1] = nx; }
        const unsigned old = xb_add(&bar[XB_XSUB(b.x)], 1u);
        const unsigned gen = old / nloc;
        if (old + 1u == (gen + 1u) * nloc) {
            __builtin_amdgcn_fence(__ATOMIC_RELEASE, XB_SCOPE);
            asm volatile("s_waitcnt vmcnt(0)" ::: "memory");
            const unsigned og = xb_add(&bar[XB_TOP], 1u);
            const unsigned tg = og / nx;
            if (og + 1u == (tg + 1u) * nx) xb_add(&bar[XB_TOPGEN], 1u);
            else XB_SPIN(xb_ld(&bar[XB_TOPGEN]) == tg, bar);
            __builtin_amdgcn_fence(__ATOMIC_ACQUIRE, XB_SCOPE);
            xb_add(&bar[XB_XGEN(b.x)], 1u);
            asm volatile("s_waitcnt vmcnt(0)" ::: "memory");
        } else {
            XB_SPIN(xb_ld(&bar[XB_XGEN(b.x)]) == gen, bar);
            __builtin_amdgcn_fence(__ATOMIC_ACQUIRE, XB_SCOPE);
            asm volatile("s_waitcnt vmcnt(0)" ::: "memory");
        }
    }
    __syncthreads();
}

struct Args { const float* in[18]; float* out; unsigned char* ws; };
static_assert(sizeof(Args) == 160, "Args layout");

__global__ void __launch_bounds__(NWAVES * 64, 2) mega_fwd(Args args) {
    extern __shared__ __attribute__((aligned(16))) unsigned char lds_raw[];
    cg::grid_group grid = cg::this_grid();
    LAS unsigned char* lds = (LAS unsigned char*)lds_raw;
    int tid = threadIdx.x, lane = tid & 63; const int wave = __builtin_amdgcn_readfirstlane(tid >> 6);
#ifdef PROBE_SYNC_TWICE
#define GRID_SYNC() do { XcdBarrier xb_; xb_.bar = ctl + 4096; xb_.x = xb_xcc_id(); xb_.st = (volatile LAS unsigned*)(lds + LDS_MISC) + 8; xcd_barrier(xb_); xcd_barrier(xb_); REBASE(); } while (0)
#else
#define GRID_SYNC() do { XcdBarrier xb_; xb_.bar = ctl + 4096; xb_.x = xb_xcc_id(); xb_.st = (volatile LAS unsigned*)(lds + LDS_MISC) + 8; xcd_barrier(xb_); REBASE(); } while (0)
#endif
#define OPQ() do { asm volatile("" : "+v"(tid)); lane = tid & 63; } while (0)
    const int G = gridDim.x, blk = blockIdx.x;
    const int gw = blk * NWAVES + wave, ngw = G * NWAVES;
    const unsigned char* ka = (const unsigned char*)__builtin_amdgcn_kernarg_segment_ptr();
    GAS unsigned char* ws = (GAS unsigned char*)args.ws;
#define REBASE() do { asm volatile("" : "+s"(ka)); asm volatile("" : "+s"(ws)); } while (0)
#define INP(i) ((const float*)(const GAS float*)(*(const float* const*)(ka + 8 * (i))))
#define X_IN INP(0)
#define meta INP(1)
#define ffn1_up INP(2)
#define ffn1_down INP(3)
#define w_in INP(4)
#define b_gate INP(5)
#define conv_w INP(6)
#define q_norm_g INP(7)
#define w_uq INP(8)
#define kv_norm_g INP(9)
#define w_ukv INP(10)
#define w_br_conv INP(11)
#define w_br_mla INP(12)
#define w_o INP(13)
#define ffn2_up INP(14)
#define ffn2_down INP(15)
#define ln_g INP(16)
#define ln_b INP(17)
#define OUTP ((float*)(GAS float*)(*(float* const*)(ka + 144)))
#define ctl ((unsigned*)(ws + OFF_CTL))
#define rope ((float*)(ws + OFF_ROPE))
#define lnstats ((float*)(ws + OFF_STATS))
#define lnident ((float*)(ws + OFF_STATS + (size_t)MPAD * 8))
#define hf ((float*)(ws + OFF_HF))
#define wreg ((unsigned char*)(ws + OFF_W))
#define hb ((bf16*)(ws + S_HB))
#define act ((bf16*)(ws + S_ACT))
#define gates ((bf16*)(ws + S_GATES))
#define bch ((bf16*)(ws + S_BCH))
#define lat ((float*)(ws + S_LAT))
#define yconv ((bf16*)(ws + S_YCONV))
#define cqn ((bf16*)(ws + S_CQN))
#define ckvn ((bf16*)(ws + S_CKVN))
#define krb ((bf16*)(ws + S_KR))
#define Qb ((bf16*)(ws + S_Q))
#define Knb ((bf16*)(ws + S_KN))
#define Vtb ((bf16*)(ws + S_VT))
#define ymla ((bf16*)(ws + S_YMLA))
#define merged ((bf16*)(ws + S_MERGED))
    LAS float* scr = (LAS float*)(lds + wave * 16384);
    LAS unsigned char* ring = lds;
    if (threadIdx.x < 64) ((LAS unsigned*)(lds + LDS_MISC))[threadIdx.x] = 0u;
    __syncthreads();
    (void)xcd_barrier_post(ctl + 4096, (volatile LAS unsigned*)(lds + LDS_MISC) + 8);
    grid.sync();

#ifdef PROBE_DUMP_BIAS
    OPQ();
    for (int row = gw; row < BATCH * SEQ; row += ngw) { float* o = OUTP + (size_t)row * 1024; for (int c = lane; c < 1024; c += 64) o[c] = b_gate[c] + 2.0f * b_gate[1024 + c] + 4.0f * b_gate[2048 + c] + 8.0f * b_gate[3072 + c]; }
    return;
#endif
    OPQ();
    { auto p0_load = [&](int row) __attribute__((always_inline)) { LnRow rr;
          if (row < M) { const int b = row / T, t = row - b * T; rr = ln_load(t < N_META ? meta + (size_t)t * 1024 : X_IN + ((size_t)b * SEQ + (t - N_META)) * 1024, lane); }
          else {
#pragma unroll
              for (int j = 0; j < 4; ++j) rr.v[j] = (f32x4){0.f, 0.f, 0.f, 0.f}; }
          return rr; };
      LnRow cur = p0_load(gw);
      for (int row = gw; row < MPAD; row += ngw) { const LnRow nxt = p0_load(row + ngw < MPAD ? row + ngw : row);
#pragma unroll
          for (int j = 0; j < 4; ++j) { const f32x4 v = cur.v[j]; ((f32x4*)(hf + (size_t)row * 1024))[lane + 64 * j] = v; v2u w; w.x = pk2(v.x, v.y); w.y = pk2(v.z, v.w); ((v2u*)(hb + (size_t)row * 1024))[lane + 64 * j] = w; }
          cur = nxt; } }
    for (int i = blk * 512 + tid; i < MPAD; i += G * 512) { lnstats[2 * i] = 0.f; lnstats[2 * i + 1] = 1.f; }
    for (int i = blk * 512 + tid; i < 2048; i += G * 512) lnident[i] = i < 1024 ? 1.f : 0.f;
    for (int i = blk * 512 + tid; i < T * 16; i += G * 512) { const int t = i >> 4, k = i & 15;
        const float inv_freq = inv_freq_of(k); const float ang = (float)t * inv_freq;
        const double rev = (double)ang * 0.15915494309189535; const float fr = (float)(rev - floor(rev));
        rope[t * 32 + k] = __builtin_amdgcn_cosf(fr); rope[t * 32 + 16 + k] = __builtin_amdgcn_sinf(fr); }
    convert_ffn(ffn1_up, ffn1_down, wreg, scr, gw, ngw, lane);
    GRID_SYNC();

    for (int step = 0; step < 3 * DEPTH; ++step) {
        const int l = step / 3, sub = step % 3;
#ifdef PROBE_STEPS
        if (step == PROBE_STEPS) {
            OPQ();
            for (int row = gw; row < M; row += ngw) { const int b = row / T, t = row - b * T; if (t >= N_META) {
#pragma unroll
                for (int j = 0; j < 4; ++j) ((f32x4*)(OUTP + ((size_t)b * SEQ + (t - N_META)) * 1024))[lane + 64 * j] = ((const f32x4*)(hf + (size_t)row * 1024))[lane + 64 * j]; } }
            return;
        }
#endif
        if (sub != 1) {
            { const int c0 = blk * 16, tl = c0 >> 7, j0 = c0 & 127; const int brow[2] = {256 * tl + j0, 256 * tl + 128 + j0};
              tail_gemm_nb<2>(hb + (size_t)MMAIN * 1024, (const bf16*)(wreg + W_UP), 1024, blk, D_FF / 16, brow, lds, TailSwiGLU{act + (size_t)MMAIN * D_FF, c0}); }
#ifdef PROBE_UP_TWICE
            for (int rep_ = 0; rep_ < 2; ++rep_)
#endif
            { pg8::Gemm g{hb, (const bf16*)(wreg + W_UP), MMAIN, 2 * D_FF, 1024}; pg8::StaticOrder S; S.init(MMAIN, 2 * D_FF, G, blk);
              pg8::EpiSwiGLU E{act, D_FF};
              pg8::gemm_phase<pg8::EpiSwiGLU, pg8::StaticOrder, true, true>(ring, g, S, E); }
            GRID_SYNC();
            const float* pg_ = (step == 0) ? lnident : (sub == 0 ? ln_g + ((size_t)(l - 1) * 3 + 2) * 1024 : ln_g + ((size_t)l * 3 + 1) * 1024);
            const float* pb_ = (step == 0) ? lnident + 1024 : (sub == 0 ? ln_b + ((size_t)(l - 1) * 3 + 2) * 1024 : ln_b + ((size_t)l * 3 + 1) * 1024);
            tail_gemm(act + (size_t)MMAIN * D_FF, (const bf16*)(wreg + W_DOWN), D_FF, blk, lds, TailResid{hf + (size_t)MMAIN * 1024, ALPHA, 0.5f, lnstats + 2 * (size_t)MMAIN, pg_, pb_});
            { pg8::Gemm g{act, (const bf16*)(wreg + W_DOWN), MMAIN, 1024, D_FF}; pg8::StaticOrder S; S.init(MMAIN, 1024, G, blk);
              pg8::EpiResid E{hf, ALPHA, 0.5f, lnstats, pg_, pb_};
              pg8::gemm_phase<pg8::EpiResid, pg8::StaticOrder, true, true>(ring, g, S, E); }
            GRID_SYNC();
            OPQ();
            const int li = (sub == 0) ? 0 : 2; const float* lg = ln_g + ((size_t)l * 3 + li) * 1024; const float* lb = ln_b + ((size_t)l * 3 + li) * 1024;
            const bool final_ln = (step == 3 * DEPTH - 1);
            if (!final_ln) {
                LnRow cur = ln_load(hf + (size_t)gw * 1024, lane);
                for (int row = gw; row < MPAD; row += ngw) { const int nx = row + ngw < MPAD ? row + ngw : row; const LnRow nxt = ln_load(hf + (size_t)nx * 1024, lane);
                    ln_finish(cur, lg, lb, nullptr, hb + (size_t)row * 1024, lane, lnstats + 2 * (size_t)row); cur = nxt; }
            } else {
                LnRow cur = ln_load(hf + (size_t)gw * 1024, lane);
                for (int row = gw; row < M; row += ngw) { const int nx = row + ngw < M ? row + ngw : row; const LnRow nxt = ln_load(hf + (size_t)nx * 1024, lane);
                    const int b = row / T, t = row - b * T; if (t >= N_META) ln_finish(cur, lg, lb, OUTP + ((size_t)b * SEQ + (t - N_META)) * 1024, nullptr, lane); cur = nxt; }
            }
            if (sub == 0) convert_mixer(w_in + (size_t)l * 1024 * D_IN, w_uq + (size_t)l * 256 * 768, w_ukv + (size_t)l * 128 * 1024, w_br_conv + (size_t)l * 512 * 1024, w_br_mla + (size_t)l * 512 * 1024, w_o + (size_t)l * 1024 * 1024, wreg, scr, gw, ngw, lane);
            else if (!final_ln) convert_ffn(ffn1_up + (size_t)(l + 1) * 1024 * 2 * D_FF, ffn1_down + (size_t)(l + 1) * D_FF * 1024, wreg, scr, gw, ngw, lane);
            if (!final_ln) GRID_SYNC();
        } else {
#ifdef PROBE_DUMP_BIAS1
            OPQ();
            for (int row = gw; row < BATCH * SEQ; row += ngw) { float* o = OUTP + (size_t)row * 1024; for (int c = lane; c < 1024; c += 64) o[c] = b_gate[c] + 2.0f * b_gate[1024 + c] + 4.0f * b_gate[2048 + c] + 8.0f * b_gate[3072 + c]; }
            return;
#endif
            { const int brow[1] = {blk * 16};
              tail_gemm_nb<1>(hb + (size_t)MMAIN * 1024, (const bf16*)(wreg + W_IN), 1024, blk, D_INP / 16, brow, lds,
                              TailInProj{bch + (size_t)MMAIN * 1536, lat + (size_t)MMAIN * 512, gates + (size_t)MMAIN * 2048, b_gate + (size_t)l * 2048, blk * 16}); }
            { pg8::Gemm g{hb, (const bf16*)(wreg + W_IN), MMAIN, D_INP, 1024}; pg8::StaticOrder S; S.init(MMAIN, D_INP, G, blk);
              pg8::EpiInProj E{bch, lat, gates, b_gate + (size_t)l * 2048};
              pg8::gemm_phase<pg8::EpiInProj, pg8::StaticOrder, true, true>(ring, g, S, E); }
            GRID_SYNC();
#ifdef PROBE_DUMP_GATES0
            OPQ();
            for (int row = gw; row < M; row += ngw) { const int b = row / T, t = row - b * T; if (t >= N_META) { float* o = OUTP + ((size_t)b * SEQ + (t - N_META)) * 1024;
                for (int c = lane; c < 1024; c += 64) o[c] = pg8::bf_lo(gates[(size_t)row * 2048 + c]) + 2.0f * pg8::bf_lo(gates[(size_t)row * 2048 + 1024 + c]); } }
            return;
#endif
            OPQ();
            { const float* cw = conv_w + (size_t)l * 3 * 512; const float* qg = q_norm_g + (size_t)l * 256; const float* kg = kv_norm_g + (size_t)l * 128;
              struct RpRow { v4u c[3], h[3], bb; f32x4 q; f32x2 kv; float x1, x2; };
              auto rp_load = [&](int row) __attribute__((always_inline)) { RpRow d; const int rr = row < M ? row : M - 1; const int b = rr / T, t = rr - b * T;
#pragma unroll
                  for (int k = 0; k < 3; ++k) { const int dt = 2 - k;
                      if (t - dt >= 0 && row < M) { const bf16* rp = bch + (size_t)(row - dt) * 1536 + 8 * lane; d.c[k] = *(const v4u*)(rp + 512); d.h[k] = *(const v4u*)(rp + 1024); }
                      else { d.c[k] = (v4u){0u, 0u, 0u, 0u}; d.h[k] = (v4u){0u, 0u, 0u, 0u}; } }
                  d.bb = *(const v4u*)(bch + (size_t)row * 1536 + 8 * lane);
                  const float* lr = lat + (size_t)row * 512;
                  d.q = *(const f32x4*)(lr + 4 * lane); d.kv = *(const f32x2*)(lr + 256 + 2 * lane); d.x1 = lr[384 + (lane & 15)]; d.x2 = lr[400 + (lane & 15)];
                  return d; };
              RpRow cur = rp_load(gw);
              for (int row = gw; row < MPAD; row += ngw) {
                const RpRow nxt = rp_load(row + ngw < MPAD ? row + ngw : row);
                const int rr = row < M ? row : M - 1; const int t = rr % T;
                f32x4 ua[2] = {(f32x4){0.f, 0.f, 0.f, 0.f}, (f32x4){0.f, 0.f, 0.f, 0.f}};
#pragma unroll
                for (int k = 0; k < 3; ++k) { const v4u c = cur.c[k], hh = cur.h[k];
                        const f32x4 w0 = *(const f32x4*)(cw + k * 512 + 8 * lane), w1 = *(const f32x4*)(cw + k * 512 + 8 * lane + 4);
                        ua[0][0] += w0[0] * pg8::bf_lo(c.x) * pg8::bf_lo(hh.x); ua[0][1] += w0[1] * pg8::bf_hi(c.x) * pg8::bf_hi(hh.x);
                        ua[0][2] += w0[2] * pg8::bf_lo(c.y) * pg8::bf_lo(hh.y); ua[0][3] += w0[3] * pg8::bf_hi(c.y) * pg8::bf_hi(hh.y);
                        ua[1][0] += w1[0] * pg8::bf_lo(c.z) * pg8::bf_lo(hh.z); ua[1][1] += w1[1] * pg8::bf_hi(c.z) * pg8::bf_hi(hh.z);
                        ua[1][2] += w1[2] * pg8::bf_lo(c.w) * pg8::bf_lo(hh.w); ua[1][3] += w1[3] * pg8::bf_hi(c.w) * pg8::bf_hi(hh.w); }
                { const v4u bb = cur.bb;
                  v4u o; o.x = pk2(ua[0][0] * pg8::bf_lo(bb.x), ua[0][1] * pg8::bf_hi(bb.x)); o.y = pk2(ua[0][2] * pg8::bf_lo(bb.y), ua[0][3] * pg8::bf_hi(bb.y));
                  o.z = pk2(ua[1][0] * pg8::bf_lo(bb.z), ua[1][1] * pg8::bf_hi(bb.z)); o.w = pk2(ua[1][2] * pg8::bf_lo(bb.w), ua[1][3] * pg8::bf_hi(bb.w));
                  *(v4u*)(yconv + (size_t)row * 512 + 8 * lane) = o; }
                { const f32x4 v = cur.q; const float ss = wave_sum((v.x * v.x + v.y * v.y) + (v.z * v.z + v.w * v.w));
                  const float rs = 1.f / sqrtf(ss * (1.f / 256.f) + RMS_EPS); const f32x4 gg = *(const f32x4*)(qg + 4 * lane);
                  v2u w; w.x = pk2(v.x * rs * gg.x, v.y * rs * gg.y); w.y = pk2(v.z * rs * gg.z, v.w * rs * gg.w); *(v2u*)(cqn + (size_t)row * 256 + 4 * lane) = w; }
                { const f32x2 v = cur.kv; const float ss = wave_sum(v.x * v.x + v.y * v.y);
                  const float rs = 1.f / sqrtf(ss * (1.f / 128.f) + RMS_EPS); const f32x2 gg = *(const f32x2*)(kg + 2 * lane);
                  *(unsigned*)(ckvn + (size_t)row * 256 + 2 * lane) = pk2(v.x * rs * gg.x, v.y * rs * gg.y); *(unsigned*)(ckvn + (size_t)row * 256 + 128 + 2 * lane) = 0u; }
                if (lane < 16) { const float x1 = cur.x1, x2 = cur.x2, cs = rope[t * 32 + lane], sn = rope[t * 32 + 16 + lane];
                  const unsigned w = pk2(x1 * cs - x2 * sn, x2 * cs + x1 * sn); krb[(size_t)row * 32 + lane] = (bf16)(w & 0xffffu); krb[(size_t)row * 32 + 16 + lane] = (bf16)(w >> 16); }
                cur = nxt;
              } }
            GRID_SYNC();
#ifdef PROBE_DUMP_GATES
            OPQ();
            for (int row = gw; row < M; row += ngw) { const int b = row / T, t = row - b * T; if (t >= N_META) { float* o = OUTP + ((size_t)b * SEQ + (t - N_META)) * 1024;
                for (int c = lane; c < 1024; c += 64) o[c] = pg8::bf_lo(gates[(size_t)row * 2048 + c]) + 2.0f * pg8::bf_lo(gates[(size_t)row * 2048 + 1024 + c]); } }
            return;
#endif
#ifdef PROBE_DUMP_ROWPREP
            OPQ();
            for (int row = gw; row < M; row += ngw) { const int b = row / T, t = row - b * T; if (t >= N_META) { float* o = OUTP + ((size_t)b * SEQ + (t - N_META)) * 1024;
                for (int c = lane; c < 1024; c += 64) { float v = 0.f;
                    if (c < 512) v = pg8::bf_lo(yconv[(size_t)row * 512 + c]); else if (c < 768) v = pg8::bf_lo(cqn[(size_t)row * 256 + c - 512]); else if (c < 896) v = pg8::bf_lo(ckvn[(size_t)row * 256 + c - 768]); else if (c < 928) v = pg8::bf_lo(krb[(size_t)row * 32 + c - 896]);
                    else if (c < 960) v = lat[(size_t)row * 512 + 384 + c - 928];
                    o[c] = v; } } }
            return;
#endif
            OPQ();
            for (int i = blk * 512 + tid; i < BATCH * NHEAD * 64 * (TP - T); i += G * 512) { const int r = i / (TP - T), c = i % (TP - T); Vtb[(size_t)r * TP + T + c] = 0; }
            { pg8::Gemm g{cqn, (const bf16*)(wreg + W_UQ), MPAD, 768, 256}; pg8::StaticOrder S; S.init(MPAD, 768, G, blk);
              pg8::EpiPlain E{Qb, 768, QSCALE};
              pg8::gemm_phase<pg8::EpiPlain, pg8::StaticOrder, true, true>(ring, g, S, E); }
            { pg8::Gemm g{ckvn, (const bf16*)(wreg + W_UKV), MPAD, 512, 256}; pg8::StaticOrder S; S.init(MPAD, 512, G, blk);
              pg8::EpiPlain E{Knb, 512, 1.0f};
              pg8::gemm_phase<pg8::EpiPlain, pg8::StaticOrder, true, true>(ring, g, S, E); }
            { pg8::Gemm g{(const bf16*)(wreg + W_UKV) + 512 * 256, ckvn, 512, MPAD, 256}; pg8::StaticOrder S; S.init(512, MPAD, G, blk);
              pg8::EpiVt E{Vtb};
              pg8::gemm_phase<pg8::EpiVt, pg8::StaticOrder, true, true>(ring, g, S, E); }
            GRID_SYNC();
            OPQ();
#ifdef PROBE_NOATTN
            for (size_t i = (size_t)blk * 512 + tid; i < (size_t)MPAD * 512 / 8; i += (size_t)G * 512) ((v4u*)ymla)[i] = (v4u){0u, 0u, 0u, 0u};
            if (false)
#endif
#ifdef PROBE_ATTN_TWICE
            for (int rep = 0; rep < 2; ++rep)
            { const int grp = blk & 7; unsigned* qctr = ctl + 64 * (rep * 16 + l * 8 + grp);
#else
            { const int grp = blk & 7; unsigned* qctr = ctl + 64 * (l * 8 + grp);
#endif
              volatile LAS unsigned* bc = (volatile LAS unsigned*)(lds + LDS_MISC);
              for (;;) {
                  if (tid == 0) bc[0] = atomicAdd(qctr, 1u);
                  __syncthreads();
                  const unsigned u = bc[0];
                  __syncthreads();
                  if (u >= 132u) break;
                  const int qb = 32 - (int)(u >> 2), bh = grp * 4 + (int)(u & 3u);
                  att::attn_unit(bh >> 3, bh & 7, qb, Qb, Knb, krb, Vtb, rope, ymla, lds);
              } }
            GRID_SYNC();
            tail_gemm(yconv + (size_t)MMAIN * 512, (const bf16*)(wreg + W_BC), 512, blk, lds, TailGate<false>{merged + (size_t)MMAIN * 1024, gates + (size_t)MMAIN * 2048});
            tail_gemm(ymla + (size_t)MMAIN * 512, (const bf16*)(wreg + W_BM), 512, blk, lds, TailGate<true>{merged + (size_t)MMAIN * 1024, gates + (size_t)MMAIN * 2048 + 1024});
            { pg8::Gemm g{yconv, (const bf16*)(wreg + W_BC), MMAIN, 1024, 512}; pg8::StaticOrder S; S.init(MMAIN, 1024, G, blk);
              pg8::EpiGate<false> E{merged, gates};
              pg8::gemm_phase<pg8::EpiGate<false>, pg8::StaticOrder, true, true>(ring, g, S, E); }
#ifdef PROBE_SYNC_BETWEEN
            GRID_SYNC();
#endif
#ifndef PROBE_SKIP_BR2
            { pg8::Gemm g{ymla, (const bf16*)(wreg + W_BM), MMAIN, 1024, 512}; pg8::StaticOrder S; S.init(MMAIN, 1024, G, blk);
              pg8::EpiGate<true> E{merged, gates + 1024};
              pg8::gemm_phase<pg8::EpiGate<true>, pg8::StaticOrder, true, true>(ring, g, S, E); }
#endif
            GRID_SYNC();
#ifdef PROBE_DUMP_MERGED
            OPQ();
            for (int row = gw; row < M; row += ngw) { const int b = row / T, t = row - b * T; if (t >= N_META) { float* o = OUTP + ((size_t)b * SEQ + (t - N_META)) * 1024;
                for (int c = lane; c < 1024; c += 64) o[c] = pg8::bf_lo(merged[(size_t)row * 1024 + c]); } }
            return;
#endif
            tail_gemm(merged + (size_t)MMAIN * 1024, (const bf16*)(wreg + W_O), 1024, blk, lds, TailResid{hf + (size_t)MMAIN * 1024, ALPHA, 1.0f, lnstats + 2 * (size_t)MMAIN, ln_g + ((size_t)l * 3 + 0) * 1024, ln_b + ((size_t)l * 3 + 0) * 1024});
            { pg8::Gemm g{merged, (const bf16*)(wreg + W_O), MMAIN, 1024, 1024}; pg8::StaticOrder S; S.init(MMAIN, 1024, G, blk);
              pg8::EpiResid E{hf, ALPHA, 1.0f, lnstats, ln_g + ((size_t)l * 3 + 0) * 1024, ln_b + ((size_t)l * 3 + 0) * 1024};
              pg8::gemm_phase<pg8::EpiResid, pg8::StaticOrder, true, true>(ring, g, S, E); }
            GRID_SYNC();
            OPQ();
            { const float* lg = ln_g + ((size_t)l * 3 + 1) * 1024; const float* lb = ln_b + ((size_t)l * 3 + 1) * 1024;
              LnRow cur = ln_load(hf + (size_t)gw * 1024, lane);
              for (int row = gw; row < MPAD; row += ngw) { const int nx = row + ngw < MPAD ? row + ngw : row; const LnRow nxt = ln_load(hf + (size_t)nx * 1024, lane);
                  ln_finish(cur, lg, lb, nullptr, hb + (size_t)row * 1024, lane, lnstats + 2 * (size_t)row); cur = nxt; }
              convert_ffn(ffn2_up + (size_t)l * 1024 * 2 * D_FF, ffn2_down + (size_t)l * D_FF * 1024, wreg, scr, gw, ngw, lane); }
            GRID_SYNC();
        }
    }
}

extern "C" void kernel_launch(void* const* d_in, const int* in_sizes, int n_in, void* d_out, int out_size, void* d_ws, size_t ws_size, hipStream_t stream) {
    static int grid = 0;
    if (grid == 0) {
        if (n_in != 18 || ws_size < WS_NEED) { fprintf(stderr, "kernel_launch: expected 18 inputs and >= %zu bytes of workspace; got %d, %zu\n", (size_t)WS_NEED, n_in, ws_size); grid = -1; return; }
        int dev = 0, cus = 0, per_cu = 0;
        hipGetDevice(&dev); hipDeviceGetAttribute(&cus, hipDeviceAttributeMultiprocessorCount, dev);
        if (hipFuncSetAttribute((const void*)mega_fwd, hipFuncAttributeMaxDynamicSharedMemorySize, LDS_BYTES) != hipSuccess) { fprintf(stderr, "kernel_launch: hipFuncSetAttribute failed\n"); grid = -1; return; }
        hipOccupancyMaxActiveBlocksPerMultiprocessor(&per_cu, (const void*)mega_fwd, NWAVES * 64, LDS_BYTES);
        (void)hipGetLastError();
        if (per_cu < 1) per_cu = 1;
        grid = cus;
    }
    if (grid < 0) return;
    (void)hipMemsetAsync((char*)d_ws + OFF_CTL, 0, 65536, stream);
    Args a{};
    for (int i = 0; i < 18; ++i) a.in[i] = (const float*)d_in[i];
    a.out = (float*)d_out; a.ws = (unsigned char*)d_ws;
    void* params[] = {&a};
    hipError_t e = hipLaunchCooperativeKernel((const void*)mega_fwd, dim3(grid), dim3(NWAVES * 64), params, LDS_BYTES, stream);
    if (e != hipSuccess) fprintf(stderr, "cooperative launch failed: %s (grid %d)\n", hipGetErrorString(e), grid);
}
```

```cpp
#include <hip/hip_runtime.h>
#include <cstdio>
#include <cstdint>
namespace pg8 {
#define PG8_LAS __attribute__((address_space(3)))
typedef unsigned short bf16_t;
typedef short bf16x8 __attribute__((ext_vector_type(8)));
typedef float f32x4 __attribute__((ext_vector_type(4)));
typedef unsigned u32x4 __attribute__((ext_vector_type(4)));
constexpr int BM = 256, BK = 64, HALF = 128, HTB = HALF * BK * 2  , STAGE_BYTES = 8 * HTB, NXCD = 8, WGM = 8;

__host__ __device__ __forceinline__ int lds_byte(int r, int c) { const int st = (r >> 4) * 2 + (c >> 5), rr = r & 15, cc = c & 31, ob = rr * 64 + cc * 2; return st * 1024 + (ob ^ (((ob >> 9) & 1) << 5)); }
__host__ __device__ __forceinline__ void stage_rc(int b, int& R, int& C) { const int st = b / 1024, sb = b % 1024, swz = sb ^ (((sb >> 9) & 1) << 5); R = (st >> 1) * 16 + swz / 64; C = (st & 1) * 32 + (swz % 64) / 2; }
__host__ __device__ __forceinline__ int perm32(int rho) { const int n = rho >> 4, i = rho & 15; return 8 * (i >> 2) + 4 * n + (i & 3); }

struct Unit { int pm, pn; };
struct Gemm { const bf16_t* A; const bf16_t* Bt; int M, N, K; };

struct StaticOrder {
    int nM, nN, nwg, G, c;
    __host__ __device__ void init(int M, int N, int G_, int c_) { nM = M / BM; nN = N / BM; nwg = nM * nN; G = G_; c = c_; }
    __host__ __device__ bool next(int i, Unit& u) const {
        const long L = (long)i * G + c; if (L >= nwg) return false;
        int wgid = (int)L; { const int q = nwg / NXCD, r = nwg % NXCD, xcd = wgid % NXCD, off = wgid / NXCD; wgid = (xcd < r ? xcd * (q + 1) : r * (q + 1) + (xcd - r) * q) + off; }
        const int nig = WGM * nN, gid = wgid / nig, fm = gid * WGM, gsz = (nM - fm) < WGM ? (nM - fm) : WGM;
        u.pm = fm + ((wgid % nig) % gsz); u.pn = (wgid % nig) / gsz; return true;
    }
    __device__ __forceinline__ void a_ready(const Unit&) const {}
    __device__ __forceinline__ void done(const Unit&) const {}
};

struct SignalOrder : StaticOrder {
    unsigned* tot_main; unsigned* tot_tail;
    __device__ __forceinline__ void done(const Unit& u) const {
        asm volatile("s_waitcnt vmcnt(0)" ::: "memory");
        if ((threadIdx.x & 63) == 0) __hip_atomic_fetch_add(u.pm < 128 ? tot_main : tot_tail, 1u, __ATOMIC_RELAXED, __HIP_MEMORY_SCOPE_AGENT);
    }
};
typedef float f32x2 __attribute__((ext_vector_type(2)));
typedef __bf16 bf16x2_cv __attribute__((ext_vector_type(2)));
__device__ __forceinline__ unsigned cvt_pk_bf16(float lo, float hi) { f32x2 v = {lo, hi}; bf16x2_cv b = __builtin_convertvector(v, bf16x2_cv); return __builtin_bit_cast(unsigned, b); }
__device__ __forceinline__ float fast_sigmoid(float x) { return __builtin_amdgcn_rcpf(1.0f + __builtin_amdgcn_exp2f(-1.4426950408889634f * x)); }
__device__ __forceinline__ u32x4 pack8(const f32x4 a, const f32x4 b) { u32x4 w; w.x = cvt_pk_bf16(a[0], a[1]); w.y = cvt_pk_bf16(a[2], a[3]); w.z = cvt_pk_bf16(b[0], b[1]); w.w = cvt_pk_bf16(b[2], b[3]); return w; }
typedef unsigned u32x2 __attribute__((ext_vector_type(2)));
__device__ __forceinline__ float bf_lo(unsigned w) { return __uint_as_float(w << 16); }
__device__ __forceinline__ float bf_hi(unsigned w) { return __uint_as_float(w & 0xffff0000u); }

struct EpiSwiGLU {
    static constexpr bool PERM = true, AFTER_DRAIN = false;
    bf16_t* O; int ldc;
    __device__ __forceinline__ void operator()(const f32x4 (&acc)[2][2][4][2], const Unit& u, int wr, int wc, int fr, int fq) const {
        const int row0 = u.pm * BM + wr * 64 + fr; const int col0 = u.pn * 128 + wc * 32 + 8 * fq;
#pragma unroll
        for (int ai = 0; ai < 2; ++ai)
#pragma unroll
            for (int m = 0; m < 4; ++m) {
                f32x4 v[2];
#pragma unroll
                for (int n = 0; n < 2; ++n) { const f32x4 g = acc[ai][0][m][n], up = acc[ai][1][m][n];
#pragma unroll
                    for (int j = 0; j < 4; ++j) v[n][j] = g[j] * fast_sigmoid(g[j]) * up[j]; }
                *(u32x4*)(O + (size_t)(row0 + ai * HALF + m * 16) * ldc + col0) = pack8(v[0], v[1]);
            }
    }
};
__device__ __forceinline__ void st_wt(float* p, const f32x4 v) { asm volatile("global_store_dwordx4 %0, %1, off sc0 sc1" :: "v"(p), "v"(v) : "memory"); }
struct EpiResid {
    static constexpr bool PERM = true, AFTER_DRAIN = false;
    float* H; float alpha, coef;
    const float* stats; const float* g; const float* b;
    __device__ __forceinline__ void operator()(const f32x4 (&acc)[2][2][4][2], const Unit& u, int wr, int wc, int fr, int fq) const {
        const int row0 = u.pm * BM + wr * 64 + fr; const int col0 = u.pn * BM + wc * 32 + 8 * fq;
#pragma unroll
        for (int ai = 0; ai < 2; ++ai)
#pragma unroll
            for (int m = 0; m < 4; ++m) {
                const int row = row0 + ai * HALF + m * 16;
                float* rp = H + (size_t)row * 1024 + col0;
                const f32x2 st = *(const f32x2*)(stats + 2 * (size_t)row);
#pragma unroll
                for (int bj = 0; bj < 2; ++bj) {
                    f32x4 a = *(const f32x4*)(rp + bj * HALF), bb = *(const f32x4*)(rp + bj * HALF + 4);
                    { const f32x4 g0 = *(const f32x4*)(g + col0 + bj * HALF), g1 = *(const f32x4*)(g + col0 + bj * HALF + 4), b0 = *(const f32x4*)(b + col0 + bj * HALF), b1 = *(const f32x4*)(b + col0 + bj * HALF + 4);
                        a = (a - st.x) * st.y * g0 + b0; bb = (bb - st.x) * st.y * g1 + b1; }
                    a = a * alpha + acc[ai][bj][m][0] * coef; bb = bb * alpha + acc[ai][bj][m][1] * coef;
                    *(f32x4*)(rp + bj * HALF) = a; *(f32x4*)(rp + bj * HALF + 4) = bb;
                }
            }
    }
};
struct EpiInProj {
    static constexpr bool PERM = true, AFTER_DRAIN = false;
    bf16_t* bch; float* lat; bf16_t* gates; const float* bgate;
    __device__ __forceinline__ void operator()(const f32x4 (&acc)[2][2][4][2], const Unit& u, int wr, int wc, int fr, int fq) const {
        const int row0 = u.pm * BM + wr * 64 + fr; const int cw = wc * 32 + 8 * fq; const int pn = u.pn;
        if (pn < 6) {
#pragma unroll
            for (int ai = 0; ai < 2; ++ai)
#pragma unroll
                for (int m = 0; m < 4; ++m) { bf16_t* rp = bch + (size_t)(row0 + ai * HALF + m * 16) * 1536 + pn * BM + cw;
#pragma unroll
                    for (int bj = 0; bj < 2; ++bj) *(u32x4*)(rp + bj * HALF) = pack8(acc[ai][bj][m][0], acc[ai][bj][m][1]); }
        } else if (pn < 8) {
#pragma unroll
            for (int ai = 0; ai < 2; ++ai)
#pragma unroll
                for (int m = 0; m < 4; ++m) { float* rp = lat + (size_t)(row0 + ai * HALF + m * 16) * 512 + (pn - 6) * BM + cw;
#pragma unroll
                    for (int bj = 0; bj < 2; ++bj) { *(f32x4*)(rp + bj * HALF) = acc[ai][bj][m][0]; *(f32x4*)(rp + bj * HALF + 4) = acc[ai][bj][m][1]; } }
        } else {
            const int gc = (pn - 8) * BM + cw;
            f32x4 bv[2][2];
#pragma unroll
            for (int bj = 0; bj < 2; ++bj)
#pragma unroll
                for (int n = 0; n < 2; ++n) bv[bj][n] = *(const f32x4*)(bgate + gc + bj * HALF + 4 * n);
#pragma unroll
            for (int ai = 0; ai < 2; ++ai)
#pragma unroll
                for (int m = 0; m < 4; ++m) { bf16_t* rp = gates + (size_t)(row0 + ai * HALF + m * 16) * 2048 + gc;
#pragma unroll
                    for (int bj = 0; bj < 2; ++bj) { f32x4 v[2];
#pragma unroll
                        for (int n = 0; n < 2; ++n) {
#ifdef PROBE_NO_BIAS
                            const f32x4 x = acc[ai][bj][m][n];
#else
                            const f32x4 x = acc[ai][bj][m][n] + bv[bj][n];
#endif
#pragma unroll
                            for (int j = 0; j < 4; ++j) {
#ifdef PROBE_PLAIN_GATES
                                v[n][j] = acc[ai][bj][m][n][j];
#elif defined(PROBE_BV_GATES)
                                v[n][j] = bv[bj][n][j] * 16.0f;
#else
                                v[n][j] = fast_sigmoid(x[j]);
#endif
                            } }
                        *(u32x4*)(rp + bj * HALF) = pack8(v[0], v[1]); } }
        }
    }
};
struct EpiPlain {
    static constexpr bool PERM = true, AFTER_DRAIN = false;
    bf16_t* O; int ldc; float scale;
    __device__ __forceinline__ void operator()(const f32x4 (&acc)[2][2][4][2], const Unit& u, int wr, int wc, int fr, int fq) const {
        const int row0 = u.pm * BM + wr * 64 + fr; const int col0 = u.pn * BM + wc * 32 + 8 * fq;
#pragma unroll
        for (int ai = 0; ai < 2; ++ai)
#pragma unroll
            for (int m = 0; m < 4; ++m) { bf16_t* rp = O + (size_t)(row0 + ai * HALF + m * 16) * ldc + col0;
#pragma unroll
                for (int bj = 0; bj < 2; ++bj) *(u32x4*)(rp + bj * HALF) = pack8(acc[ai][bj][m][0] * scale, acc[ai][bj][m][1] * scale); }
    }
};
struct EpiVt {
    static constexpr bool PERM = false, AFTER_DRAIN = false;
    bf16_t* Vt;
    __device__ __forceinline__ void operator()(const f32x4 (&acc)[2][2][4][2], const Unit& u, int wr, int wc, int fr, int fq) const {
        constexpr int T_ = 8208, TP_ = 8320, M_ = 4 * 8208;
        const int feat0 = u.pm * BM + wr * 64 + fr; const int pos = 8 * (fq & 1) + 4 * (fq >> 1);
#pragma unroll
        for (int bj = 0; bj < 2; ++bj)
#pragma unroll
            for (int n = 0; n < 2; ++n) {
                const int tok0 = u.pn * BM + bj * HALF + wc * 32 + n * 16;
                if (tok0 < M_) {
                    const int b = tok0 / T_, t0 = tok0 - b * T_;
                    bf16_t* vp = Vt + ((size_t)b * 512 + feat0) * TP_ + t0 + pos;
#pragma unroll
                    for (int ai = 0; ai < 2; ++ai)
#pragma unroll
                        for (int m = 0; m < 4; ++m) { const f32x4 x = acc[ai][bj][m][n]; u32x2 w; w.x = cvt_pk_bf16(x[0], x[1]); w.y = cvt_pk_bf16(x[2], x[3]);
                            *(u32x2*)(vp + (size_t)(ai * HALF + m * 16) * TP_) = w; }
                }
            }
    }
};
template <bool ACCUM> struct EpiGate {
    static constexpr bool PERM = true, AFTER_DRAIN = false;
    bf16_t* O; const bf16_t* G;
    __device__ __forceinline__ void operator()(const f32x4 (&acc)[2][2][4][2], const Unit& u, int wr, int wc, int fr, int fq) const {
        const int row0 = u.pm * BM + wr * 64 + fr; const int col0 = u.pn * BM + wc * 32 + 8 * fq;
#pragma unroll
        for (int ai = 0; ai < 2; ++ai)
#pragma unroll
            for (int m = 0; m < 4; ++m) { const size_t row = (size_t)(row0 + ai * HALF + m * 16);
#pragma unroll
                for (int bj = 0; bj < 2; ++bj) {
                    const u32x4 g = *(const u32x4*)(G + row * 2048 + col0 + bj * HALF);
                    f32x4 a = acc[ai][bj][m][0], b = acc[ai][bj][m][1];
                    a[0] *= bf_lo(g.x); a[1] *= bf_hi(g.x); a[2] *= bf_lo(g.y); a[3] *= bf_hi(g.y);
                    b[0] *= bf_lo(g.z); b[1] *= bf_hi(g.z); b[2] *= bf_lo(g.w); b[3] *= bf_hi(g.w);
                    bf16_t* op = O + row * 1024 + col0 + bj * HALF;
                    if (ACCUM) { const u32x4 p = *(const u32x4*)op;
                        a[0] += bf_lo(p.x); a[1] += bf_hi(p.x); a[2] += bf_lo(p.y); a[3] += bf_hi(p.y);
                        b[0] += bf_lo(p.z); b[1] += bf_hi(p.z); b[2] += bf_lo(p.w); b[3] += bf_hi(p.w); }
                    *(u32x4*)op = pack8(a, b);
                }
            }
    }
};

template <class Epi, class Sched, bool ALIGN_EPI = false, bool SP2 = false>
__device__ __forceinline__ void gemm_phase(PG8_LAS unsigned char* lds, const Gemm g, const Sched& S, const Epi& E) {
    int tid_ = threadIdx.x; asm volatile("" : "+v"(tid_));
    const int tid = tid_, wid = __builtin_amdgcn_readfirstlane(tid >> 6), lane = tid & 63, wr = wid >> 2, wc = wid & 3, fr = lane & 15, fq = lane >> 4;
    int K_ = g.K; asm volatile("" : "+s"(K_));
    const int K = K_, nt = K / BK;
    unsigned voffA[2], voffB[2];
#pragma unroll
    for (int i = 0; i < 2; ++i) { int R, C; stage_rc(tid * 16 + i * 8192, R, C); const int Rb = Epi::PERM ? ((R & ~31) + perm32(R & 31)) : R;
        voffA[i] = (unsigned)(R * K + C) * 2u; voffB[i] = (unsigned)(Rb * K + C) * 2u; }
    const size_t kstep = (size_t)(BK * 2);
    const size_t hstep = (size_t)HALF * K * 2;
    const size_t tstep = 2 * hstep;
    const unsigned ldsw = (unsigned)wid * 1024u;
    const int aoff = lds_byte(wr * 64 + fr, fq * 8), boff = lds_byte(wc * 32 + fr, fq * 8);
#define PG8_SA(b, h) (((b) * 2 + (h)) * HTB)
#define PG8_SB(b, h) ((4 + (b) * 2 + (h)) * HTB)
#define PG8_STAGE(bufoff, gbase, voff) do { _Pragma("unroll") for (int _i = 0; _i < 2; ++_i) \
        __builtin_amdgcn_global_load_lds((const unsigned*)((const char*)(gbase) + (voff)[_i]), (PG8_LAS unsigned*)(lds + (bufoff) + ldsw + _i * 8192), 16, 0, 0); } while (0)
#define PG8_LDA(dst, b, h) do { _Pragma("unroll") for (int m = 0; m < 4; ++m) _Pragma("unroll") for (int k = 0; k < 2; ++k) dst[m][k] = *(const PG8_LAS bf16x8*)(lds + PG8_SA(b, h) + aoff + m * 2048 + k * 1024); } while (0)
#define PG8_LDB(dst, b, h) do { _Pragma("unroll") for (int n = 0; n < 2; ++n) _Pragma("unroll") for (int k = 0; k < 2; ++k) dst[n][k] = *(const PG8_LAS bf16x8*)(lds + PG8_SB(b, h) + boff + n * 2048 + k * 1024); } while (0)
#define PG8_MMA(ai, bj, At, Bt) do { __builtin_amdgcn_s_setprio(1); _Pragma("unroll") for (int m = 0; m < 4; ++m) _Pragma("unroll") for (int n = 0; n < 2; ++n) _Pragma("unroll") for (int k = 0; k < 2; ++k) \
        acc[ai][bj][m][n] = __builtin_amdgcn_mfma_f32_16x16x32_bf16(Bt[n][k], At[m][k], acc[ai][bj][m][n], 0, 0, 0); __builtin_amdgcn_s_setprio(0); } while (0)
#define PG8_WAIT_V(n) asm volatile("s_waitcnt vmcnt(" #n ")" ::: "memory")
#define PG8_WAIT_L(n) asm volatile("s_waitcnt lgkmcnt(" #n ")" ::: "memory")
#define PG8_BAR __builtin_amdgcn_s_barrier()
#define PG8_SCHED __builtin_amdgcn_sched_barrier(0)
    Unit cur, nxt; int ui = 0;
    if (!S.next(0, cur)) return;
    f32x4 acc[2][2][4][2];
#pragma unroll
    for (int a = 0; a < 2; ++a)
#pragma unroll
        for (int b = 0; b < 2; ++b)
#pragma unroll
            for (int m = 0; m < 4; ++m)
#pragma unroll
                for (int n = 0; n < 2; ++n) acc[a][b][m][n] = (f32x4){0.f, 0.f, 0.f, 0.f};
    bf16x8 At[4][2], B0[2][2], B1[2][2];
    const char* cA = (const char*)g.A + (size_t)cur.pm * tstep; const char* cB = (const char*)g.Bt + (size_t)cur.pn * tstep;
    S.a_ready(cur);
    if constexpr (SP2) {
        PG8_STAGE(PG8_SB(0, 0), cB, voffB); PG8_STAGE(PG8_SB(0, 1), cB + hstep, voffB); PG8_STAGE(PG8_SA(0, 0), cA, voffA); PG8_STAGE(PG8_SA(0, 1), cA + hstep, voffA);
        if (wr == 1) PG8_BAR;
        PG8_WAIT_V(2); PG8_BAR;
        PG8_STAGE(PG8_SB(1, 0), cB + kstep, voffB); PG8_STAGE(PG8_SA(1, 0), cA + kstep, voffA); PG8_STAGE(PG8_SB(1, 1), cB + hstep + kstep, voffB);
        PG8_WAIT_V(6); PG8_BAR;
    } else {
        PG8_STAGE(PG8_SB(0, 0), cB, voffB); PG8_STAGE(PG8_SA(0, 0), cA, voffA); PG8_STAGE(PG8_SB(0, 1), cB + hstep, voffB); PG8_STAGE(PG8_SA(0, 1), cA + hstep, voffA);
        if (wr == 1) PG8_BAR;
        PG8_WAIT_V(4); PG8_BAR;
        PG8_STAGE(PG8_SB(1, 0), cB + kstep, voffB); PG8_STAGE(PG8_SA(1, 0), cA + kstep, voffA); PG8_STAGE(PG8_SB(1, 1), cB + hstep + kstep, voffB);
        PG8_WAIT_V(6); PG8_BAR;
    }
    for (;;) {
        const bool has_next = S.next(ui + 1, nxt);
        const char* nA = has_next ? (const char*)g.A + (size_t)nxt.pm * tstep : cA; const char* nB = has_next ? (const char*)g.Bt + (size_t)nxt.pn * tstep : cB;
        for (int t = 0; t < nt; t += 2) {
            const bool last = (t == nt - 2);
            const char* a1 = cA + (size_t)(t + 1) * kstep;
            const char* a2 = last ? nA : cA + (size_t)(t + 2) * kstep; const char* b2 = last ? nB : cB + (size_t)(t + 2) * kstep;
            const char* a3 = a2 + kstep; const char* b3 = b2 + kstep;
            if (last && has_next) S.a_ready(nxt);
            if constexpr (SP2) {
            PG8_LDB(B0, 0, 0); PG8_LDB(B1, 0, 1); PG8_SCHED; PG8_LDA(At, 0, 0); PG8_STAGE(PG8_SA(1, 1), a1 + hstep, voffA);
            PG8_WAIT_V(8); PG8_WAIT_L(0); PG8_BAR; PG8_MMA(0, 0, At, B0); PG8_MMA(0, 1, At, B1); PG8_BAR; PG8_SCHED;
            PG8_LDA(At, 0, 1); PG8_STAGE(PG8_SB(0, 0), b2, voffB); PG8_STAGE(PG8_SB(0, 1), b2 + hstep, voffB); PG8_STAGE(PG8_SA(0, 0), a2, voffA);
            PG8_WAIT_V(8); PG8_WAIT_L(0); PG8_BAR; PG8_MMA(1, 0, At, B0); PG8_MMA(1, 1, At, B1); PG8_BAR; PG8_SCHED;
            PG8_LDB(B0, 1, 0); PG8_LDB(B1, 1, 1); PG8_SCHED; PG8_LDA(At, 1, 0); PG8_STAGE(PG8_SA(0, 1), a2 + hstep, voffA);
            PG8_WAIT_V(8); PG8_WAIT_L(0); PG8_BAR; PG8_MMA(0, 0, At, B0); PG8_MMA(0, 1, At, B1); PG8_BAR; PG8_SCHED;
            PG8_LDA(At, 1, 1); PG8_STAGE(PG8_SB(1, 0), b3, voffB); PG8_STAGE(PG8_SB(1, 1), b3 + hstep, voffB); PG8_STAGE(PG8_SA(1, 0), a3, voffA);
            PG8_WAIT_V(8); PG8_WAIT_L(0); PG8_BAR; PG8_MMA(1, 0, At, B0); PG8_MMA(1, 1, At, B1); PG8_BAR; PG8_SCHED;
            } else {
            PG8_LDB(B0, 0, 0); PG8_SCHED; PG8_LDA(At, 0, 0); PG8_STAGE(PG8_SA(1, 1), a1 + hstep, voffA);
            PG8_WAIT_L(8); PG8_BAR; PG8_WAIT_L(0); PG8_MMA(0, 0, At, B0); PG8_BAR; PG8_SCHED;
            PG8_LDB(B1, 0, 1); PG8_STAGE(PG8_SB(0, 0), b2, voffB);
            PG8_BAR; PG8_WAIT_L(0); PG8_MMA(0, 1, At, B1); PG8_BAR;
            PG8_LDA(At, 0, 1); PG8_STAGE(PG8_SA(0, 0), a2, voffA);
            PG8_BAR; PG8_WAIT_L(0); PG8_MMA(1, 0, At, B0); PG8_BAR; PG8_SCHED;
            PG8_STAGE(PG8_SB(0, 1), b2 + hstep, voffB);
            PG8_WAIT_V(6); PG8_BAR; PG8_MMA(1, 1, At, B1); PG8_BAR;
            PG8_LDB(B0, 1, 0); PG8_SCHED; PG8_LDA(At, 1, 0); PG8_STAGE(PG8_SA(0, 1), a2 + hstep, voffA);
            PG8_WAIT_L(8); PG8_BAR; PG8_WAIT_L(0); PG8_MMA(0, 0, At, B0); PG8_BAR; PG8_SCHED;
            PG8_LDB(B1, 1, 1); PG8_STAGE(PG8_SB(1, 0), b3, voffB);
            PG8_BAR; PG8_WAIT_L(0); PG8_MMA(0, 1, At, B1); PG8_BAR;
            PG8_LDA(At, 1, 1); PG8_STAGE(PG8_SA(1, 0), a3, voffA);
            PG8_BAR; PG8_WAIT_L(0); PG8_MMA(1, 0, At, B0); PG8_BAR; PG8_SCHED;
            PG8_STAGE(PG8_SB(1, 1), b3 + hstep, voffB);
            PG8_WAIT_V(6); PG8_BAR; PG8_MMA(1, 1, At, B1); PG8_BAR;
            }
        }
        if constexpr (ALIGN_EPI) { if (wr == 0) PG8_BAR; }
        if constexpr (!Epi::AFTER_DRAIN) { E(acc, cur, wr, wc, fr, fq); S.done(cur); }
        if (!has_next) break;
#pragma unroll
        for (int a = 0; a < 2; ++a)
#pragma unroll
            for (int b = 0; b < 2; ++b)
#pragma unroll
                for (int m = 0; m < 4; ++m)
#pragma unroll
                    for (int n = 0; n < 2; ++n) acc[a][b][m][n] = (f32x4){0.f, 0.f, 0.f, 0.f};
        cur = nxt; cA = nA; cB = nB; ++ui;
        if constexpr (ALIGN_EPI) { if (wr == 1) PG8_BAR; }
    }
    PG8_WAIT_V(0);
    if constexpr (!ALIGN_EPI) { if (wr == 0) PG8_BAR; }
    PG8_BAR;
    if constexpr (Epi::AFTER_DRAIN) { E.fused(acc, cur, wr, wc, fr, fq, lds, wid, lane); S.done(cur); }
#undef PG8_SA
#undef PG8_SB
#undef PG8_STAGE
#undef PG8_LDA
#undef PG8_LDB
#undef PG8_MMA
#undef PG8_WAIT_V
#undef PG8_WAIT_L
#undef PG8_BAR
#undef PG8_SCHED
}
}

#include <hip/hip_cooperative_groups.h>
#include <type_traits>
namespace cg = cooperative_groups;

constexpr int D_MODEL = 1024, BATCH = 4, SEQ = 8192, DEPTH = 2, N_META = 16, T = SEQ + N_META  , M = BATCH * T  , MPAD = 33024  , MMAIN = 32768  ;
constexpr int D_CONV = 512, D_FF = 2816, D_IN = 4000, D_INP = 4096, NHEAD = 8, TP = 8320;
constexpr float ALPHA = 1.4142135623730951f;
constexpr float LN_EPS = 1e-5f, RMS_EPS = 1e-6f;
constexpr float QSCALE = 0.10206207261596575f * 1.4426950408889634f;
constexpr int NWAVES = 8;

constexpr size_t OFF_CTL = 0;
constexpr size_t OFF_ROPE = 65536;
constexpr size_t OFF_STATS = 1179648;
constexpr size_t OFF_HF = 2097152;
constexpr size_t SZ_HF = (size_t)MPAD * 1024 * 4;
constexpr size_t OFF_W = OFF_HF + SZ_HF;
constexpr size_t SZ_W = 17825792;
constexpr size_t OFF_S = OFF_W + SZ_W;
constexpr size_t SZ_HB = (size_t)MPAD * 1024 * 2;
constexpr size_t S_HB = OFF_S;
constexpr size_t S_GATES = OFF_S + SZ_HB;
constexpr size_t S_ACT = S_GATES;
constexpr size_t S_BCH = S_GATES + (size_t)MPAD * 2048 * 2;
constexpr size_t S_LAT = S_BCH + (size_t)MPAD * 1536 * 2;
constexpr size_t S_END4 = S_LAT + (size_t)MPAD * 512 * 4;
constexpr size_t S_YCONV = S_HB;
constexpr size_t S_CQN = S_YCONV + (size_t)MPAD * 512 * 2;
constexpr size_t S_CKVN = S_CQN + (size_t)MPAD * 256 * 2;
static_assert(S_CKVN + (size_t)MPAD * 256 * 2 <= S_GATES, "row-prep outputs fit in hb's region");
constexpr size_t S_Q = S_BCH;
constexpr size_t S_KN = S_Q + (size_t)MPAD * 768 * 2;
constexpr size_t S_VT = S_KN + (size_t)MPAD * 512 * 2;
constexpr size_t S_YMLA = S_VT + (size_t)BATCH * NHEAD * 64 * TP * 2;
static_assert(S_YMLA + (size_t)MPAD * 512 * 2 <= S_END4, "attention tensors fit in bch|lat's region");
constexpr size_t S_MERGED = S_Q;
static_assert(S_MERGED + (size_t)MPAD * 1024 * 2 <= S_VT + 0 * S_YMLA && S_ACT + (size_t)MPAD * 2816 * 2 <= S_END4, "overlays");
constexpr size_t S_KR = S_END4;
constexpr size_t WS_NEED = S_KR + (size_t)MPAD * 32 * 2;
static_assert(WS_NEED <= 536870912, "fits the guaranteed workspace");
constexpr size_t W_UP = 0, W_DOWN = (size_t)5632 * 1024 * 2;
constexpr size_t W_IN = 0, W_UQ = (size_t)4096 * 1024 * 2, W_UKV = W_UQ + 768 * 256 * 2, W_BC = W_UKV + 1024 * 256 * 2, W_BM = W_BC + 1024 * 512 * 2, W_O = W_BM + 1024 * 512 * 2;
static_assert(W_O + 1024 * 1024 * 2 <= SZ_W && W_DOWN + (size_t)1024 * 2816 * 2 <= SZ_W, "weight region");
constexpr int RING_BYTES = 131072, LDS_MISC = RING_BYTES, LDS_BYTES = RING_BYTES + 256;

#define LAS __attribute__((address_space(3)))
#define GAS __attribute__((address_space(1)))
typedef unsigned short bf16;
typedef unsigned v4u __attribute__((ext_vector_type(4)));
typedef unsigned v2u __attribute__((ext_vector_type(2)));
typedef float f32x4 __attribute__((ext_vector_type(4)));
typedef float f32x2 __attribute__((ext_vector_type(2)));
typedef float f32x16 __attribute__((ext_vector_type(16)));
typedef short bf16x8 __attribute__((ext_vector_type(8)));
#define LDS_WAIT() asm volatile("s_waitcnt lgkmcnt(0)" ::: "memory")

__device__ __forceinline__ unsigned pk2(float lo, float hi) { return pg8::cvt_pk_bf16(lo, hi); }
__device__ __forceinline__ float wave_sum(float v) {
#pragma unroll
    for (int o = 1; o < 64; o <<= 1) v += __shfl_xor(v, o);
    return v;
}

__device__ __forceinline__ float inv_freq_of(int k) {
    switch (k) { case 0: return 1.000000000e+00f; case 1: return 5.623413324e-01f; case 2: return 3.162277639e-01f; case 3: return 1.778279394e-01f; case 4: return 1.000000015e-01f; case 5: return 5.623412877e-02f;
        case 6: return 3.162277862e-02f; case 7: return 1.778279431e-02f; case 8: return 9.999999776e-03f; case 9: return 5.623413250e-03f; case 10: return 3.162277862e-03f; case 11: return 1.778279431e-03f;
        case 12: return 1.000000047e-03f; case 13: return 5.623413017e-04f; case 14: return 3.162277862e-04f; default: return 1.778279402e-04f; }
}
__device__ __forceinline__ void transpose_item(const float* W, int N, int k0, int scol0, bf16* dst, int ldk, int drow0, LAS float* scr, int lane) {
    if (scol0 >= 0) {
        float wv[32];
#pragma unroll
        for (int i = 0; i < 32; ++i) wv[i] = W[(size_t)(k0 + 2 * i + (lane >> 5)) * N + scol0 + (lane & 31)];
#pragma unroll
        for (int i = 0; i < 32; ++i) scr[(2 * i + (lane >> 5)) * 33 + (lane & 31)] = wv[i];
    } else {
#pragma unroll 8
        for (int i = 0; i < 32; ++i) { const int kk = 2 * i + (lane >> 5); scr[kk * 33 + (lane & 31)] = 0.f; }
    }
    LDS_WAIT(); asm volatile("" ::: "memory");
    const int c = lane & 7;
#pragma unroll
    for (int j = 0; j < 4; ++j) { const int n = (lane >> 3) + 8 * j; const LAS float* s = scr + (8 * c) * 33 + n;
        v4u o; o.x = pk2(s[0 * 33], s[1 * 33]); o.y = pk2(s[2 * 33], s[3 * 33]); o.z = pk2(s[4 * 33], s[5 * 33]); o.w = pk2(s[6 * 33], s[7 * 33]);
        *(v4u*)(dst + (size_t)(drow0 + n) * ldk + k0 + 8 * c) = o; }
    LDS_WAIT(); asm volatile("" ::: "memory");
}
__device__ __forceinline__ void convert_ffn(const float* w_up, const float* w_down, unsigned char* wreg, LAS float* scr, int gw, int ngw, int lane) {
    constexpr int I_UP = 16 * 176, I_DN = 44 * 32;
    for (int it = gw; it < I_UP + I_DN; it += ngw) {
        if (it < I_UP) { const int kb = it / 176, g = it % 176, tile = g >> 3, sub = g & 7;
            const int scol = sub < 4 ? tile * 128 + sub * 32 : D_FF + tile * 128 + (sub - 4) * 32;
            transpose_item(w_up, 2 * D_FF, kb * 64, scol, (bf16*)(wreg + W_UP), 1024, g * 32, scr, lane); }
        else { const int r = it - I_UP, kb = r / 32, g = r % 32; transpose_item(w_down, 1024, kb * 64, g * 32, (bf16*)(wreg + W_DOWN), D_FF, g * 32, scr, lane); }
    }
}
__device__ __forceinline__ void convert_mixer(const float* w_in, const float* w_uq, const float* w_ukv, const float* w_bc, const float* w_bm, const float* w_o, unsigned char* wreg, LAS float* scr, int gw, int ngw, int lane) {
    constexpr int I_IN = 16 * 128, I_UQ = 4 * 24, I_UKV = 4 * 32, I_BR = 8 * 32, I_O = 16 * 32;
    for (int it = gw; it < I_IN + I_UQ + I_UKV + 2 * I_BR + I_O; it += ngw) {
        int r = it;
        if (r < I_IN) { const int kb = r / 128, g = r % 128, n = g * 32; const int scol = n < 1952 ? n : (n < 2048 ? -1 : (n < 3072 ? 1952 + (n - 2048) : 2976 + (n - 3072)));
            transpose_item(w_in, D_IN, kb * 64, scol, (bf16*)(wreg + W_IN), 1024, n, scr, lane); continue; } r -= I_IN;
        if (r < I_UQ) { const int kb = r / 24, g = r % 24; transpose_item(w_uq, 768, kb * 64, g * 32, (bf16*)(wreg + W_UQ), 256, g * 32, scr, lane); continue; } r -= I_UQ;
        if (r < I_UKV) { const int kb = r / 32, g = r % 32, gg = g & 15; const int scol = (gg >> 1) * 128 + (g >> 4) * 64 + (gg & 1) * 32;
            transpose_item(w_ukv, 1024, kb < 2 ? kb * 64 : 0, kb < 2 ? scol : -1, (bf16*)(wreg + W_UKV) + (kb < 2 ? 0 : kb * 64), 256, g * 32, scr, lane); continue; } r -= I_UKV;
        if (r < I_BR) { const int kb = r / 32, g = r % 32; transpose_item(w_bc, 1024, kb * 64, g * 32, (bf16*)(wreg + W_BC), 512, g * 32, scr, lane); continue; } r -= I_BR;
        if (r < I_BR) { const int kb = r / 32, g = r % 32; transpose_item(w_bm, 1024, kb * 64, g * 32, (bf16*)(wreg + W_BM), 512, g * 32, scr, lane); continue; } r -= I_BR;
        { const int kb = r / 32, g = r % 32; transpose_item(w_o, 1024, kb * 64, g * 32, (bf16*)(wreg + W_O), 1024, g * 32, scr, lane); }
    }
}

struct LnRow { f32x4 v[4]; };
__device__ __forceinline__ LnRow ln_load(const float* xin, int lane) { LnRow r; const f32x4* xr = (const f32x4*)xin + lane;
#pragma unroll
    for (int j = 0; j < 4; ++j) r.v[j] = xr[64 * j];
    return r; }
__device__ __forceinline__ void ln_finish(LnRow r, const float* g, const float* bt, float* of32, bf16* ob16, int lane, float* ostat = nullptr) {
    f32x4 (&v)[4] = r.v; float s = 0.f;
#pragma unroll
    for (int j = 0; j < 4; ++j) s += (v[j].x + v[j].y) + (v[j].z + v[j].w);
    const float mean = wave_sum(s) * (1.f / 1024.f); float s2 = 0.f;
#pragma unroll
    for (int j = 0; j < 4; ++j) { v[j] = v[j] - mean; s2 += (v[j].x * v[j].x + v[j].y * v[j].y) + (v[j].z * v[j].z + v[j].w * v[j].w); }
    const float rstd = 1.f / sqrtf(wave_sum(s2) * (1.f / 1024.f) + LN_EPS);
    if (ostat && lane == 0) { ostat[0] = mean; ostat[1] = rstd; }
#pragma unroll
    for (int j = 0; j < 4; ++j) { const f32x4 gg = ((const f32x4*)g)[lane + 64 * j], bb = ((const f32x4*)bt)[lane + 64 * j]; v[j] = v[j] * rstd * gg + bb; }
    if (of32) {
#pragma unroll
        for (int j = 0; j < 4; ++j) ((f32x4*)of32)[lane + 64 * j] = v[j]; }
    if (ob16) {
#pragma unroll
        for (int j = 0; j < 4; ++j) { v2u w; w.x = pk2(v[j].x, v[j].y); w.y = pk2(v[j].z, v[j].w); ((v2u*)ob16)[lane + 64 * j] = w; } }
}
__device__ __forceinline__ void ln_row(const float* xin, const float* g, const float* bt, float* of32, bf16* ob16, int lane) { ln_finish(ln_load(xin, lane), g, bt, of32, ob16, lane); }

struct TailResid { float* H; float alpha, coef; const float* stats; const float* g; const float* b;
    __device__ __forceinline__ void operator()(int token, int col, const f32x4 s) const { float* p = H + (size_t)token * 1024 + col; f32x4 h = *(const f32x4*)p;
        { const f32x2 st = *(const f32x2*)(stats + 2 * token); h = (h - st.x) * st.y * *(const f32x4*)(g + col) + *(const f32x4*)(b + col); }
        *(f32x4*)p = h * alpha + s * coef; } };
template <bool ACCUM> struct TailGate { bf16* O; const bf16* G;
    __device__ __forceinline__ void operator()(int token, int col, f32x4 s) const {
        const v2u g = *(const v2u*)(G + (size_t)token * 2048 + col); bf16* op = O + (size_t)token * 1024 + col;
        s[0] *= pg8::bf_lo(g.x); s[1] *= pg8::bf_hi(g.x); s[2] *= pg8::bf_lo(g.y); s[3] *= pg8::bf_hi(g.y);
        if (ACCUM) { const v2u p = *(const v2u*)op; s[0] += pg8::bf_lo(p.x); s[1] += pg8::bf_hi(p.x); s[2] += pg8::bf_lo(p.y); s[3] += pg8::bf_hi(p.y); }
        v2u w; w.x = pk2(s[0], s[1]); w.y = pk2(s[2], s[3]); *(v2u*)op = w; } };
template <int NB, class F> __device__ __forceinline__ void tail_gemm_nb(const bf16* A, const bf16* Bt, int K, int blk, int nstrip, const int (&brow)[NB], LAS unsigned char* lds, const F& epi) {
    if (blk >= nstrip) return;
    int tid_ = threadIdx.x; asm volatile("" : "+v"(tid_));
    const int lane = tid_ & 63, wid = tid_ >> 6, fr = lane & 15, fq = lane >> 4, kw = K >> 3;
    const bf16* ap = A + (size_t)fr * K + wid * kw + fq * 8;
    f32x4 acc[NB][4];
#pragma unroll
    for (int j = 0; j < NB; ++j)
#pragma unroll
        for (int m = 0; m < 4; ++m) acc[j][m] = (f32x4){0.f, 0.f, 0.f, 0.f};
    bf16x8 a[4], b[NB];
#pragma unroll
    for (int m = 0; m < 4; ++m) a[m] = *(const GAS bf16x8*)(ap + (size_t)m * 16 * K);
#pragma unroll
    for (int j = 0; j < NB; ++j) b[j] = *(const GAS bf16x8*)(Bt + (size_t)(brow[j] + fr) * K + wid * kw + fq * 8);
    for (int k = 0; k < kw; k += 32) {
        bf16x8 an[4], bn[NB];
        const int kn = k + 32 < kw ? k + 32 : k;
#pragma unroll
        for (int m = 0; m < 4; ++m) an[m] = *(const GAS bf16x8*)(ap + (size_t)m * 16 * K + kn);
#pragma unroll
        for (int j = 0; j < NB; ++j) bn[j] = *(const GAS bf16x8*)(Bt + (size_t)(brow[j] + fr) * K + wid * kw + fq * 8 + kn);
#pragma unroll
        for (int j = 0; j < NB; ++j)
#pragma unroll
            for (int m = 0; m < 4; ++m) acc[j][m] = __builtin_amdgcn_mfma_f32_16x16x32_bf16(b[j], a[m], acc[j][m], 0, 0, 0);
#pragma unroll
        for (int m = 0; m < 4; ++m) a[m] = an[m];
#pragma unroll
        for (int j = 0; j < NB; ++j) b[j] = bn[j];
    }
    LAS f32x4* red = (LAS f32x4*)lds;
#pragma unroll
    for (int j = 0; j < NB; ++j)
#pragma unroll
        for (int m = 0; m < 4; ++m) red[((wid * NB + j) * 4 + m) * 64 + lane] = acc[j][m];
    __syncthreads();
    if (wid < 4) { f32x4 s[NB];
#pragma unroll
        for (int j = 0; j < NB; ++j) { s[j] = red[(j * 4 + wid) * 64 + lane];
#pragma unroll
            for (int w = 1; w < 8; ++w) s[j] = s[j] + red[((w * NB + j) * 4 + wid) * 64 + lane]; }
        epi(wid * 16 + fr, fq * 4, s); }
    __syncthreads();
}
template <class F> struct TailOne { const F& f; int n0; __device__ __forceinline__ void operator()(int token, int c4, const f32x4 (&s)[1]) const { f(token, n0 + c4, s[0]); } };
template <class F> __device__ __forceinline__ void tail_gemm(const bf16* A, const bf16* Bt, int K, int blk, LAS unsigned char* lds, const F& epi) {
    const int brow[1] = {blk * 16}; const TailOne<F> e{epi, blk * 16};
    tail_gemm_nb<1>(A, Bt, K, blk, 64, brow, lds, e);
}
struct TailSwiGLU { bf16* O; int c0;
    __device__ __forceinline__ void operator()(int token, int c4, const f32x4 (&s)[2]) const { f32x4 v;
#pragma unroll
        for (int i = 0; i < 4; ++i) v[i] = s[0][i] * pg8::fast_sigmoid(s[0][i]) * s[1][i];
        v2u w; w.x = pk2(v[0], v[1]); w.y = pk2(v[2], v[3]); *(v2u*)(O + (size_t)token * D_FF + c0 + c4) = w; } };
struct TailInProj { bf16* bch_; float* lat_; bf16* gates_; const float* bgate; int c0;
    __device__ __forceinline__ void operator()(int token, int c4, const f32x4 (&s)[1]) const { const int c = c0 + c4; f32x4 v = s[0];
        if (c < 1536) { v2u w; w.x = pk2(v[0], v[1]); w.y = pk2(v[2], v[3]); *(v2u*)(bch_ + (size_t)token * 1536 + c) = w; }
        else if (c < 2048) { *(f32x4*)(lat_ + (size_t)token * 512 + (c - 1536)) = v; }
        else { const f32x4 bv = *(const f32x4*)(bgate + (c - 2048));
#pragma unroll
            for (int i = 0; i < 4; ++i) v[i] = pg8::fast_sigmoid(v[i] + bv[i]);
            v2u w; w.x = pk2(v[0], v[1]); w.y = pk2(v[2], v[3]); *(v2u*)(gates_ + (size_t)token * 2048 + (c - 2048)) = w; } } };

namespace att {
constexpr int KB = 12288, VB = 8192, OFF_V = 3 * KB, OFF_WS = 3 * KB + 3 * VB, OFF_Q = OFF_WS + 8 * 256;
__device__ __forceinline__ int crow(int r, int hi) { return (r & 3) + 8 * (r >> 2) + 4 * hi; }
__device__ __forceinline__ float max3f(float a, float b, float c) { return __builtin_fmaxf(__builtin_fmaxf(a, b), c); }
__device__ __forceinline__ void attn_unit(int b, int h, int qb, const bf16* Q, const bf16* Kn, const bf16* Kr, const bf16* Vt, const float* rope, bf16* Y, LAS unsigned char* lds) {
    int tid_ = threadIdx.x; asm volatile("" : "+v"(tid_));
    const int tid = tid_, lane = tid & 63, r32 = lane & 31, hi = lane >> 5; const int wid = __builtin_amdgcn_readfirstlane(tid >> 6);
    const int q0 = qb * 256, q0w = q0 + wid * 32;
    const size_t rowbase = (size_t)b * T;
    int NT = (q0 + 256) / 64; if (NT > (T + 63) / 64) NT = (T + 63) / 64;
    int ntw = 0; if (q0w < T) { ntw = (q0w + 31) / 64 + 1; if (ntw > NT) ntw = NT; }
    bf16x8 qr[6];
    { int tq = q0w + r32; if (tq > T - 1) tq = T - 1; const bf16* qp = Q + (rowbase + tq) * 768 + h * 96 + hi * 8;
#pragma unroll
      for (int d0 = 0; d0 < 6; ++d0) qr[d0] = *(const GAS bf16x8*)(qp + d0 * 16);
      const float* rt = rope + (size_t)tq * 32 + 8 * hi; const f32x4 c0 = *(const GAS f32x4*)rt, c1 = *(const GAS f32x4*)(rt + 4), s0 = *(const GAS f32x4*)(rt + 16), s1 = *(const GAS f32x4*)(rt + 20);
      v4u a = __builtin_bit_cast(v4u, qr[4]), bb = __builtin_bit_cast(v4u, qr[5]), oa, ob;
#define ROT2(AW, BW, CA, CB, SA, SB, OA, OB) do { const float x1l = pg8::bf_lo(AW), x1h = pg8::bf_hi(AW), x2l = pg8::bf_lo(BW), x2h = pg8::bf_hi(BW); \
        OA = pk2(x1l * (CA) - x2l * (SA), x1h * (CB) - x2h * (SB)); OB = pk2(x2l * (CA) + x1l * (SA), x2h * (CB) + x1h * (SB)); } while (0)
      ROT2(a.x, bb.x, c0[0], c0[1], s0[0], s0[1], oa.x, ob.x); ROT2(a.y, bb.y, c0[2], c0[3], s0[2], s0[3], oa.y, ob.y);
      ROT2(a.z, bb.z, c1[0], c1[1], s1[0], s1[1], oa.z, ob.z); ROT2(a.w, bb.w, c1[2], c1[3], s1[2], s1[3], oa.w, ob.w);
#undef ROT2
      qr[4] = __builtin_bit_cast(bf16x8, oa); qr[5] = __builtin_bit_cast(bf16x8, ob); }
    const bf16* kn_src = Kn + (rowbase + (tid >> 3)) * 512 + h * 64 + (tid & 7) * 8;
    const bf16* kr_src = Kr + (rowbase + ((tid & 255) >> 2)) * 32 + (tid & 3) * 8;
    const bf16* v_src = Vt + ((size_t)(b * 8 + h) * 64 + (tid >> 3)) * TP + (tid & 7) * 8;
    const int kn_dst = (tid & 7) * 1024 + (((tid >> 3) ^ (tid & 7)) << 4);
    const int kr_dst = (8 + (tid & 3)) * 1024 + ((((tid & 255) >> 2) ^ (tid & 3)) << 4);
    const int v_dst = OFF_V + (tid & 7) * 1024 + (((tid >> 3) ^ (tid & 7)) << 4);
    int kaddr[6], vaddr[4];
#pragma unroll
    for (int d0 = 0; d0 < 6; ++d0) kaddr[d0] = (int)(unsigned)(uintptr_t)lds + (2 * d0 + hi) * 1024 + ((r32 ^ ((2 * d0 + hi) & 7)) << 4);
#pragma unroll
    for (int ks = 0; ks < 4; ++ks) vaddr[ks] = (int)(unsigned)(uintptr_t)lds + OFF_V + (2 * ks + hi) * 1024 + ((r32 ^ (2 * ks + hi)) << 4);
    v4u kA, krA = (v4u){0u, 0u, 0u, 0u}, vA;
#define ATT_LOADK(kt, K_, KR_) do { K_ = *(const GAS v4u*)(kn_src + (size_t)(kt) * 64 * 512); if (wid < 4) KR_ = *(const GAS v4u*)(kr_src + (size_t)(kt) * 64 * 32); } while (0)
#define ATT_LOADV(kt, V_) do { V_ = *(const GAS v4u*)(v_src + (size_t)(kt) * 64); } while (0)
#define ATT_STOREK(slot, K_, KR_) do { *(LAS v4u*)(lds + (slot) * KB + kn_dst) = K_; if (wid < 4) *(LAS v4u*)(lds + (slot) * KB + kr_dst) = KR_; } while (0)
#define ATT_STOREV(slot, V_) do { *(LAS v4u*)(lds + (slot) * VB + v_dst) = V_; } while (0)
    LAS float* wsf = (LAS float*)(lds + OFF_WS + wid * 256);
    const bool skew = wid >= 4;
    bf16x8 pw[4];
    float mrow = 0.f, lsum = 0.f;
    f32x16 o0, o1, negm, p0, p1;
#pragma unroll
    for (int r = 0; r < 16; ++r) { o0[r] = 0.f; o1[r] = 0.f; negm[r] = 0.f; p0[r] = 0.f; p1[r] = 0.f; }
#define ATT_PV(VOFF) do { \
        _Pragma("unroll") for (int ks = 0; ks < 4; ++ks) { \
            const bf16x8 v0 = *(const LAS bf16x8*)(unsigned)(vaddr[ks] + (VOFF)), v1 = *(const LAS bf16x8*)(unsigned)(vaddr[ks] + (VOFF) + 512); \
            o0 = __builtin_amdgcn_mfma_f32_32x32x16_bf16(pw[ks], v0, o0, 0, 0, 0); \
            o1 = __builtin_amdgcn_mfma_f32_32x32x16_bf16(pw[ks], v1, o1, 0, 0, 0); } } while (0)
#define ATT_QK(KOFF) do { \
        _Pragma("unroll") for (int d0 = 0; d0 < 6; ++d0) { \
            const bf16x8 a0 = *(const LAS bf16x8*)(unsigned)(kaddr[d0] + (KOFF)), a1 = *(const LAS bf16x8*)(unsigned)(kaddr[d0] + (KOFF) + 512); \
            p0 = __builtin_amdgcn_mfma_f32_32x32x16_bf16(a0, qr[d0], d0 == 0 ? negm : p0, 0, 0, 0); \
            p1 = __builtin_amdgcn_mfma_f32_32x32x16_bf16(a1, qr[d0], d0 == 0 ? negm : p1, 0, 0, 0); } } while (0)
    auto softmax_tile = [&](const int kt) __attribute__((always_inline)) {
        if (64 * kt + 63 > q0w) {
            const int q = q0w + r32, kbase = 64 * kt + 4 * hi;
#pragma unroll
            for (int r = 0; r < 16; ++r) { const int key = kbase + (r & 3) + 8 * (r >> 2); if (key > q) p0[r] = -1e30f; if (key + 32 > q) p1[r] = -1e30f; }
        }
        float mxa = max3f(p0[0], p0[1], p1[0]), mxb = max3f(p0[2], p0[3], p1[1]); mxa = max3f(mxa, p1[2], p1[3]);
#pragma unroll
        for (int r = 4; r < 16; r += 4) { mxa = max3f(mxa, p0[r], p0[r + 1]); mxb = max3f(mxb, p0[r + 2], p0[r + 3]); mxa = max3f(mxa, p1[r], p1[r + 1]); mxb = max3f(mxb, p1[r + 2], p1[r + 3]); }
        float mx = fmaxf(mxa, mxb);
        mx = fmaxf(mx, __shfl_xor(mx, 32));
        if (kt == 0 || __any(mx > 8.0f)) {
            const float dl = (kt == 0) ? mx : fmaxf(mx, 0.f), alpha = __builtin_amdgcn_exp2f(-dl);
            mrow += dl; lsum *= alpha;
#pragma unroll
            for (int r = 0; r < 16; ++r) { p0[r] -= dl; p1[r] -= dl; negm[r] = -mrow; }
            if (hi == 0) wsf[r32] = alpha;
            LDS_WAIT();
#pragma unroll
            for (int i = 0; i < 4; ++i) { const f32x4 a = *(const LAS f32x4*)(wsf + 8 * i + 4 * hi);
#pragma unroll
                for (int j = 0; j < 4; ++j) { o0[4 * i + j] *= a[j]; o1[4 * i + j] *= a[j]; } }
        }
#pragma unroll
        for (int r = 0; r < 16; ++r) { p0[r] = __builtin_amdgcn_exp2f(p0[r]); p1[r] = __builtin_amdgcn_exp2f(p1[r]); }
        float sa = lsum;
#pragma unroll
        for (int r = 0; r < 16; ++r) sa += p0[r];
#pragma unroll
        for (int r = 0; r < 16; ++r) sa += p1[r];
        lsum = sa;
#pragma unroll
        for (int ks = 0; ks < 4; ++ks) { v4u w;
            if (ks < 2) { w.x = pk2(p0[8 * ks + 0], p0[8 * ks + 1]); w.y = pk2(p0[8 * ks + 2], p0[8 * ks + 3]); w.z = pk2(p0[8 * ks + 4], p0[8 * ks + 5]); w.w = pk2(p0[8 * ks + 6], p0[8 * ks + 7]); }
            else { const int k2 = ks - 2; w.x = pk2(p1[8 * k2 + 0], p1[8 * k2 + 1]); w.y = pk2(p1[8 * k2 + 2], p1[8 * k2 + 3]); w.z = pk2(p1[8 * k2 + 4], p1[8 * k2 + 5]); w.w = pk2(p1[8 * k2 + 6], p1[8 * k2 + 7]); }
            pw[ks] = __builtin_bit_cast(bf16x8, w); }
    };
    ATT_LOADK(0, kA, krA); ATT_LOADV(0, vA); ATT_STOREK(0, kA, krA); ATT_STOREV(0, vA);
    if (NT > 1) { ATT_LOADK(1, kA, krA); ATT_STOREK(1, kA, krA); }
    __syncthreads();
    if (!skew && 0 < ntw) ATT_QK(0);
    int s0 = 0, s1 = 1, s2 = 2;
#define ATT_STEP(COMPUTE) do { \
        if (kt + 2 < NT) ATT_LOADK(kt + 2, kA, krA); if (kt + 1 < NT) ATT_LOADV(kt + 1, vA); \
        COMPUTE; \
        if (kt + 2 < NT) ATT_STOREK(s2, kA, krA); if (kt + 1 < NT) ATT_STOREV(s1, vA); \
        { const int t_ = s0; s0 = s1; s1 = s2; s2 = t_; } \
        asm volatile("s_waitcnt lgkmcnt(0)\n\ts_barrier" ::: "memory");   \
    } while (0)
    if (!skew) {
        for (int kt = 0; kt < NT; ++kt) ATT_STEP({ if (kt < ntw) { softmax_tile(kt); ATT_PV(s0 * VB); } if (kt + 1 < ntw) ATT_QK(s1 * KB); });
    } else {
        for (int kt = 0; kt < NT; ++kt) ATT_STEP({ if (kt >= 1 && kt - 1 < ntw) ATT_PV(s2 * VB); if (kt < ntw) { ATT_QK(s0 * KB); softmax_tile(kt); } });
    }
#undef ATT_STEP
    if (skew && NT - 1 < ntw) ATT_PV(((NT - 1) % 3) * VB);
#undef ATT_PV
#undef ATT_QK
    if (ntw > 0) {
        lsum += __shfl_xor(lsum, 32);
        if (hi == 0) wsf[32 + r32] = 1.0f / lsum;
        LDS_WAIT();
        bf16* yp = Y + (rowbase + q0w) * 512 + h * 64 + r32;
#pragma unroll
        for (int i = 0; i < 4; ++i) { const f32x4 a = *(const LAS f32x4*)(wsf + 32 + 8 * i + 4 * hi);
#pragma unroll
            for (int j = 0; j < 4; ++j) { const int r = 4 * i + j, q = crow(r, hi);
                if (q0w + q < T) { const unsigned w = pk2(o0[r] * a[j], o1[r] * a[j]); ((GAS bf16*)yp)[(size_t)q * 512] = (bf16)(w & 0xffffu); ((GAS bf16*)yp)[(size_t)q * 512 + 32] = (bf16)(w >> 16); } } }
        LDS_WAIT();
    }
#undef ATT_LOADK
#undef ATT_LOADV
#undef ATT_STOREK
#undef ATT_STOREV
}
}

#ifdef PROBE_SYS_SCOPE
#define XB_SCOPE ""
#else
#define XB_SCOPE "agent"
#endif
#define XB_TMO      128
#define XB_XCNT(j)  (256  + 64 * (j))
#define XB_XSUB(j)  (1280 + 64 * (j))
#define XB_XGEN(j)  (2304 + 64 * (j))
#define XB_TOP      3328
#define XB_TOPGEN   3392
#define XCD_BAR_WORDS 3456
#define XB_SPIN_CAP (1u << 18)

__device__ __forceinline__ unsigned xb_ld(unsigned* p)              { return __hip_atomic_load(p, __ATOMIC_RELAXED, __HIP_MEMORY_SCOPE_AGENT); }
__device__ __forceinline__ unsigned xb_add(unsigned* p, unsigned v) { return __hip_atomic_fetch_add(p, v, __ATOMIC_RELAXED, __HIP_MEMORY_SCOPE_AGENT); }
__device__ __forceinline__ unsigned xb_xcc_id() { return (unsigned)__builtin_amdgcn_s_getreg((3 << 11) | 20) & 0xFu; }
#define XB_SPIN(cond, bar) do { unsigned _sp = 0; while (cond) { __builtin_amdgcn_s_sleep(1); \
    if ((++_sp & 255u) == 0u) { if (xb_ld(&(bar)[XB_TMO])) break; if (_sp > XB_SPIN_CAP) { atomicAdd(&(bar)[XB_TMO], 1u); break; } } } } while (0)

struct XcdBarrier {
    unsigned* bar; unsigned x;
    volatile LAS unsigned* st;
};

__device__ __forceinline__ XcdBarrier xcd_barrier_post(unsigned* bar, volatile LAS unsigned* st) {
    XcdBarrier b; b.bar = bar; b.x = xb_xcc_id(); b.st = st;
    if (threadIdx.x == 0) (void)xb_add(&bar[XB_XCNT(b.x)], 1u);
    return b;
}
__device__ __forceinline__ void xcd_barrier_complete(unsigned* bar, unsigned x, unsigned& nloc, unsigned& nx) {
    const unsigned G = gridDim.x * gridDim.y * gridDim.z;
    unsigned sum, cnt, mine, sp = 0u;
    for (;;) {
        sum = 0u; cnt = 0u; mine = 0u;
#pragma unroll
        for (unsigned j = 0; j < 16; ++j) { const unsigned c = xb_ld(&bar[XB_XCNT(j)]); sum += c; cnt += (c > 0u) ? 1u : 0u; mine = (j == x) ? c : mine; }
        if (sum == G) break;
        __builtin_amdgcn_s_sleep(1);
        if ((++sp & 255u) == 0u) { if (xb_ld(&bar[XB_TMO])) break; if (sp > XB_SPIN_CAP) { atomicAdd(&bar[XB_TMO], 1u); break; } }
    }
    nloc = mine > 0u ? mine : 1u; nx = cnt > 0u ? cnt : 1u;
}

__device__ __forceinline__ void xcd_barrier(const XcdBarrier& b) {
    asm volatile("s_waitcnt vmcnt(0)" ::: "memory");
    __syncthreads();
    if (threadIdx.x == 0) {
        unsigned* bar = b.bar;
        __builtin_amdgcn_s_waitcnt(0);
        unsigned nloc = b.st[0], nx = b.st[1];
        if (nloc == 0u) { xcd_barrier_complete(bar, b.x, nloc, nx); b.st[0] = nloc; b.st[1] = nx; }
        const unsigned old = xb_add(&bar[XB_XSUB(b.x)], 1u);
        const unsigned gen = old / nloc;
        if (old + 1u == (gen + 1u) * nloc) {
            __builtin_amdgcn_fence(__ATOMIC_RELEASE, XB_SCOPE);
            asm volatile("s_waitcnt vmcnt(0)" ::: "memory");
            const unsigned og = xb_add(&bar[XB_TOP], 1u);
            const unsigned tg = og / nx;
            if (og + 1u == (tg + 1u) * nx) xb_add(&bar[XB_TOPGEN], 1u);
            else XB_SPIN(xb_ld(&bar[XB_TOPGEN]) == tg, bar);
            __builtin_amdgcn_fence(__ATOMIC_ACQUIRE, XB_SCOPE);
            xb_add(&bar[XB_XGEN(b.x)], 1u);
            asm volatile("s_waitcnt vmcnt(0)" ::: "memory");
        } else {
            XB_SPIN(xb_ld(&bar[XB_XGEN(b.x)]) == gen, bar);
            __builtin_amdgcn_fence(__ATOMIC_ACQUIRE, XB_SCOPE);
            asm volatile("s_waitcnt vmcnt(0)" ::: "memory");
        }
    }
    __syncthreads();
}

struct Args { const float* in[18]; float* out; unsigned char* ws; };
static_assert(sizeof(Args) == 160, "Args layout");

__global__ void __launch_bounds__(NWAVES * 64, 2) mega_fwd(Args args) {
    extern __shared__ __attribute__((aligned(16))) unsigned char lds_raw[];
    cg::grid_group grid = cg::this_grid();
    LAS unsigned char* lds = (LAS unsigned char*)lds_raw;
    int tid = threadIdx.x, lane = tid & 63; const int wave = __builtin_amdgcn_readfirstlane(tid >> 6);
#ifdef PROBE_SYNC_TWICE
#define GRID_SYNC() do { XcdBarrier xb_; xb_.bar = ctl + 4096; xb_.x = xb_xcc_id(); xb_.st = (volatile LAS unsigned*)(lds + LDS_MISC) + 8; xcd_barrier(xb_); xcd_barrier(xb_); REBASE(); } while (0)
#else
#define GRID_SYNC() do { XcdBarrier xb_; xb_.bar = ctl + 4096; xb_.x = xb_xcc_id(); xb_.st = (volatile LAS unsigned*)(lds + LDS_MISC) + 8; xcd_barrier(xb_); REBASE(); } while (0)
#endif
#define OPQ() do { asm volatile("" : "+v"(tid)); lane = tid & 63; } while (0)
    const int G = gridDim.x, blk = blockIdx.x;
    const int gw = blk * NWAVES + wave, ngw = G * NWAVES;
    const unsigned char* ka = (const unsigned char*)__builtin_amdgcn_kernarg_segment_ptr();
    GAS unsigned char* ws = (GAS unsigned char*)args.ws;
#define REBASE() do { asm volatile("" : "+s"(ka)); asm volatile("" : "+s"(ws)); } while (0)
#define INP(i) ((const float*)(const GAS float*)(*(const float* const*)(ka + 8 * (i))))
#define X_IN INP(0)
#define meta INP(1)
#define ffn1_up INP(2)
#define ffn1_down INP(3)
#define w_in INP(4)
#define b_gate INP(5)
#define conv_w INP(6)
#define q_norm_g INP(7)
#define w_uq INP(8)
#define kv_norm_g INP(9)
#define w_ukv INP(10)
#define w_br_conv INP(11)
#define w_br_mla INP(12)
#define w_o INP(13)
#define ffn2_up INP(14)
#define ffn2_down INP(15)
#define ln_g INP(16)
#define ln_b INP(17)
#define OUTP ((float*)(GAS float*)(*(float* const*)(ka + 144)))
#define ctl ((unsigned*)(ws + OFF_CTL))
#define rope ((float*)(ws + OFF_ROPE))
#define lnstats ((float*)(ws + OFF_STATS))
#define lnident ((float*)(ws + OFF_STATS + (size_t)MPAD * 8))
#define hf ((float*)(ws + OFF_HF))
#define wreg ((unsigned char*)(ws + OFF_W))
#define hb ((bf16*)(ws + S_HB))
#define act ((bf16*)(ws + S_ACT))
#define gates ((bf16*)(ws + S_GATES))
#define bch ((bf16*)(ws + S_BCH))
#define lat ((float*)(ws + S_LAT))
#define yconv ((bf16*)(ws + S_YCONV))
#define cqn ((bf16*)(ws + S_CQN))
#define ckvn ((bf16*)(ws + S_CKVN))
#define krb ((bf16*)(ws + S_KR))
#define Qb ((bf16*)(ws + S_Q))
#define Knb ((bf16*)(ws + S_KN))
#define Vtb ((bf16*)(ws + S_VT))
#define ymla ((bf16*)(ws + S_YMLA))
#define merged ((bf16*)(ws + S_MERGED))
    LAS float* scr = (LAS float*)(lds + wave * 16384);
    LAS unsigned char* ring = lds;
    if (threadIdx.x < 64) ((LAS unsigned*)(lds + LDS_MISC))[threadIdx.x] = 0u;
    __syncthreads();
    (void)xcd_barrier_post(ctl + 4096, (volatile LAS unsigned*)(lds + LDS_MISC) + 8);
    grid.sync();

#ifdef PROBE_DUMP_BIAS
    OPQ();
    for (int row = gw; row < BATCH * SEQ; row += ngw) { float* o = OUTP + (size_t)row * 1024; for (int c = lane; c < 1024; c += 64) o[c] = b_gate[c] + 2.0f * b_gate[1024 + c] + 4.0f * b_gate[2048 + c] + 8.0f * b_gate[3072 + c]; }
    return;
#endif
    OPQ();
    { auto p0_load = [&](int row) __attribute__((always_inline)) { LnRow rr;
          if (row < M) { const int b = row / T, t = row - b * T; rr = ln_load(t < N_META ? meta + (size_t)t * 1024 : X_IN + ((size_t)b * SEQ + (t - N_META)) * 1024, lane); }
          else {
#pragma unroll
              for (int j = 0; j < 4; ++j) rr.v[j] = (f32x4){0.f, 0.f, 0.f, 0.f}; }
          return rr; };
      LnRow cur = p0_load(gw);
      for (int row = gw; row < MPAD; row += ngw) { const LnRow nxt = p0_load(row + ngw < MPAD ? row + ngw : row);
#pragma unroll
          for (int j = 0; j < 4; ++j) { const f32x4 v = cur.v[j]; ((f32x4*)(hf + (size_t)row * 1024))[lane + 64 * j] = v; v2u w; w.x = pk2(v.x, v.y); w.y = pk2(v.z, v.w); ((v2u*)(hb + (size_t)row * 1024))[lane + 64 * j] = w; }
          cur = nxt; } }
    for (int i = blk * 512 + tid; i < MPAD; i += G * 512) { lnstats[2 * i] = 0.f; lnstats[2 * i + 1] = 1.f; }
    for (int i = blk * 512 + tid; i < 2048; i += G * 512) lnident[i] = i < 1024 ? 1.f : 0.f;
    for (int i = blk * 512 + tid; i < T * 16; i += G * 512) { const int t = i >> 4, k = i & 15;
        const float inv_freq = inv_freq_of(k); const float ang = (float)t * inv_freq;
        const double rev = (double)ang * 0.15915494309189535; const float fr = (float)(rev - floor(rev));
        rope[t * 32 + k] = __builtin_amdgcn_cosf(fr); rope[t * 32 + 16 + k] = __builtin_amdgcn_sinf(fr); }
    convert_ffn(ffn1_up, ffn1_down, wreg, scr, gw, ngw, lane);
    GRID_SYNC();

    for (int step = 0; step < 3 * DEPTH; ++step) {
        const int l = step / 3, sub = step % 3;
#ifdef PROBE_STEPS
        if (step == PROBE_STEPS) {
            OPQ();
            for (int row = gw; row < M; row += ngw) { const int b = row / T, t = row - b * T; if (t >= N_META) {
#pragma unroll
                for (int j = 0; j < 4; ++j) ((f32x4*)(OUTP + ((size_t)b * SEQ + (t - N_META)) * 1024))[lane + 64 * j] = ((const f32x4*)(hf + (size_t)row * 1024))[lane + 64 * j]; } }
            return;
        }
#endif
        if (sub != 1) {
            { const int c0 = blk * 16, tl = c0 >> 7, j0 = c0 & 127; const int brow[2] = {256 * tl + j0, 256 * tl + 128 + j0};
              tail_gemm_nb<2>(hb + (size_t)MMAIN * 1024, (const bf16*)(wreg + W_UP), 1024, blk, D_FF / 16, brow, lds, TailSwiGLU{act + (size_t)MMAIN * D_FF, c0}); }
#ifdef PROBE_UP_TWICE
            for (int rep_ = 0; rep_ < 2; ++rep_)
#endif
            { pg8::Gemm g{hb, (const bf16*)(wreg + W_UP), MMAIN, 2 * D_FF, 1024}; pg8::StaticOrder S; S.init(MMAIN, 2 * D_FF, G, blk);
              pg8::EpiSwiGLU E{act, D_FF};
              pg8::gemm_phase<pg8::EpiSwiGLU, pg8::StaticOrder, true, true>(ring, g, S, E); }
            GRID_SYNC();
            const float* pg_ = (step == 0) ? lnident : (sub == 0 ? ln_g + ((size_t)(l - 1) * 3 + 2) * 1024 : ln_g + ((size_t)l * 3 + 1) * 1024);
            const float* pb_ = (step == 0) ? lnident + 1024 : (sub == 0 ? ln_b + ((size_t)(l - 1) * 3 + 2) * 1024 : ln_b + ((size_t)l * 3 + 1) * 1024);
            tail_gemm(act + (size_t)MMAIN * D_FF, (const bf16*)(wreg + W_DOWN), D_FF, blk, lds, TailResid{hf + (size_t)MMAIN * 1024, ALPHA, 0.5f, lnstats + 2 * (size_t)MMAIN, pg_, pb_});
            { pg8::Gemm g{act, (const bf16*)(wreg + W_DOWN), MMAIN, 1024, D_FF}; pg8::StaticOrder S; S.init(MMAIN, 1024, G, blk);
              pg8::EpiResid E{hf, ALPHA, 0.5f, lnstats, pg_, pb_};
              pg8::gemm_phase<pg8::EpiResid, pg8::StaticOrder, true, true>(ring, g, S, E); }
            GRID_SYNC();
            OPQ();
            const int li = (sub == 0) ? 0 : 2; const float* lg = ln_g + ((size_t)l * 3 + li) * 1024; const float* lb = ln_b + ((size_t)l * 3 + li) * 1024;
            const bool final_ln = (step == 3 * DEPTH - 1);
            if (!final_ln) {
                LnRow cur = ln_load(hf + (size_t)gw * 1024, lane);
                for (int row = gw; row < MPAD; row += ngw) { const int nx = row + ngw < MPAD ? row + ngw : row; const LnRow nxt = ln_load(hf + (size_t)nx * 1024, lane);
                    ln_finish(cur, lg, lb, nullptr, hb + (size_t)row * 1024, lane, lnstats + 2 * (size_t)row); cur = nxt; }
            } else {
                LnRow cur = ln_load(hf + (size_t)gw * 1024, lane);
                for (int row = gw; row < M; row += ngw) { const int nx = row + ngw < M ? row + ngw : row; const LnRow nxt = ln_load(hf + (size_t)nx * 1024, lane);
                    const int b = row / T, t = row - b * T; if (t >= N_META) ln_finish(cur, lg, lb, OUTP + ((size_t)b * SEQ + (t - N_META)) * 1024, nullptr, lane); cur = nxt; }
            }
            if (sub == 0) convert_mixer(w_in + (size_t)l * 1024 * D_IN, w_uq + (size_t)l * 256 * 768, w_ukv + (size_t)l * 128 * 1024, w_br_conv + (size_t)l * 512 * 1024, w_br_mla + (size_t)l * 512 * 1024, w_o + (size_t)l * 1024 * 1024, wreg, scr, gw, ngw, lane);
            else if (!final_ln) convert_ffn(ffn1_up + (size_t)(l + 1) * 1024 * 2 * D_FF, ffn1_down + (size_t)(l + 1) * D_FF * 1024, wreg, scr, gw, ngw, lane);
            if (!final_ln) GRID_SYNC();
        } else {
#ifdef PROBE_DUMP_BIAS1
            OPQ();
            for (int row = gw; row < BATCH * SEQ; row += ngw) { float* o = OUTP + (size_t)row * 1024; for (int c = lane; c < 1024; c += 64) o[c] = b_gate[c] + 2.0f * b_gate[1024 + c] + 4.0f * b_gate[2048 + c] + 8.0f * b_gate[3072 + c]; }
            return;
#endif
            { const int brow[1] = {blk * 16};
              tail_gemm_nb<1>(hb + (size_t)MMAIN * 1024, (const bf16*)(wreg + W_IN), 1024, blk, D_INP / 16, brow, lds,
                              TailInProj{bch + (size_t)MMAIN * 1536, lat + (size_t)MMAIN * 512, gates + (size_t)MMAIN * 2048, b_gate + (size_t)l * 2048, blk * 16}); }
            { pg8::Gemm g{hb, (const bf16*)(wreg + W_IN), MMAIN, D_INP, 1024}; pg8::StaticOrder S; S.init(MMAIN, D_INP, G, blk);
              pg8::EpiInProj E{bch, lat, gates, b_gate + (size_t)l * 2048};
              pg8::gemm_phase<pg8::EpiInProj, pg8::StaticOrder, true, true>(ring, g, S, E); }
            GRID_SYNC();
#ifdef PROBE_DUMP_GATES0
            OPQ();
            for (int row = gw; row < M; row += ngw) { const int b = row / T, t = row - b * T; if (t >= N_META) { float* o = OUTP + ((size_t)b * SEQ + (t - N_META)) * 1024;
                for (int c = lane; c < 1024; c += 64) o[c] = pg8::bf_lo(gates[(size_t)row * 2048 + c]) + 2.0f * pg8::bf_lo(gates[(size_t)row * 2048 + 1024 + c]); } }
            return;
#endif
            OPQ();
            { const float* cw = conv_w + (size_t)l * 3 * 512; const float* qg = q_norm_g + (size_t)l * 256; const float* kg = kv_norm_g + (size_t)l * 128;
              struct RpRow { v4u c[3], h[3], bb; f32x4 q; f32x2 kv; float x1, x2; };
              auto rp_load = [&](int row) __attribute__((always_inline)) { RpRow d; const int rr = row < M ? row : M - 1; const int b = rr / T, t = rr - b * T;
#pragma unroll
                  for (int k = 0; k < 3; ++k) { const int dt = 2 - k;
                      if (t - dt >= 0 && row < M) { const bf16* rp = bch + (size_t)(row - dt) * 1536 + 8 * lane; d.c[k] = *(const v4u*)(rp + 512); d.h[k] = *(const v4u*)(rp + 1024); }
                      else { d.c[k] = (v4u){0u, 0u, 0u, 0u}; d.h[k] = (v4u){0u, 0u, 0u, 0u}; } }
                  d.bb = *(const v4u*)(bch + (size_t)row * 1536 + 8 * lane);
                  const float* lr = lat + (size_t)row * 512;
                  d.q = *(const f32x4*)(lr + 4 * lane); d.kv = *(const f32x2*)(lr + 256 + 2 * lane); d.x1 = lr[384 + (lane & 15)]; d.x2 = lr[400 + (lane & 15)];
                  return d; };
              RpRow cur = rp_load(gw);
              for (int row = gw; row < MPAD; row += ngw) {
                const RpRow nxt = rp_load(row + ngw < MPAD ? row + ngw : row);
                const int rr = row < M ? row : M - 1; const int t = rr % T;
                f32x4 ua[2] = {(f32x4){0.f, 0.f, 0.f, 0.f}, (f32x4){0.f, 0.f, 0.f, 0.f}};
#pragma unroll
                for (int k = 0; k < 3; ++k) { const v4u c = cur.c[k], hh = cur.h[k];
                        const f32x4 w0 = *(const f32x4*)(cw + k * 512 + 8 * lane), w1 = *(const f32x4*)(cw + k * 512 + 8 * lane + 4);
                        ua[0][0] += w0[0] * pg8::bf_lo(c.x) * pg8::bf_lo(hh.x); ua[0][1] += w0[1] * pg8::bf_hi(c.x) * pg8::bf_hi(hh.x);
                        ua[0][2] += w0[2] * pg8::bf_lo(c.y) * pg8::bf_lo(hh.y); ua[0][3] += w0[3] * pg8::bf_hi(c.y) * pg8::bf_hi(hh.y);
                        ua[1][0] += w1[0] * pg8::bf_lo(c.z) * pg8::bf_lo(hh.z); ua[1][1] += w1[1] * pg8::bf_hi(c.z) * pg8::bf_hi(hh.z);
                        ua[1][2] += w1[2] * pg8::bf_lo(c.w) * pg8::bf_lo(hh.w); ua[1][3] += w1[3] * pg8::bf_hi(c.w) * pg8::bf_hi(hh.w); }
                { const v4u bb = cur.bb;
                  v4u o; o.x = pk2(ua[0][0] * pg8::bf_lo(bb.x), ua[0][1] * pg8::bf_hi(bb.x)); o.y = pk2(ua[0][2] * pg8::bf_lo(bb.y), ua[0][3] * pg8::bf_hi(bb.y));
                  o.z = pk2(ua[1][0] * pg8::bf_lo(bb.z), ua[1][1] * pg8::bf_hi(bb.z)); o.w = pk2(ua[1][2] * pg8::bf_lo(bb.w), ua[1][3] * pg8::bf_hi(bb.w));
                  *(v4u*)(yconv + (size_t)row * 512 + 8 * lane) = o; }
                { const f32x4 v = cur.q; const float ss = wave_sum((v.x * v.x + v.y * v.y) + (v.z * v.z + v.w * v.w));
                  const float rs = 1.f / sqrtf(ss * (1.f / 256.f) + RMS_EPS); const f32x4 gg = *(const f32x4*)(qg + 4 * lane);
                  v2u w; w.x = pk2(v.x * rs * gg.x, v.y * rs * gg.y); w.y = pk2(v.z * rs * gg.z, v.w * rs * gg.w); *(v2u*)(cqn + (size_t)row * 256 + 4 * lane) = w; }
                { const f32x2 v = cur.kv; const float ss = wave_sum(v.x * v.x + v.y * v.y);
                  const float rs = 1.f / sqrtf(ss * (1.f / 128.f) + RMS_EPS); const f32x2 gg = *(const f32x2*)(kg + 2 * lane);
                  *(unsigned*)(ckvn + (size_t)row * 256 + 2 * lane) = pk2(v.x * rs * gg.x, v.y * rs * gg.y); *(unsigned*)(ckvn + (size_t)row * 256 + 128 + 2 * lane) = 0u; }
                if (lane < 16) { const float x1 = cur.x1, x2 = cur.x2, cs = rope[t * 32 + lane], sn = rope[t * 32 + 16 + lane];
                  const unsigned w = pk2(x1 * cs - x2 * sn, x2 * cs + x1 * sn); krb[(size_t)row * 32 + lane] = (bf16)(w & 0xffffu); krb[(size_t)row * 32 + 16 + lane] = (bf16)(w >> 16); }
                cur = nxt;
              } }
            GRID_SYNC();
#ifdef PROBE_DUMP_GATES
            OPQ();
            for (int row = gw; row < M; row += ngw) { const int b = row / T, t = row - b * T; if (t >= N_META) { float* o = OUTP + ((size_t)b * SEQ + (t - N_META)) * 1024;
                for (int c = lane; c < 1024; c += 64) o[c] = pg8::bf_lo(gates[(size_t)row * 2048 + c]) + 2.0f * pg8::bf_lo(gates[(size_t)row * 2048 + 1024 + c]); } }
            return;
#endif
#ifdef PROBE_DUMP_ROWPREP
            OPQ();
            for (int row = gw; row < M; row += ngw) { const int b = row / T, t = row - b * T; if (t >= N_META) { float* o = OUTP + ((size_t)b * SEQ + (t - N_META)) * 1024;
                for (int c = lane; c < 1024; c += 64) { float v = 0.f;
                    if (c < 512) v = pg8::bf_lo(yconv[(size_t)row * 512 + c]); else if (c < 768) v = pg8::bf_lo(cqn[(size_t)row * 256 + c - 512]); else if (c < 896) v = pg8::bf_lo(ckvn[(size_t)row * 256 + c - 768]); else if (c < 928) v = pg8::bf_lo(krb[(size_t)row * 32 + c - 896]);
                    else if (c < 960) v = lat[(size_t)row * 512 + 384 + c - 928];
                    o[c] = v; } } }
            return;
#endif
            OPQ();
            for (int i = blk * 512 + tid; i < BATCH * NHEAD * 64 * (TP - T); i += G * 512) { const int r = i / (TP - T), c = i % (TP - T); Vtb[(size_t)r * TP + T + c] = 0; }
            { pg8::Gemm g{cqn, (const bf16*)(wreg + W_UQ), MPAD, 768, 256}; pg8::StaticOrder S; S.init(MPAD, 768, G, blk);
              pg8::EpiPlain E{Qb, 768, QSCALE};
              pg8::gemm_phase<pg8::EpiPlain, pg8::StaticOrder, true, true>(ring, g, S, E); }
            { pg8::Gemm g{ckvn, (const bf16*)(wreg + W_UKV), MPAD, 512, 256}; pg8::StaticOrder S; S.init(MPAD, 512, G, blk);
              pg8::EpiPlain E{Knb, 512, 1.0f};
              pg8::gemm_phase<pg8::EpiPlain, pg8::StaticOrder, true, true>(ring, g, S, E); }
            { pg8::Gemm g{(const bf16*)(wreg + W_UKV) + 512 * 256, ckvn, 512, MPAD, 256}; pg8::StaticOrder S; S.init(512, MPAD, G, blk);
              pg8::EpiVt E{Vtb};
              pg8::gemm_phase<pg8::EpiVt, pg8::StaticOrder, true, true>(ring, g, S, E); }
            GRID_SYNC();
            OPQ();
#ifdef PROBE_NOATTN
            for (size_t i = (size_t)blk * 512 + tid; i < (size_t)MPAD * 512 / 8; i += (size_t)G * 512) ((v4u*)ymla)[i] = (v4u){0u, 0u, 0u, 0u};
            if (false)
#endif
#ifdef PROBE_ATTN_TWICE
            for (int rep = 0; rep < 2; ++rep)
            { const int grp = blk & 7; unsigned* qctr = ctl + 64 * (rep * 16 + l * 8 + grp);
#else
            { const int grp = blk & 7; unsigned* qctr = ctl + 64 * (l * 8 + grp);
#endif
              volatile LAS unsigned* bc = (volatile LAS unsigned*)(lds + LDS_MISC);
              for (;;) {
                  if (tid == 0) bc[0] = atomicAdd(qctr, 1u);
                  __syncthreads();
                  const unsigned u = bc[0];
                  __syncthreads();
                  if (u >= 132u) break;
                  const int qb = 32 - (int)(u >> 2), bh = grp * 4 + (int)(u & 3u);
                  att::attn_unit(bh >> 3, bh & 7, qb, Qb, Knb, krb, Vtb, rope, ymla, lds);
              } }
            GRID_SYNC();
            tail_gemm(yconv + (size_t)MMAIN * 512, (const bf16*)(wreg + W_BC), 512, blk, lds, TailGate<false>{merged + (size_t)MMAIN * 1024, gates + (size_t)MMAIN * 2048});
            tail_gemm(ymla + (size_t)MMAIN * 512, (const bf16*)(wreg + W_BM), 512, blk, lds, TailGate<true>{merged + (size_t)MMAIN * 1024, gates + (size_t)MMAIN * 2048 + 1024});
            { pg8::Gemm g{yconv, (const bf16*)(wreg + W_BC), MMAIN, 1024, 512}; pg8::StaticOrder S; S.init(MMAIN, 1024, G, blk);
              pg8::EpiGate<false> E{merged, gates};
              pg8::gemm_phase<pg8::EpiGate<false>, pg8::StaticOrder, true, true>(ring, g, S, E); }
#ifdef PROBE_SYNC_BETWEEN
            GRID_SYNC();
#endif
#ifndef PROBE_SKIP_BR2
            { pg8::Gemm g{ymla, (const bf16*)(wreg + W_BM), MMAIN, 1024, 512}; pg8::StaticOrder S; S.init(MMAIN, 1024, G, blk);
              pg8::EpiGate<true> E{merged, gates + 1024};
              pg8::gemm_phase<pg8::EpiGate<true>, pg8::StaticOrder, true, true>(ring, g, S, E); }
#endif
            GRID_SYNC();
#ifdef PROBE_DUMP_MERGED
            OPQ();
            for (int row = gw; row < M; row += ngw) { const int b = row / T, t = row - b * T; if (t >= N_META) { float* o = OUTP + ((size_t)b * SEQ + (t - N_META)) * 1024;
                for (int c = lane; c < 1024; c += 64) o[c] = pg8::bf_lo(merged[(size_t)row * 1024 + c]); } }
            return;
#endif
            tail_gemm(merged + (size_t)MMAIN * 1024, (const bf16*)(wreg + W_O), 1024, blk, lds, TailResid{hf + (size_t)MMAIN * 1024, ALPHA, 1.0f, lnstats + 2 * (size_t)MMAIN, ln_g + ((size_t)l * 3 + 0) * 1024, ln_b + ((size_t)l * 3 + 0) * 1024});
            { pg8::Gemm g{merged, (const bf16*)(wreg + W_O), MMAIN, 1024, 1024}; pg8::StaticOrder S; S.init(MMAIN, 1024, G, blk);
              pg8::EpiResid E{hf, ALPHA, 1.0f, lnstats, ln_g + ((size_t)l * 3 + 0) * 1024, ln_b + ((size_t)l * 3 + 0) * 1024};
              pg8::gemm_phase<pg8::EpiResid, pg8::StaticOrder, true, true>(ring, g, S, E); }
            GRID_SYNC();
            OPQ();
            { const float* lg = ln_g + ((size_t)l * 3 + 1) * 1024; const float* lb = ln_b + ((size_t)l * 3 + 1) * 1024;
              LnRow cur = ln_load(hf + (size_t)gw * 1024, lane);
              for (int row = gw; row < MPAD; row += ngw) { const int nx = row + ngw < MPAD ? row + ngw : row; const LnRow nxt = ln_load(hf + (size_t)nx * 1024, lane);
                  ln_finish(cur, lg, lb, nullptr, hb + (size_t)row * 1024, lane, lnstats + 2 * (size_t)row); cur = nxt; }
              convert_ffn(ffn2_up + (size_t)l * 1024 * 2 * D_FF, ffn2_down + (size_t)l * D_FF * 1024, wreg, scr, gw, ngw, lane); }
            GRID_SYNC();
        }
    }
}

extern "C" void kernel_launch(void* const* d_in, const int* in_sizes, int n_in, void* d_out, int out_size, void* d_ws, size_t ws_size, hipStream_t stream) {
    static int grid = 0;
    if (grid == 0) {
        if (n_in != 18 || ws_size < WS_NEED) { fprintf(stderr, "kernel_launch: expected 18 inputs and >= %zu bytes of workspace; got %d, %zu\n", (size_t)WS_NEED, n_in, ws_size); grid = -1; return; }
        int dev = 0, cus = 0, per_cu = 0;
        hipGetDevice(&dev); hipDeviceGetAttribute(&cus, hipDeviceAttributeMultiprocessorCount, dev);
        if (hipFuncSetAttribute((const void*)mega_fwd, hipFuncAttributeMaxDynamicSharedMemorySize, LDS_BYTES) != hipSuccess) { fprintf(stderr, "kernel_launch: hipFuncSetAttribute failed\n"); grid = -1; return; }
        hipOccupancyMaxActiveBlocksPerMultiprocessor(&per_cu, (const void*)mega_fwd, NWAVES * 64, LDS_BYTES);
        (void)hipGetLastError();
        if (per_cu < 1) per_cu = 1;
        grid = cus;
    }
    if (grid < 0) return;
    (void)hipMemsetAsync((char*)d_ws + OFF_CTL, 0, 65536, stream);
    Args a{};
    for (int i = 0; i < 18; ++i) a.in[i] = (const float*)d_in[i];
    a.out = (float*)d_out; a.ws = (unsigned char*)d_ws;
    void* params[] = {&a};
    hipError_t e = hipLaunchCooperativeKernel((const void*)mega_fwd, dim3(grid), dim3(NWAVES * 64), params, LDS_BYTES, stream);
    if (e != hipSuccess) fprintf(stderr, "cooperative launch failed: %s (grid %d)\n", hipGetErrorString(e), grid);
}
```
